# Optimizing an MI355X kernel written in HIP

```python
import math
import jax
import jax.numpy as jnp
from jax import lax
import numpy as np

D_MODEL = 1024
BATCH = 1
SEQ = 16384
DEPTH = 4

CHUNK = 64
Q_BLOCK = 128
PLE_DIM = 256

A_HEADS = 8
A_HEAD_DIM = 64
A_LEFT_CHUNKS = 8
A_BAND = (A_LEFT_CHUNKS + 1) * CHUNK
A_REL_CLIP = 128
A_WIDTH = A_HEADS * A_HEAD_DIM

B_HEADS = 8
B_NOPE_DIM = 64
B_ROPE_DIM = 32
B_V_DIM = 64
B_Q_RANK = 512
B_KV_RANK = 256
ROPE_BASE = 10000.0

C_HEADS = 8
C_HEAD_DIM = 64
C_QK = 2 * C_HEADS * C_HEAD_DIM
C_OUT = C_HEADS * 2 * C_HEAD_DIM
C_IN = 2 * C_QK + C_OUT

T5_BUCKETS = 32
T5_MAX_DIST = 128

N_EXPERTS = 32
TOP_K = 4
D_FF = 1024
SWIGLU_ALPHA = 1.702
SWIGLU_LIMIT = 7.0

DEEPNORM_ALPHA = (2.0 * DEPTH) ** 0.25
DEEPNORM_BETA = (8.0 * DEPTH) ** -0.25
LN_EPS = 1e-5
RMS_EPS = 1e-6
N_AB = (DEPTH + 1) // 2
N_C = DEPTH // 2

AB_IN = 3 * A_WIDTH + B_Q_RANK + B_KV_RANK + B_ROPE_DIM
AB_OUT = A_WIDTH + B_HEADS * B_V_DIM
AB_SPLITS = [A_WIDTH, 2 * A_WIDTH, 3 * A_WIDTH, 3 * A_WIDTH + B_Q_RANK, 3 * A_WIDTH + B_Q_RANK + B_KV_RANK]
C_SPLITS = [C_QK, 2 * C_QK]

F32 = jnp.float32
NEG_INF = -1e30

kernel_name = 'hybrid_chunk_causal_moe_trunk'


def layer_norm(x, g, b):
    xf = x.astype(F32)
    mu = jnp.mean(xf, axis=-1, keepdims=True)
    var = jnp.mean(jnp.square(xf - mu), axis=-1, keepdims=True)
    return ((xf - mu) * lax.rsqrt(var + LN_EPS) * g.astype(F32) + b.astype(F32)).astype(x.dtype)


def rms_norm(x, g):
    xf = x.astype(F32)
    inv = lax.rsqrt(jnp.mean(jnp.square(xf), axis=-1, keepdims=True) + RMS_EPS)
    return (xf * inv * g.astype(F32)).astype(x.dtype)


def rope(x, pos):
    d = x.shape[-1]
    inv_freq = ROPE_BASE ** (-jnp.arange(0, d, 2, dtype=F32) / d)
    ang = pos.astype(F32)[:, None] * inv_freq[None, :]
    cos = jnp.cos(ang)[None, :, None, :]
    sin = jnp.sin(ang)[None, :, None, :]
    xf = x.astype(F32)
    x1, x2 = xf[..., : d // 2], xf[..., d // 2:]
    return jnp.concatenate([x1 * cos - x2 * sin, x2 * cos + x1 * sin], axis=-1).astype(x.dtype)


def masked_softmax(logits, mask):
    return jax.nn.softmax(jnp.where(mask, logits, NEG_INF), axis=-1)


def block_chunk_mask(block_idx, s):
    q_pos = block_idx * Q_BLOCK + jnp.arange(Q_BLOCK)
    k_pos = jnp.arange(s)
    return (k_pos[None, :] // CHUNK) <= (q_pos[:, None] // CHUNK)


def sweep_query_blocks(block_fn, q_arrays):
    b, s = q_arrays[0].shape[:2]
    nb = s // Q_BLOCK
    xs = tuple(jnp.swapaxes(q.reshape(b, nb, Q_BLOCK, *q.shape[2:]), 0, 1) for q in q_arrays)
    out = lax.map(lambda args: block_fn(args[0], *args[1:]), (jnp.arange(nb), *xs))
    return jnp.swapaxes(out, 0, 1).reshape(b, s, *out.shape[3:])


def t5_bucket(rel):
    half = T5_BUCKETS // 2
    max_exact = half // 2
    ret = jnp.where(rel > 0, half, 0)
    n = jnp.abs(rel)
    large = max_exact + (jnp.log(jnp.maximum(n, max_exact).astype(F32) / max_exact)
                         / math.log(T5_MAX_DIST / max_exact) * (half - max_exact)).astype(jnp.int32)
    large = jnp.minimum(large, half - 1)
    return ret + jnp.where(n < max_exact, n, large)


def chunked_band_attention(q, k, v, rel_bias):
    b, s, h, dh = q.shape
    nc = s // CHUNK
    qc = q.reshape(b, nc, CHUNK, h, dh)
    pad = ((0, 0), (A_LEFT_CHUNKS, 0), (0, 0), (0, 0), (0, 0))
    kc = jnp.pad(k.reshape(b, nc, CHUNK, h, dh), pad)
    vc = jnp.pad(v.reshape(b, nc, CHUNK, h, dh), pad)
    k_band = jnp.concatenate([kc[:, j:j + nc] for j in range(A_LEFT_CHUNKS + 1)], axis=2)
    v_band = jnp.concatenate([vc[:, j:j + nc] for j in range(A_LEFT_CHUNKS + 1)], axis=2)
    logits = jnp.einsum('bcqhd,bckhd->bchqk', qc, k_band).astype(F32) * (dh ** -0.5)
    qi = jnp.arange(CHUNK)
    ki = jnp.arange(A_BAND)
    rel = A_LEFT_CHUNKS * CHUNK + qi[:, None] - ki[None, :]
    bias = rel_bias[jnp.clip(rel, -A_REL_CLIP, A_REL_CLIP) + A_REL_CLIP]
    logits = logits + jnp.transpose(bias, (2, 0, 1)).astype(F32)[None, None]
    valid = (jnp.arange(nc)[:, None] - A_LEFT_CHUNKS + ki[None, :] // CHUNK) >= 0
    probs = masked_softmax(logits, valid[None, :, None, None, :])
    out = jnp.einsum('bchqk,bckhd->bcqhd', probs.astype(v.dtype), v_band)
    return out.reshape(b, s, h, dh)


def latent_attention(c_q, c_kv, k_r, q_norm_g, kv_norm_g, w_uq, w_ukv, pos):
    b, s, _ = c_q.shape
    q = (rms_norm(c_q, q_norm_g) @ w_uq).reshape(b, s, B_HEADS, B_NOPE_DIM + B_ROPE_DIM)
    q_nope = q[..., :B_NOPE_DIM]
    q_rope = rope(q[..., B_NOPE_DIM:], pos)
    kv = (rms_norm(c_kv, kv_norm_g) @ w_ukv).reshape(b, s, B_HEADS, B_NOPE_DIM + B_V_DIM)
    k_nope = kv[..., :B_NOPE_DIM]
    v = kv[..., B_NOPE_DIM:]
    k_rope = rope(k_r[:, :, None, :], pos)[:, :, 0]
    scale = (B_NOPE_DIM + B_ROPE_DIM) ** -0.5

    def block(bi, qn, qr):
        logits = (jnp.einsum('bqhd,bkhd->bhqk', qn, k_nope).astype(F32)
                  + jnp.einsum('bqhd,bkd->bhqk', qr, k_rope).astype(F32)) * scale
        probs = masked_softmax(logits, block_chunk_mask(bi, s)[None, None])
        return jnp.einsum('bhqk,bkhd->bqhd', probs.astype(v.dtype), v)

    return sweep_query_blocks(block, (q_nope, q_rope))


def lambda_init(layer_idx):
    return 0.8 - 0.6 * math.exp(-0.3 * layer_idx)


def differential_attention(q, k, v, lam_params, subln_g, t5_table, lam_init):
    b, s = q.shape[:2]
    lp = lam_params.astype(F32)
    lam = jnp.exp(jnp.sum(lp[0] * lp[1])) - jnp.exp(jnp.sum(lp[2] * lp[3])) + lam_init
    scale = C_HEAD_DIM ** -0.5

    def block(bi, qb):
        logits = jnp.einsum('bqhnd,bkhnd->bhnqk', qb, k).astype(F32) * scale
        rel = jnp.arange(s)[None, :] - (bi * Q_BLOCK + jnp.arange(Q_BLOCK))[:, None]
        bias = jnp.transpose(t5_table[t5_bucket(rel)], (2, 0, 1)).astype(F32)
        probs = masked_softmax(logits + bias[None, :, None], block_chunk_mask(bi, s)[None, None, None])
        attn = probs[:, :, 0] - lam * probs[:, :, 1]
        return jnp.einsum('bhqk,bkhd->bqhd', attn.astype(v.dtype), v)

    o = sweep_query_blocks(block, (q,))
    return rms_norm(o, subln_g) * (1.0 - lam_init)


def moe_ffn(x, w_router, b_router, w_in, b_in, w_out, b_out):
    logits = (x @ w_router).astype(F32) + b_router.astype(F32)
    top_val, top_idx = lax.top_k(logits, TOP_K)
    top_w = jax.nn.softmax(top_val, axis=-1)
    gates = jnp.einsum('bsk,bske->ebs', top_w, jax.nn.one_hot(top_idx, N_EXPERTS, dtype=F32))

    def expert(acc, params):
        wi, bi, wo, bo, g = params
        h = x @ wi + bi
        glu = jnp.minimum(h[..., :D_FF], SWIGLU_LIMIT)
        lin = jnp.clip(h[..., D_FF:], -SWIGLU_LIMIT, SWIGLU_LIMIT)
        y = (glu * jax.nn.sigmoid(SWIGLU_ALPHA * glu) * (lin + 1.0)) @ wo + bo
        return acc + g[..., None].astype(x.dtype) * y, None

    out, _ = lax.scan(expert, jnp.zeros_like(x), (w_in, b_in, w_out, b_out, gates))
    return out


def _normal(key, shape, scale):
    return jax.random.normal(key, shape, F32) * scale


def setup_inputs(seed: int = 0) -> dict:
    key = jax.random.key(seed)
    ks = jax.random.split(key, 26)
    d = D_MODEL
    return {
        'x': _normal(ks[0], (BATCH, SEQ, d), 1.0),
        'p': _normal(ks[1], (DEPTH, BATCH, SEQ, PLE_DIM), 1.0),
        'ab_w_in': _normal(ks[2], (N_AB, d, AB_IN), d ** -0.5),
        'ab_rel_bias': _normal(ks[3], (N_AB, 2 * A_REL_CLIP + 1, A_HEADS), 0.2),
        'ab_q_norm': 1.0 + _normal(ks[4], (N_AB, B_Q_RANK), 0.01),
        'ab_kv_norm': 1.0 + _normal(ks[5], (N_AB, B_KV_RANK), 0.01),
        'ab_w_uq': _normal(ks[6], (N_AB, B_Q_RANK, B_HEADS * (B_NOPE_DIM + B_ROPE_DIM)), B_Q_RANK ** -0.5),
        'ab_w_ukv': _normal(ks[7], (N_AB, B_KV_RANK, B_HEADS * (B_NOPE_DIM + B_V_DIM)), B_KV_RANK ** -0.5),
        'ab_w_out': _normal(ks[8], (N_AB, AB_OUT, d), DEEPNORM_BETA * AB_OUT ** -0.5),
        'c_w_in': _normal(ks[9], (N_C, d, C_IN), d ** -0.5),
        'c_lambda': _normal(ks[10], (N_C, 4, C_HEAD_DIM), 0.1),
        'c_subln': 1.0 + _normal(ks[11], (N_C, 2 * C_HEAD_DIM), 0.01),
        'c_w_out': _normal(ks[12], (N_C, C_OUT, d), DEEPNORM_BETA * C_OUT ** -0.5),
        't5_table': _normal(ks[13], (T5_BUCKETS, C_HEADS), 0.2),
        'ln_mix_g': 1.0 + _normal(ks[14], (DEPTH, d), 0.01),
        'ln_mix_b': _normal(ks[15], (DEPTH, d), 0.01),
        'ln_ffn_g': 1.0 + _normal(ks[16], (DEPTH, d), 0.01),
        'ln_ffn_b': _normal(ks[17], (DEPTH, d), 0.01),
        'router_w': _normal(ks[18], (DEPTH, d, N_EXPERTS), d ** -0.5),
        'router_b': _normal(ks[19], (DEPTH, N_EXPERTS), 0.01),
        'exp_w_in': _normal(ks[20], (DEPTH, N_EXPERTS, d, 2 * D_FF), d ** -0.5),
        'exp_b_in': _normal(ks[21], (DEPTH, N_EXPERTS, 2 * D_FF), 0.01),
        'exp_w_out': _normal(ks[22], (DEPTH, N_EXPERTS, D_FF, d), DEEPNORM_BETA * D_FF ** -0.5),
        'exp_b_out': _normal(ks[23], (DEPTH, N_EXPERTS, d), 0.01),
        'ple_gate_w': _normal(ks[24], (DEPTH, d, d), d ** -0.5),
        'ple_proj_w': _normal(ks[25], (DEPTH, PLE_DIM, d), DEEPNORM_BETA * PLE_DIM ** -0.5),
    }


def reference(x, p, ab_w_in, ab_rel_bias, ab_q_norm, ab_kv_norm, ab_w_uq, ab_w_ukv, ab_w_out,
              c_w_in, c_lambda, c_subln, c_w_out, t5_table,
              ln_mix_g, ln_mix_b, ln_ffn_g, ln_ffn_b,
              router_w, router_b, exp_w_in, exp_b_in, exp_w_out, exp_b_out,
              ple_gate_w, ple_proj_w):
    b, s, _ = x.shape
    pos = jnp.arange(s)
    for i in range(DEPTH):
        j = i // 2
        if i % 2 == 0:
            h = x @ ab_w_in[j]
            qa, ka, va, c_q, c_kv, k_r = jnp.split(h, AB_SPLITS, axis=-1)
            o_a = chunked_band_attention(qa.reshape(b, s, A_HEADS, A_HEAD_DIM),
                                         ka.reshape(b, s, A_HEADS, A_HEAD_DIM),
                                         va.reshape(b, s, A_HEADS, A_HEAD_DIM),
                                         ab_rel_bias[j])
            o_b = latent_attention(c_q, c_kv, k_r, ab_q_norm[j], ab_kv_norm[j],
                                   ab_w_uq[j], ab_w_ukv[j], pos)
            mixed = jnp.concatenate([o_a.reshape(b, s, -1), o_b.reshape(b, s, -1)], axis=-1) @ ab_w_out[j]
        else:
            h = x @ c_w_in[j]
            qc, kc, vc = jnp.split(h, C_SPLITS, axis=-1)
            o_c = differential_attention(qc.reshape(b, s, C_HEADS, 2, C_HEAD_DIM),
                                         kc.reshape(b, s, C_HEADS, 2, C_HEAD_DIM),
                                         vc.reshape(b, s, C_HEADS, 2 * C_HEAD_DIM),
                                         c_lambda[j], c_subln[j], t5_table, lambda_init(i))
            mixed = o_c.reshape(b, s, C_OUT) @ c_w_out[j]
        x = layer_norm(DEEPNORM_ALPHA * x + mixed, ln_mix_g[i], ln_mix_b[i])
        ffn = moe_ffn(x, router_w[i], router_b[i], exp_w_in[i], exp_b_in[i], exp_w_out[i], exp_b_out[i])
        ple = jax.nn.sigmoid(x @ ple_gate_w[i]) * (p[i] @ ple_proj_w[i])
        x = layer_norm(DEEPNORM_ALPHA * x + ffn + ple, ln_ffn_g[i], ln_ffn_b[i])
    return x
```

```cpp
#include <hip/hip_runtime.h>
#include <cstdio>
#include <cstdint>
#include <cmath>

#ifndef MK_ONE_LAUNCH
#define MK_ONE_LAUNCH 1
#endif
#ifndef NAIVE_ATTN
#define NAIVE_ATTN 0
#endif
#ifndef MOE_FP8
#define MOE_FP8 1
#endif
#ifndef ATT_C_FP8
#define ATT_C_FP8 1
#endif
#ifndef ATT_B_FP8
#define ATT_B_FP8 1
#endif
#ifndef REF_GEMM
#define REF_GEMM 0
#endif

#define LAS __attribute__((address_space(3)))
#define GAS __attribute__((address_space(1)))
typedef unsigned short bf16_t;
typedef short bf16x8 __attribute__((ext_vector_type(8)));
typedef float f32x4 __attribute__((ext_vector_type(4)));
typedef float f32x2 __attribute__((ext_vector_type(2)));
typedef unsigned u32x4 __attribute__((ext_vector_type(4)));
typedef unsigned u32x2 __attribute__((ext_vector_type(2)));
typedef GAS unsigned gu32;

constexpr int S = 16384, D = 1024, DEPTH = 4, PLE = 256;
constexpr int NE = 32, TOPK = 4, DFF = 1024;
constexpr int AB_IN = 2336;
constexpr float LOG2E = 1.4426950408889634f;
constexpr float DN_ALPHA = 1.681792830507429f;
constexpr float LN_EPS = 1e-5f, RMS_EPS = 1e-6f;
constexpr int NWAVES = 8, NTHREADS = 512;
constexpr int SLOT_ROWS = 65536 + NE * 256;

constexpr size_t MiB = 1u << 20;
constexpr size_t CTL_BYTES = 1 * MiB;
constexpr size_t al(size_t x) { return (x + MiB - 1) / MiB * MiB; }
constexpr size_t WS_CTL = 0;
constexpr size_t WS_TAB = WS_CTL + CTL_BYTES;
constexpr size_t TAB_ROPE = 0;
constexpr size_t TAB_WRT = 2 * MiB;
constexpr size_t TAB_BIASA = TAB_WRT + 512 * 1024;
constexpr size_t TAB_T5 = TAB_BIASA + 32 * 1024;
constexpr size_t TAB_LAM = TAB_T5 + 8 * 1024;
constexpr size_t TAB_FA = TAB_LAM + 1024;
constexpr size_t TAB_FAFAR = TAB_FA + 3 * 8 * 256 * 4;
constexpr size_t WS_WABIN = WS_TAB + 4 * MiB;
constexpr size_t WS_WUQ = WS_WABIN + al((size_t)2 * 2560 * 1024 * 2);
constexpr size_t WS_WUKVK = WS_WUQ + al((size_t)2 * 768 * 512 * 2);
constexpr size_t WS_WUKVV = WS_WUKVK + al((size_t)2 * 512 * 256 * 2);
constexpr size_t WS_WABOUT = WS_WUKVV + al((size_t)2 * 512 * 256 * 2);
constexpr size_t WS_WCIN = WS_WABOUT + al((size_t)2 * 1024 * 1024 * 2);
constexpr size_t WS_WCOUT = WS_WCIN + al((size_t)2 * 3072 * 1024 * 2);
constexpr size_t WS_WPG = WS_WCOUT + al((size_t)2 * 1024 * 1024 * 2);
constexpr size_t WS_WPP = WS_WPG + al((size_t)4 * 1024 * 1024 * 2);
constexpr size_t WS_W1 = WS_WPP + al((size_t)4 * 1024 * 256 * 2);
constexpr size_t WS_W2 = WS_W1 + al((size_t)4 * 32 * 2048 * 1024 * 2);
constexpr size_t WS_XB = WS_W2 + al((size_t)4 * 32 * 1024 * 1024 * 2);
constexpr size_t WS_PB = WS_XB + al((size_t)S * D * 2);
constexpr size_t WS_PP = WS_PB + al((size_t)4 * S * 256 * 2);
constexpr size_t WS_QA = WS_PP + al((size_t)4 * S * D * 2);
constexpr size_t WS_KA = WS_QA + al((size_t)S * 512 * 2);
constexpr size_t WS_VAT = WS_KA + al((size_t)S * 512 * 2);
constexpr size_t WS_CQ = WS_VAT + al((size_t)S * 512 * 2);
constexpr size_t WS_CKV = WS_CQ + al((size_t)S * 512 * 2);
constexpr size_t WS_SSQQ = WS_CKV + al((size_t)S * 256 * 2);
constexpr size_t WS_SSQKV = WS_SSQQ + al((size_t)S * 8 * 4);
constexpr size_t WS_QB = WS_SSQKV + al((size_t)S * 4 * 4);
constexpr size_t WS_KB = WS_QB + al((size_t)S * 768 * 2);
constexpr size_t WS_VBT = WS_KB + al((size_t)S * 768 * 2);
constexpr size_t WS_QC = WS_VBT + al((size_t)S * 512 * 2);
constexpr size_t WS_KC = WS_QC + al((size_t)S * D * 2);
constexpr size_t WS_VCT = WS_KC + al((size_t)S * D * 2);
constexpr size_t WS_OAB = WS_VCT + al((size_t)S * D * 2);
constexpr size_t WS_Z = WS_OAB + al((size_t)S * D * 2);
constexpr size_t WS_X1 = WS_Z + al((size_t)S * D * 4);
constexpr size_t WS_XB1 = WS_X1 + al((size_t)S * D * 4);
constexpr size_t WS_Z2 = WS_XB1 + al((size_t)S * D * 2);
constexpr size_t WS_HS = WS_Z2 + al((size_t)S * D * 4);
constexpr size_t WS_YS = WS_HS + al((size_t)SLOT_ROWS * 1024 * 2);
constexpr size_t WS_TOK = WS_YS + al((size_t)SLOT_ROWS * 1024 * 2);
constexpr size_t WS_GATE = WS_TOK + al((size_t)NE * S * 4);
constexpr size_t WS_SLOT = WS_GATE + al((size_t)NE * S * 4);
constexpr size_t WS_XF8 = WS_SLOT + al((size_t)S * 4 * 8);
constexpr size_t WS_END = WS_XF8 + al((size_t)S * D);

constexpr int CW_BAR = 4096;
constexpr int CW_CNT = 16384;

constexpr int LDS_BYTES = 147456;
constexpr int LM = 131072;
constexpr int LM_BAR = LM + 0;
constexpr int LM_TOFF = LM + 64;
constexpr int LM_CNT = LM + 256;
constexpr int LM_HIST = LM + 512;
constexpr int LM_BASE = LM + 640;
constexpr int LM_SEL = LM + 1024;
constexpr int LM_FLAG = LM + 32;
constexpr int LM_T2E = LM + 4608;
constexpr int LM_FREE = LM + 8192;

__device__ __forceinline__ unsigned cvt_pk_bf16(float lo, float hi) { unsigned r; asm volatile("v_cvt_pk_bf16_f32 %0, %1, %2" : "=v"(r) : "v"(lo), "v"(hi)); return r; }
__device__ __forceinline__ float bf_lo(unsigned w) { return __uint_as_float(w << 16); }
__device__ __forceinline__ float bf_hi(unsigned w) { return __uint_as_float(w & 0xffff0000u); }
__device__ __forceinline__ float bf2f(bf16_t h) { return __uint_as_float(((unsigned)h) << 16); }
__device__ __forceinline__ float wave_sum(float v) {
#pragma unroll
    for (int o = 1; o < 64; o <<= 1) v += __shfl_xor(v, o);
    return v;
}
__device__ __forceinline__ float wave_max(float v) {
#pragma unroll
    for (int o = 1; o < 64; o <<= 1) v = fmaxf(v, __shfl_xor(v, o));
    return v;
}
__device__ __forceinline__ float rdlane(float v, int l) { return __uint_as_float((unsigned)__builtin_amdgcn_readlane((int)__float_as_uint(v), l)); }
__device__ __forceinline__ float fast_exp2(float x) { return __builtin_amdgcn_exp2f(x); }
__device__ __forceinline__ float fast_rcp(float x) { return __builtin_amdgcn_rcpf(x); }
__device__ __forceinline__ float sigmoidf_(float x) { return fast_rcp(1.0f + fast_exp2(-x * LOG2E)); }
__device__ __forceinline__ int lane_id_asm() { int l; asm volatile("v_mbcnt_lo_u32_b32 %0, -1, 0\n\tv_mbcnt_hi_u32_b32 %0, -1, %0" : "=v"(l)); return l; }
template <int CTRL> __device__ __forceinline__ float dppx(float v) { return __uint_as_float((unsigned)__builtin_amdgcn_update_dpp(0, (int)__float_as_uint(v), CTRL, 0xF, 0xF, true)); }
__device__ __forceinline__ float xpart16(float v, int lane) { auto rr = __builtin_amdgcn_permlane16_swap(__float_as_uint(v), __float_as_uint(v), false, false); return __uint_as_float((lane & 16) ? rr[0] : rr[1]); }
__device__ __forceinline__ float xpart32(float v, int lane) { auto rr = __builtin_amdgcn_permlane32_swap(__float_as_uint(v), __float_as_uint(v), false, false); return __uint_as_float((lane & 32) ? rr[0] : rr[1]); }
__device__ __forceinline__ float wsum_fast(float v) {
    v += dppx<0xB1>(v); v += dppx<0x4E>(v); v += dppx<0x124>(v); v += dppx<0x128>(v);
    { auto rr = __builtin_amdgcn_permlane16_swap(__float_as_uint(v), __float_as_uint(v), false, false); v = __uint_as_float(rr[0]) + __uint_as_float(rr[1]); }
    { auto rr = __builtin_amdgcn_permlane32_swap(__float_as_uint(v), __float_as_uint(v), false, false); v = __uint_as_float(rr[0]) + __uint_as_float(rr[1]); }
    return v;
}
#define LDS_WAIT() asm volatile("s_waitcnt lgkmcnt(0)" ::: "memory")
#define VM_WAIT() asm volatile("s_waitcnt vmcnt(0)" ::: "memory")

#define XB_TMO      128
#define XB_XCNT(j)  (256  + 64 * (j))
#define XB_XSUB(j)  (1280 + 64 * (j))
#define XB_XGEN(j)  (2304 + 64 * (j))
#define XB_TOP      3328
#define XB_TOPGEN   3392
#define XCD_BAR_WORDS 3456
#define XB_SPIN_CAP (1u << 22)
__device__ __forceinline__ unsigned xb_ld(unsigned* p)              { return __hip_atomic_load(p, __ATOMIC_RELAXED, __HIP_MEMORY_SCOPE_AGENT); }
__device__ __forceinline__ unsigned xb_add(unsigned* p, unsigned v) { return __hip_atomic_fetch_add(p, v, __ATOMIC_RELAXED, __HIP_MEMORY_SCOPE_AGENT); }
__device__ __forceinline__ unsigned xb_xcc_id() { return (unsigned)__builtin_amdgcn_s_getreg((3 << 11) | 20) & 0xFu; }
#define XB_SPIN(cond, bar) do { unsigned _sp = 0; while (cond) { __builtin_amdgcn_s_sleep(1); \
    if ((++_sp & 255u) == 0u) { if (xb_ld(&(bar)[XB_TMO])) break; if (_sp > XB_SPIN_CAP) { atomicAdd(&(bar)[XB_TMO], 1u); break; } } } } while (0)
struct XcdBarrier { unsigned* bar; unsigned x; volatile LAS unsigned* st; };
__device__ __forceinline__ XcdBarrier xcd_barrier_post(unsigned* bar, volatile LAS unsigned* st) {
    XcdBarrier b; b.bar = bar; b.x = xb_xcc_id(); b.st = st;
    if (threadIdx.x == 0) (void)xb_add(&bar[XB_XCNT(b.x)], 1u);
    return b;
}
__device__ __forceinline__ void xcd_barrier_complete(unsigned* bar, unsigned x, unsigned& nloc, unsigned& nx) {
    const unsigned G = gridDim.x * gridDim.y * gridDim.z;
    unsigned sum, cnt, mine, sp = 0u;
    for (;;) {
        sum = 0u; cnt = 0u; mine = 0u;
#pragma unroll
        for (unsigned j = 0; j < 16; ++j) { const unsigned c = xb_ld(&bar[XB_XCNT(j)]); sum += c; cnt += (c > 0u) ? 1u : 0u; mine = (j == x) ? c : mine; }
        if (sum == G) break;
        __builtin_amdgcn_s_sleep(1);
        if ((++sp & 255u) == 0u) { if (xb_ld(&bar[XB_TMO])) break; if (sp > XB_SPIN_CAP) { atomicAdd(&bar[XB_TMO], 1u); break; } }
    }
    nloc = mine > 0u ? mine : 1u; nx = cnt > 0u ? cnt : 1u;
}
__device__ __forceinline__ void xcd_barrier(const XcdBarrier& b) {
    asm volatile("s_waitcnt vmcnt(0)" ::: "memory");
    __syncthreads();
    if (threadIdx.x == 0) {
        unsigned* bar = b.bar;
        __builtin_amdgcn_s_waitcnt(0);
        unsigned nloc = b.st[0], nx = b.st[1];
        if (nloc == 0u) { xcd_barrier_complete(bar, b.x, nloc, nx); b.st[0] = nloc; b.st[1] = nx; }
        const unsigned old = xb_add(&bar[XB_XSUB(b.x)], 1u);
        const unsigned gen = old / nloc;
        if (old + 1u == (gen + 1u) * nloc) {
            __builtin_amdgcn_fence(__ATOMIC_RELEASE, "agent");
            asm volatile("s_waitcnt vmcnt(0)" ::: "memory");
            const unsigned og = xb_add(&bar[XB_TOP], 1u);
            const unsigned tg = og / nx;
            if (og + 1u == (tg + 1u) * nx) xb_add(&bar[XB_TOPGEN], 1u);
            else XB_SPIN(xb_ld(&bar[XB_TOPGEN]) == tg, bar);
            __builtin_amdgcn_fence(__ATOMIC_ACQUIRE, "agent");
            xb_add(&bar[XB_XGEN(b.x)], 1u);
            asm volatile("s_waitcnt vmcnt(0)" ::: "memory");
        } else {
            XB_SPIN(xb_ld(&bar[XB_XGEN(b.x)]) == gen, bar);
            __builtin_amdgcn_fence(__ATOMIC_ACQUIRE, "agent");
            asm volatile("s_waitcnt vmcnt(0)" ::: "memory");
        }
    }
    __syncthreads();
}

namespace pg8 {
constexpr int BM = 256, BK = 64, HALF = 128, HTB = HALF * BK * 2, STAGE_BYTES = 8 * HTB, NXCD = 8, WGM = 8;
__host__ __device__ __forceinline__ int lds_byte(int r, int c) { const int st = (r >> 4) * 2 + (c >> 5), rr = r & 15, cc = c & 31, ob = rr * 64 + cc * 2; return st * 1024 + (ob ^ (((ob >> 9) & 1) << 5)); }
__host__ __device__ __forceinline__ void stage_rc(int b, int& R, int& C) { const int st = b / 1024, sb = b % 1024, swz = sb ^ (((sb >> 9) & 1) << 5); R = (st >> 1) * 16 + swz / 64; C = (st & 1) * 32 + (swz % 64) / 2; }
__host__ __device__ __forceinline__ int perm32(int rho) { const int n = rho >> 4, i = rho & 15; return 8 * (i >> 2) + 4 * n + (i & 3); }

struct Unit { int pm, pn, e, aux; };
struct Gemm { const bf16_t* A; const bf16_t* Bt; int K; size_t strideBe; int wave; };

struct StaticOrder {
    static constexpr bool GATHER = false;
    int nM, nN, nwg, G, c;
    __device__ __forceinline__ void init(int M, int N, int G_, int c_) { nM = M / BM; nN = N / BM; nwg = nM * nN; G = G_; c = c_; }
    __device__ __forceinline__ bool next(int i, Unit& u) const {
        const long L = (long)i * G + c; if (L >= nwg) return false;
        int wgid = (int)L; { const int q = nwg / NXCD, r = nwg % NXCD, xcd = wgid % NXCD, off = wgid / NXCD; wgid = (xcd < r ? xcd * (q + 1) : r * (q + 1) + (xcd - r) * q) + off; }
        const int nig = WGM * nN, gid = wgid / nig, fm = gid * WGM, gsz = (nM - fm) < WGM ? (nM - fm) : WGM;
        u.pm = fm + ((wgid % nig) % gsz); u.pn = (wgid % nig) / gsz; u.e = 0; u.aux = 0; return true;
    }
    __device__ __forceinline__ int arow(const Unit& u, int r) const { return u.pm * BM + r; }
};

struct LayeredOrder {
    static constexpr bool GATHER = false;
    StaticOrder so;
    __device__ __forceinline__ bool next(int i, Unit& u) const { if (!so.next(i, u)) return false; u.e = u.pm / (S / BM); return true; }
    __device__ __forceinline__ int arow(const Unit& u, int r) const { return u.pm * BM + r; }
};
#define PG8_SA(b, h) (((b) * 2 + (h)) * HTB)
#define PG8_SB(b, h) ((4 + (b) * 2 + (h)) * HTB)
__device__ __forceinline__ const char* uniform_ptr(const void* p) { const unsigned long long a = (unsigned long long)p; const unsigned lo = (unsigned)__builtin_amdgcn_readfirstlane((int)(unsigned)a), hi = (unsigned)__builtin_amdgcn_readfirstlane((int)(unsigned)(a >> 32)); return (const char*)(((unsigned long long)hi << 32) | lo); }
__device__ __forceinline__ void glds_sv(const void* base, unsigned voff, unsigned ldsaddr) { unsigned keep;
    asm volatile("s_mov_b32 %0, m0\n\ts_mov_b32 m0, %3\n\ts_nop 0\n\tglobal_load_lds_dwordx4 %1, %2\n\ts_mov_b32 m0, %0" : "=&s"(keep) : "v"(voff), "s"(base), "s"(ldsaddr) : "memory"); }
__device__ __forceinline__ void glds_dw(const void* base, unsigned voff, unsigned ldsaddr) { unsigned keep;
    asm volatile("s_mov_b32 %0, m0\n\ts_mov_b32 m0, %3\n\ts_nop 0\n\tglobal_load_lds_dword %1, %2\n\ts_mov_b32 m0, %0" : "=&s"(keep) : "v"(voff), "s"(base), "s"(ldsaddr) : "memory"); }
#define PG8_STAGE_B(bufoff, gbase) do { _Pragma("unroll") for (int _i = 0; _i < 2; ++_i) \
        glds_sv((const char*)(gbase), voffB[_i], ldsbase + (unsigned)((bufoff) + _i * 8192)); } while (0)
#define PG8_STAGE_A(bufoff, kofs, W, h) do { _Pragma("unroll") for (int _i = 0; _i < 2; ++_i) { \
        if constexpr (GATH) glds_sv(gA + (kofs), v##W[(h) % NH][_i], ldsbase + (unsigned)((bufoff) + _i * 8192)); \
        else glds_sv(u##W + (kofs) + (size_t)(h) * hstep, voffA[_i], ldsbase + (unsigned)((bufoff) + _i * 8192)); } } while (0)
typedef int i32x8 __attribute__((ext_vector_type(8)));
typedef int i32x4 __attribute__((ext_vector_type(4)));
__device__ __forceinline__ i32x8 ld_pair(const LAS unsigned char* p) { const i32x4 x = *(const LAS i32x4*)p, y = *(const LAS i32x4*)(p + 1024); return __builtin_shufflevector(x, y, 0, 1, 2, 3, 4, 5, 6, 7); }
__device__ __forceinline__ bf16x8 half_lo(i32x8 v) { const i32x4 x = __builtin_shufflevector(v, v, 0, 1, 2, 3); return __builtin_bit_cast(bf16x8, x); }
__device__ __forceinline__ bf16x8 half_hi(i32x8 v) { const i32x4 x = __builtin_shufflevector(v, v, 4, 5, 6, 7); return __builtin_bit_cast(bf16x8, x); }
#define PG8_LDA(dst, b, h) do { _Pragma("unroll") for (int m = 0; m < 4; ++m) dst[m] = ld_pair(lds + PG8_SA(b, h) + aoff + m * 2048); } while (0)
#define PG8_LDB(dst, b, h) do { _Pragma("unroll") for (int n = 0; n < 2; ++n) dst[n] = ld_pair(lds + PG8_SB(b, h) + boff + n * 2048); } while (0)
#define PG8_MMA(ai, bj, At, Bt) do { __builtin_amdgcn_s_setprio(1); _Pragma("unroll") for (int m = 0; m < 4; ++m) _Pragma("unroll") for (int n = 0; n < 2; ++n) { \
        if constexpr (Epi::FP8) asm volatile("v_mfma_scale_f32_16x16x128_f8f6f4 %0, %1, %2, %0, %3, %3 op_sel_hi:[0,0,0]" : "+v"(acc[ai][bj][m][n]) : "v"(Bt[n]), "v"(At[m]), "v"(0x7F7F7F7F)); \
        else { acc[ai][bj][m][n] = __builtin_amdgcn_mfma_f32_16x16x32_bf16(half_lo(Bt[n]), half_lo(At[m]), acc[ai][bj][m][n], 0, 0, 0); \
               acc[ai][bj][m][n] = __builtin_amdgcn_mfma_f32_16x16x32_bf16(half_hi(Bt[n]), half_hi(At[m]), acc[ai][bj][m][n], 0, 0, 0); } } \
        __builtin_amdgcn_s_setprio(0); } while (0)
#define PG8_WAIT_V(n) asm volatile("s_waitcnt vmcnt(" #n ")" ::: "memory")
#define PG8_WAIT_L(n) asm volatile("s_waitcnt lgkmcnt(" #n ")" ::: "memory")
#define PG8_BAR __builtin_amdgcn_s_barrier()
#define PG8_SCHED __builtin_amdgcn_sched_barrier(0)
#define PG8_SETOFF(W, UN) do { if constexpr (GATH) { _Pragma("unroll") for (int _i = 0; _i < 2; ++_i) { int _R, _C; stage_rc(tid * 16 + _i * 8192, _R, _C); \
        _Pragma("unroll") for (int _h = 0; _h < 2; ++_h) v##W[_h][_i] = (unsigned)S.arow((UN), _h * HALF + _R) * (unsigned)(K * 2) + (unsigned)_C * 2u; } } \
        else { u##W = gA + (size_t)S.arow((UN), 0) * (size_t)(K * 2); } } while (0)
#define PG8_ZERO_ACC() do { _Pragma("unroll") for (int a = 0; a < 2; ++a) _Pragma("unroll") for (int b = 0; b < 2; ++b) _Pragma("unroll") for (int m = 0; m < 4; ++m) _Pragma("unroll") for (int n = 0; n < 2; ++n) acc[a][b][m][n] = (f32x4){0.f, 0.f, 0.f, 0.f}; } while (0)
#define PG8_KPASS(k1, k2, b2, b3, W) do { \
            PG8_LDB(B0, 0, 0); PG8_LDB(B1, 0, 1); PG8_SCHED; PG8_LDA(At, 0, 0); PG8_STAGE_A(PG8_SA(1, 1), k1, cur, 1); \
            PG8_WAIT_V(8); PG8_WAIT_L(0); PG8_BAR; PG8_MMA(0, 0, At, B0); PG8_MMA(0, 1, At, B1); PG8_BAR; PG8_SCHED; \
            PG8_LDA(At, 0, 1); PG8_STAGE_B(PG8_SB(0, 0), b2); PG8_STAGE_B(PG8_SB(0, 1), (b2) + hstep); PG8_STAGE_A(PG8_SA(0, 0), k2, W, 0); \
            PG8_WAIT_V(8); PG8_WAIT_L(0); PG8_BAR; PG8_MMA(1, 0, At, B0); PG8_MMA(1, 1, At, B1); PG8_BAR; PG8_SCHED; \
            PG8_LDB(B0, 1, 0); PG8_LDB(B1, 1, 1); PG8_SCHED; PG8_LDA(At, 1, 0); PG8_STAGE_A(PG8_SA(0, 1), k2, W, 1); \
            PG8_WAIT_V(8); PG8_WAIT_L(0); PG8_BAR; PG8_MMA(0, 0, At, B0); PG8_MMA(0, 1, At, B1); PG8_BAR; PG8_SCHED; \
            PG8_LDA(At, 1, 1); PG8_STAGE_B(PG8_SB(1, 0), b3); PG8_STAGE_B(PG8_SB(1, 1), (b3) + hstep); PG8_STAGE_A(PG8_SA(1, 0), (k2) + kstep, W, 0); \
            PG8_WAIT_V(8); PG8_WAIT_L(0); PG8_BAR; PG8_MMA(1, 0, At, B0); PG8_MMA(1, 1, At, B1); PG8_BAR; PG8_SCHED; } while (0)

struct NoPre {};
template <class T, class = void> struct EpiHasPre { static constexpr bool value = false; };
template <class T> struct EpiHasPre<T, decltype((void)sizeof(typename T::Pre))> { static constexpr bool value = true; };
template <class Epi> __device__ __forceinline__ auto epi_pre(const Epi& E, const Unit& u, int wr, int wc) { if constexpr (EpiHasPre<Epi>::value) return E.pre(u, wr, wc); else return NoPre{}; }
#if !REF_GEMM
template <class Epi, class Sched, bool ALIGN_EPI>
__device__ __forceinline__ void gemm_phase(LAS unsigned char* lds, const Gemm g, const Sched& S, const Epi& E) {
    const int wid = g.wave, lane = lane_id_asm(), tid = wid * 64 + lane,
              wr = wid >> 2, wc = wid & 3, fr = lane & 15, fq = lane >> 4;
    const int K = g.K, nt = K / BK;
    constexpr bool GATH = Sched::GATHER; constexpr int NH = GATH ? 2 : 1;
    unsigned voffA[2], voffB[2];
#pragma unroll
    for (int i = 0; i < 2; ++i) { int R, C; stage_rc(tid * 16 + i * 8192, R, C); const int Rb = Epi::PERM ? ((R & ~31) + perm32(R & 31)) : R; voffA[i] = (unsigned)(R * K + C) * 2u; voffB[i] = (unsigned)(Rb * K + C) * 2u; }
    const size_t kstep = (size_t)(BK * 2);
    const size_t hstep = (size_t)HALF * K * 2;
    const size_t tstep = 2 * hstep;
    const unsigned ldsbase = (unsigned)__builtin_amdgcn_readfirstlane((int)((unsigned)(size_t)lds + (unsigned)wid * 1024u));
    const int aoff = lds_byte(wr * 64 + fr, fq * 8), boff = lds_byte(wc * 32 + fr, fq * 8);
    Unit cur, nxt; int ui = 0;
    if (!S.next(0, cur)) return;
    f32x4 acc[2][2][4][2];
    PG8_ZERO_ACC();
    i32x8 At[4], B0[2], B1[2];
    const char* gA = (const char*)g.A;
    const char* cB = (const char*)(g.Bt + (size_t)cur.e * g.strideBe) + (size_t)cur.pn * tstep;
    unsigned vcur[NH][2], vnxt[NH][2]; const char* ucur = gA; const char* unxt = gA;
    (void)vcur; (void)vnxt; (void)ucur; (void)unxt; (void)voffA;
    PG8_SETOFF(cur, cur);
    PG8_STAGE_B(PG8_SB(0, 0), cB); PG8_STAGE_B(PG8_SB(0, 1), cB + hstep); PG8_STAGE_A(PG8_SA(0, 0), 0, cur, 0); PG8_STAGE_A(PG8_SA(0, 1), 0, cur, 1);
    if (wr == 1) PG8_BAR;
    PG8_WAIT_V(2); PG8_BAR;
    PG8_STAGE_B(PG8_SB(1, 0), cB + kstep); PG8_STAGE_A(PG8_SA(1, 0), kstep, cur, 0); PG8_STAGE_B(PG8_SB(1, 1), cB + hstep + kstep);
    PG8_WAIT_V(6); PG8_BAR;
    for (;;) {
        const bool has_next = S.next(ui + 1, nxt);
        const char* nB = cB;
        if (has_next) { nB = (const char*)(g.Bt + (size_t)nxt.e * g.strideBe) + (size_t)nxt.pn * tstep;
            if constexpr (GATH) {
                const unsigned scr = (unsigned)(LM_FREE + wid * 1024 + lane * 4);
                if (ui == 0) { PG8_SETOFF(nxt, nxt); }
                else {
#pragma unroll
                    for (int _i = 0; _i < 2; ++_i) { int _R, _C; stage_rc(tid * 16 + _i * 8192, _R, _C);
#pragma unroll
                        for (int _h = 0; _h < 2; ++_h) vnxt[_h][_i] = (unsigned)(*(const LAS int*)(lds + scr + (_h * 2 + _i) * 256)) * (unsigned)(K * 2) + (unsigned)_C * 2u; }
                }
                Unit n2;
                if (S.next(ui + 2, n2)) { asm volatile("s_waitcnt lgkmcnt(0)" ::: "memory");
#pragma unroll
                    for (int _i = 0; _i < 2; ++_i) { int _R, _C; stage_rc(tid * 16 + _i * 8192, _R, _C);
#pragma unroll
                        for (int _h = 0; _h < 2; ++_h) glds_dw(uniform_ptr(S.tokbase(n2)), S.tokidx(n2, _h * HALF + _R) * 4u, (unsigned)__builtin_amdgcn_readfirstlane((int)((unsigned)(size_t)lds + (unsigned)(LM_FREE + wid * 1024 + (_h * 2 + _i) * 256)))); }
                }
            } else { PG8_SETOFF(nxt, nxt); }
        }
        else { unxt = ucur;
#pragma unroll
            for (int h = 0; h < NH; ++h)
#pragma unroll
                for (int i = 0; i < 2; ++i) vnxt[h][i] = vcur[h][i];
        }
        int t = 0;
#pragma clang loop unroll(disable)
        for (; t < nt - 2; t += 2) {
            const size_t k1 = (size_t)(t + 1) * kstep, k2 = (size_t)(t + 2) * kstep; const char* b2 = cB + k2; const char* b3 = b2 + kstep;
            PG8_KPASS(k1, k2, b2, b3, cur);
        }
        const auto pre = epi_pre(E, cur, wr, wc);
        {
            const size_t k1 = (size_t)(t + 1) * kstep; const char* b3 = nB + kstep;
            PG8_KPASS(k1, (size_t)0, nB, b3, nxt);
            cB = nB;
        }
        if constexpr (ALIGN_EPI) { if (wr == 0) PG8_BAR; }
        if constexpr (Epi::FP8) asm volatile("s_nop 15\n\ts_nop 15" ::: "memory");
        if constexpr (EpiHasPre<Epi>::value) E(acc, cur, wr, wc, fr, fq, pre); else E(acc, cur, wr, wc, fr, fq);
        if (!has_next) break;
        PG8_ZERO_ACC();
        cur = nxt; ++ui; ucur = unxt;
#pragma unroll
        for (int h = 0; h < NH; ++h)
#pragma unroll
            for (int i = 0; i < 2; ++i) vcur[h][i] = vnxt[h][i];
        if constexpr (ALIGN_EPI) { if (wr == 1) PG8_BAR; }
    }
    PG8_WAIT_V(0);
    if constexpr (!ALIGN_EPI) { if (wr == 0) PG8_BAR; }
    PG8_BAR;
}
#else
template <class Epi, class Sched, bool ALIGN_EPI>
__device__ __forceinline__ void gemm_phase(LAS unsigned char* lds, const Gemm g, const Sched& S, const Epi& E) {
    const int wid = g.wave, lane = lane_id_asm(), wr = wid >> 2, wc = wid & 3, fr = lane & 15, fq = lane >> 4;
    const int K = g.K;
    Unit u;
    for (int ui = 0; S.next(ui, u); ++ui) {
        f32x4 acc[2][2][4][2];
        const bf16_t* Bb = g.Bt + (size_t)u.e * g.strideBe + (size_t)u.pn * 256 * K;
        for (int ai = 0; ai < 2; ++ai) for (int m = 0; m < 4; ++m) {
            const bf16_t* ap = g.A + (size_t)S.arow(u, ai * 128 + wr * 64 + m * 16 + fr) * K;
            for (int bj = 0; bj < 2; ++bj) for (int n = 0; n < 2; ++n) { f32x4 r;
                for (int j = 0; j < 4; ++j) {
                    const int col = 128 * bj + 32 * wc + (Epi::PERM ? 8 * fq + 4 * n + j : 16 * n + 4 * fq + j);
                    const bf16_t* bp = Bb + (size_t)col * K; float s = 0.f;
                    for (int k = 0; k < K; k += 8) { const u32x4 a = *(const u32x4*)(ap + k), b = *(const u32x4*)(bp + k);
                        s += bf_lo(a.x) * bf_lo(b.x) + bf_hi(a.x) * bf_hi(b.x) + bf_lo(a.y) * bf_lo(b.y) + bf_hi(a.y) * bf_hi(b.y) + bf_lo(a.z) * bf_lo(b.z) + bf_hi(a.z) * bf_hi(b.z) + bf_lo(a.w) * bf_lo(b.w) + bf_hi(a.w) * bf_hi(b.w); }
                    r[j] = s; }
                acc[ai][bj][m][n] = r; } }
        E(acc, u, wr, wc, fr, fq);
    }
}
#endif

typedef const f32x4 (&AccRef)[2][2][4][2];
__device__ __forceinline__ u32x4 pack8(f32x4 v0, f32x4 v1) { u32x4 w; w.x = cvt_pk_bf16(v0[0], v0[1]); w.y = cvt_pk_bf16(v0[2], v0[3]); w.z = cvt_pk_bf16(v1[0], v1[1]); w.w = cvt_pk_bf16(v1[2], v1[3]); return w; }
#define EPI_FOR_AM for (int ai = 0; ai < 2; ++ai) _Pragma("unroll") for (int m = 0; m < 4; ++m)

__device__ __forceinline__ void rope8(f32x4& v0, f32x4& v1, const f32x2* cs  , int fq) {
    const int i0 = 8 * (fq & 1);
    const bool second = (fq & 2) != 0;
#pragma unroll
    for (int j = 0; j < 4; ++j) {
        const float o0 = __shfl_xor(v0[j], 32), o1 = __shfl_xor(v1[j], 32);
        const f32x2 c0 = cs[i0 + j], c1 = cs[i0 + 4 + j];
        v0[j] = second ? (v0[j] * c0.x + o0 * c0.y) : (v0[j] * c0.x - o0 * c0.y);
        v1[j] = second ? (v1[j] * c1.x + o1 * c1.y) : (v1[j] * c1.x - o1 * c1.y);
    }
}
__device__ __forceinline__ void rope8r(f32x4& v0, f32x4& v1, const f32x4* ct, int fq) {
    const bool second = (fq & 2) != 0;
#pragma unroll
    for (int j = 0; j < 4; ++j) {
        const float o0 = __shfl_xor(v0[j], 32), o1 = __shfl_xor(v1[j], 32);
        const float c0x = ct[j >> 1][2 * (j & 1)], c0y = ct[j >> 1][2 * (j & 1) + 1], c1x = ct[2 + (j >> 1)][2 * (j & 1)], c1y = ct[2 + (j >> 1)][2 * (j & 1) + 1];
        v0[j] = second ? (v0[j] * c0x + o0 * c0y) : (v0[j] * c0x - o0 * c0y);
        v1[j] = second ? (v1[j] * c1x + o1 * c1y) : (v1[j] * c1x - o1 * c1y);
    }
}

__device__ __forceinline__ size_t kimg(int h, int s, int cc, int NCH) { return ((((size_t)h * 256 + (s >> 6)) * NCH + cc) * 64 + (s & 63)) * 8; }
__device__ __forceinline__ size_t vimg(int h, int d, int s, int DV) { return ((((size_t)h * 256 + (s >> 6)) * 8 + ((s & 63) >> 3)) * DV + d) * 8; }
__device__ __forceinline__ size_t kimg8b(int h, int s, int c16) { return ((((size_t)h * 256 + (s >> 6)) * 8 + c16) * 64 + (s & 63)) * 16; }
__device__ __forceinline__ unsigned pack4_fp8(float a, float b, float c, float d);
__device__ __forceinline__ f32x2 lo2(const f32x4 v) { return __builtin_shufflevector(v, v, 0, 1); }
__device__ __forceinline__ f32x2 hi2(const f32x4 v) { return __builtin_shufflevector(v, v, 2, 3); }
__device__ __forceinline__ f32x4 cat2(const f32x2 a, const f32x2 b) { return __builtin_shufflevector(a, b, 0, 1, 2, 3); }
__device__ __forceinline__ f32x4 pk_fma4(const f32x4 a, const float b, const f32x4 c) { const f32x2 b2 = {b, b}; return cat2(lo2(a) * b2 + lo2(c), hi2(a) * b2 + hi2(c)); }
__device__ __forceinline__ f32x4 pk_mul4(const f32x4 a, const float b) { const f32x2 b2 = {b, b}; return cat2(lo2(a) * b2, hi2(a) * b2); }
struct EpiABIn {
    static constexpr bool PERM = true, FP8 = false;
    unsigned char* ws; float qscale;
    __device__ __forceinline__ void operator()(AccRef acc, const Unit& u, int wr, int wc, int fr, int fq) const {
        { const int l_ = lane_id_asm(); fr = l_ & 15; fq = l_ >> 4; }
        bf16_t* QA = (bf16_t*)(ws + WS_QA); bf16_t* KA = (bf16_t*)(ws + WS_KA); bf16_t* CQ = (bf16_t*)(ws + WS_CQ); bf16_t* CKV = (bf16_t*)(ws + WS_CKV); bf16_t* KB = (bf16_t*)(ws + WS_KB);
        float* SSQQ = (float*)(ws + WS_SSQQ); float* SSQKV = (float*)(ws + WS_SSQKV); const f32x2* ROPE = (const f32x2*)(ws + WS_TAB + TAB_ROPE);
        const int pn = u.pn, row0 = u.pm * 256 + wr * 64 + fr;
        if (pn < 2) {
            const int cb = (pn & 1) * 256 + wc * 32 + 8 * fq;
#pragma unroll
            EPI_FOR_AM { const int row = row0 + ai * 128 + m * 16;
#pragma unroll
                for (int bj = 0; bj < 2; ++bj) *(u32x4*)(QA + (size_t)row * 512 + cb + bj * 128) = pack8(acc[ai][bj][m][0] * qscale, acc[ai][bj][m][1] * qscale); }
        } else if (pn < 4) {
#pragma unroll
            EPI_FOR_AM { const int row = row0 + ai * 128 + m * 16;
#pragma unroll
                for (int bj = 0; bj < 2; ++bj) { const int col = (pn & 1) * 256 + bj * 128 + wc * 32 + 8 * fq; *(u32x4*)(KA + kimg(col >> 6, row, (col & 63) >> 3, 8)) = pack8(acc[ai][bj][m][0], acc[ai][bj][m][1]); } }
        } else if (pn < 7) {
            const bool isq = pn < 6; bf16_t* dst = isq ? CQ : CKV; const int ld = isq ? 512 : 256; const int cb = (isq ? (pn - 4) * 256 : 0) + wc * 32 + 8 * fq;
#pragma unroll
            EPI_FOR_AM { const int row = row0 + ai * 128 + m * 16; float s = 0.f;
#pragma unroll
                for (int bj = 0; bj < 2; ++bj) { const f32x4 a = acc[ai][bj][m][0], b = acc[ai][bj][m][1];
                    s += (a[0] * a[0] + a[1] * a[1]) + (a[2] * a[2] + a[3] * a[3]) + (b[0] * b[0] + b[1] * b[1]) + (b[2] * b[2] + b[3] * b[3]);
                    *(u32x4*)(dst + (size_t)row * ld + cb + bj * 128) = pack8(a, b); }
                s += __shfl_xor(s, 16); s += __shfl_xor(s, 32);
                if (fq == 0) { if (isq) SSQQ[(size_t)row * 8 + (pn - 4) * 4 + wc] = s; else SSQKV[(size_t)row * 4 + wc] = s; } }
        } else if (wc == 0) {
#pragma unroll
            EPI_FOR_AM rope8(const_cast<f32x4&>(acc[ai][0][m][0]), const_cast<f32x4&>(acc[ai][0][m][1]), ROPE + (size_t)(row0 + ai * 128 + m * 16) * 16, fq);
#pragma unroll
            EPI_FOR_AM { const int row = row0 + ai * 128 + m * 16; const f32x4 v0 = acc[ai][0][m][0], v1 = acc[ai][0][m][1];
                const u32x4 w = pack8(v0, v1);
#if ATT_B_FP8
                { u32x2 w8; w8.x = pack4_fp8(v0[0], v0[1], v0[2], v0[3]); w8.y = pack4_fp8(v1[0], v1[1], v1[2], v1[3]); const u32x2 z8 = {0u, 0u};
#pragma unroll
                  for (int h = 0; h < 8; ++h) { unsigned char* kp = (unsigned char*)KB + kimg8b(h, row, 4 + (fq >> 1)) + 8 * (fq & 1); *(u32x2*)kp = w8; *(u32x2*)(kp + 2 * 1024) = z8; } }
                (void)w; }
#else
#pragma unroll
                for (int h = 0; h < 8; ++h) *(u32x4*)(KB + kimg(h, row, 8 + fq, 12)) = w; }
#endif
        }
    }
};
template <int DV, int NP> struct EpiVt {
    static constexpr bool PERM = true, FP8 = false;
    bf16_t* Vt; const float* ssq; float inv_n;
    __device__ __forceinline__ void operator()(AccRef acc, const Unit& u, int wr, int wc, int fr, int fq) const {
        { const int l_ = lane_id_asm(); fr = l_ & 15; fq = l_ >> 4; }
        float sc[2][8];
#pragma unroll
        for (int bj = 0; bj < 2; ++bj)
#pragma unroll
            for (int j = 0; j < 8; ++j) { sc[bj][j] = 1.0f;
                if (NP > 0) { const int tok = u.pn * 256 + bj * 128 + wc * 32 + 8 * fq + j; float s = 0.f;
#pragma unroll
                    for (int p = 0; p < (NP > 0 ? NP : 1); ++p) s += ssq[(size_t)tok * NP + p];
                    sc[bj][j] = 1.0f / sqrtf(s * inv_n + RMS_EPS); } }
#pragma unroll
        EPI_FOR_AM { const int f = u.pm * 256 + ai * 128 + wr * 64 + m * 16 + fr, h = f / DV, d = f % DV;
#pragma unroll
            for (int bj = 0; bj < 2; ++bj) { const int tok = u.pn * 256 + bj * 128 + wc * 32 + 8 * fq; f32x4 a = acc[ai][bj][m][0], b = acc[ai][bj][m][1];
                if (NP > 0) { a[0] *= sc[bj][0]; a[1] *= sc[bj][1]; a[2] *= sc[bj][2]; a[3] *= sc[bj][3]; b[0] *= sc[bj][4]; b[1] *= sc[bj][5]; b[2] *= sc[bj][6]; b[3] *= sc[bj][7]; }
                *(u32x4*)(Vt + vimg(h, d, tok, DV)) = pack8(a, b); } }
    }
};
struct EpiQUp {
    static constexpr bool PERM = true, FP8 = false;
    unsigned char* ws; float qscale;
    __device__ __forceinline__ void operator()(AccRef acc, const Unit& u, int wr, int wc, int fr, int fq) const {
        { const int l_ = lane_id_asm(); fr = l_ & 15; fq = l_ >> 4; }
        bf16_t* QB = (bf16_t*)(ws + WS_QB); const float* SSQQ = (const float*)(ws + WS_SSQQ); const f32x2* ROPE = (const f32x2*)(ws + WS_TAB + TAB_ROPE);
        float rqv[2][4];
#pragma unroll
        EPI_FOR_AM { const int row = u.pm * 256 + ai * 128 + wr * 64 + m * 16 + fr;
            const f32x4 p0 = *(const f32x4*)(SSQQ + (size_t)row * 8), p1 = *(const f32x4*)(SSQQ + (size_t)row * 8 + 4);
            const float ss = ((p0[0] + p0[1]) + (p0[2] + p0[3])) + ((p1[0] + p1[1]) + (p1[2] + p1[3]));
            rqv[ai][m] = qscale / sqrtf(ss * (1.0f / 512.0f) + RMS_EPS); }
#pragma unroll
        EPI_FOR_AM { const int row = u.pm * 256 + ai * 128 + wr * 64 + m * 16 + fr;
#pragma unroll
            for (int bj = 0; bj < 2; ++bj) { const int g32 = u.pn * 8 + bj * 4 + wc; if (g32 % 3 == 2) rope8(const_cast<f32x4&>(acc[ai][bj][m][0]), const_cast<f32x4&>(acc[ai][bj][m][1]), ROPE + (size_t)row * 16, fq); } }
#pragma unroll
        EPI_FOR_AM { const int row = u.pm * 256 + ai * 128 + wr * 64 + m * 16 + fr; const float rq = rqv[ai][m];
#pragma unroll
            for (int bj = 0; bj < 2; ++bj) { const int g32 = u.pn * 8 + bj * 4 + wc; const f32x4 a = acc[ai][bj][m][0] * rq, b = acc[ai][bj][m][1] * rq;
                *(u32x4*)(QB + (size_t)row * 768 + g32 * 32 + 8 * fq) = pack8(a, b); } }
    }
};
struct EpiKUp {
    static constexpr bool PERM = true, FP8 = false;
    unsigned char* ws;
    __device__ __forceinline__ void operator()(AccRef acc, const Unit& u, int wr, int wc, int fr, int fq) const {
        { const int l_ = lane_id_asm(); fr = l_ & 15; fq = l_ >> 4; }
        bf16_t* KB = (bf16_t*)(ws + WS_KB); const float* SSQKV = (const float*)(ws + WS_SSQKV);
        float rkv[2][4];
#pragma unroll
        EPI_FOR_AM { const int row = u.pm * 256 + ai * 128 + wr * 64 + m * 16 + fr; const f32x4 p0 = *(const f32x4*)(SSQKV + (size_t)row * 4);
            rkv[ai][m] = 1.0f / sqrtf(((p0[0] + p0[1]) + (p0[2] + p0[3])) * (1.0f / 256.0f) + RMS_EPS); }
#pragma unroll
        EPI_FOR_AM { const int row = u.pm * 256 + ai * 128 + wr * 64 + m * 16 + fr; const float rk = rkv[ai][m];
#pragma unroll
            for (int bj = 0; bj < 2; ++bj) { const int col = u.pn * 256 + bj * 128 + wc * 32 + 8 * fq, h = col >> 6, d = col & 63;
#if ATT_B_FP8
                { const f32x4 a = acc[ai][bj][m][0] * rk, b = acc[ai][bj][m][1] * rk; u32x2 w8; w8.x = pack4_fp8(a[0], a[1], a[2], a[3]); w8.y = pack4_fp8(b[0], b[1], b[2], b[3]);
                  *(u32x2*)((unsigned char*)KB + kimg8b(h, row, d >> 4) + (d & 15)) = w8; } } }
#else
                *(u32x4*)(KB + kimg(h, row, d >> 3, 12)) = pack8(acc[ai][bj][m][0] * rk, acc[ai][bj][m][1] * rk); } }
#endif
    }
};
struct EpiBf16Split {
    static constexpr bool PERM = true, FP8 = false;
    bf16_t* O; int ldc; int split; size_t stride; float scale0;
    __device__ __forceinline__ void operator()(AccRef acc, const Unit& u, int wr, int wc, int fr, int fq) const {
        { const int l_ = lane_id_asm(); fr = l_ & 15; fq = l_ >> 4; }
        int colt = u.pn * 256; bf16_t* base = O; float sc = 1.0f;
        { const int t = colt / split; base += (size_t)t * stride; colt -= t * split; if (t == 0) sc = scale0; }
#pragma unroll
        EPI_FOR_AM { const int row = u.pm * 256 + ai * 128 + wr * 64 + m * 16 + fr;
#pragma unroll
            for (int bj = 0; bj < 2; ++bj) *(u32x4*)(base + (size_t)row * ldc + colt + bj * 128 + wc * 32 + 8 * fq) = pack8(acc[ai][bj][m][0] * sc, acc[ai][bj][m][1] * sc); }
    }
};
__device__ __forceinline__ unsigned pack4_fp8(float a, float b, float c, float d);
struct EpiCIn {
    static constexpr bool PERM = true, FP8 = false;
    unsigned char* ws; float qscale;
    __device__ __forceinline__ void operator()(AccRef acc, const Unit& u, int wr, int wc, int fr, int fq) const {
        { const int l_ = lane_id_asm(); fr = l_ & 15; fq = l_ >> 4; }
        bf16_t* QC = (bf16_t*)(ws + WS_QC); bf16_t* KC = (bf16_t*)(ws + WS_KC);
#pragma unroll
        EPI_FOR_AM { const int row = u.pm * 256 + ai * 128 + wr * 64 + m * 16 + fr;
#pragma unroll
            for (int bj = 0; bj < 2; ++bj) { const int col = (u.pn & 3) * 256 + bj * 128 + wc * 32 + 8 * fq;
                if (u.pn < 4) *(u32x4*)(QC + (size_t)row * D + col) = pack8(acc[ai][bj][m][0] * qscale, acc[ai][bj][m][1] * qscale);
                else {
#if ATT_C_FP8
                    const int h = col >> 7, dd = col & 127, sb = dd >> 6, d = dd & 63;
                    unsigned char* kp = (unsigned char*)KC + (((((size_t)h * 256 + (row >> 6)) * 2 + sb) * 4 + (d >> 4)) * 64 + (row & 63)) * 16 + (d & 15);
                    const f32x4 a = acc[ai][bj][m][0], b = acc[ai][bj][m][1]; u32x2 w; w.x = pack4_fp8(a[0], a[1], a[2], a[3]); w.y = pack4_fp8(b[0], b[1], b[2], b[3]); *(u32x2*)kp = w;
#else
                    *(u32x4*)(KC + kimg(col >> 7, row, (col & 127) >> 3, 16)) = pack8(acc[ai][bj][m][0], acc[ai][bj][m][1]);
#endif
                } } }
    }
};
__device__ __forceinline__ void unpack8(const u32x4 w, f32x4& a, f32x4& b) { a[0] = bf_lo(w.x); a[1] = bf_hi(w.x); a[2] = bf_lo(w.y); a[3] = bf_hi(w.y); b[0] = bf_lo(w.z); b[1] = bf_hi(w.z); b[2] = bf_lo(w.w); b[3] = bf_hi(w.w); }
template <bool XF32> struct EpiResid {
    static constexpr bool PERM = true, FP8 = false;
    const void* X; bf16_t* Z;
    __device__ __forceinline__ void operator()(AccRef acc, const Unit& u, int wr, int wc, int fr, int fq) const {
        { const int l_ = lane_id_asm(); fr = l_ & 15; fq = l_ >> 4; }
        if constexpr (XF32) {
#pragma unroll
            for (int ai = 0; ai < 2; ++ai) { f32x4 xf[4][2][2];
#pragma unroll
                for (int m = 0; m < 4; ++m)
#pragma unroll
                    for (int bj = 0; bj < 2; ++bj) { const size_t o = (size_t)(u.pm * 256 + ai * 128 + wr * 64 + m * 16 + fr) * D + u.pn * 256 + wc * 32 + 8 * fq + bj * 128;
                        xf[m][bj][0] = *(const f32x4*)((const float*)X + o); xf[m][bj][1] = *(const f32x4*)((const float*)X + o + 4); }
#pragma unroll
                for (int m = 0; m < 4; ++m)
#pragma unroll
                    for (int bj = 0; bj < 2; ++bj) { const size_t o = (size_t)(u.pm * 256 + ai * 128 + wr * 64 + m * 16 + fr) * D + u.pn * 256 + wc * 32 + 8 * fq + bj * 128;
                        *(u32x4*)(Z + o) = pack8(pk_fma4(xf[m][bj][0], DN_ALPHA, acc[ai][bj][m][0]), pk_fma4(xf[m][bj][1], DN_ALPHA, acc[ai][bj][m][1])); } }
        } else {
            u32x4 xr[2][4][2];
#pragma unroll
            EPI_FOR_AM { const size_t off = (size_t)(u.pm * 256 + ai * 128 + wr * 64 + m * 16 + fr) * D + u.pn * 256 + wc * 32 + 8 * fq;
#pragma unroll
                for (int bj = 0; bj < 2; ++bj) xr[ai][m][bj] = *(const u32x4*)((const bf16_t*)X + off + bj * 128); }
#pragma unroll
            EPI_FOR_AM { const size_t off = (size_t)(u.pm * 256 + ai * 128 + wr * 64 + m * 16 + fr) * D + u.pn * 256 + wc * 32 + 8 * fq;
#pragma unroll
                for (int bj = 0; bj < 2; ++bj) { const size_t o = off + bj * 128; f32x4 xa, xb; unpack8(xr[ai][m][bj], xa, xb);
                    *(u32x4*)(Z + o) = pack8(pk_fma4(xa, DN_ALPHA, acc[ai][bj][m][0]), pk_fma4(xb, DN_ALPHA, acc[ai][bj][m][1])); } }
        }
    }
};
struct EpiPle {
    static constexpr bool PERM = true, FP8 = (MOE_FP8 != 0);
    const bf16_t* X1; const bf16_t* PP; bf16_t* Z2;
    __device__ __forceinline__ void operator()(AccRef acc, const Unit& u, int wr, int wc, int fr, int fq) const {
        { const int l_ = lane_id_asm(); fr = l_ & 15; fq = l_ >> 4; }
#pragma unroll
        for (int ai = 0; ai < 2; ++ai) { u32x4 xr[4][2], pr[4][2];
#pragma unroll
            for (int m = 0; m < 4; ++m)
#pragma unroll
                for (int bj = 0; bj < 2; ++bj) { const size_t o = (size_t)(u.pm * 256 + ai * 128 + wr * 64 + m * 16 + fr) * D + u.pn * 256 + wc * 32 + 8 * fq + bj * 128;
                    xr[m][bj] = *(const u32x4*)(X1 + o); pr[m][bj] = *(const u32x4*)(PP + o); }
#pragma unroll
            for (int m = 0; m < 4; ++m)
#pragma unroll
                for (int bj = 0; bj < 2; ++bj) { const size_t o = (size_t)(u.pm * 256 + ai * 128 + wr * 64 + m * 16 + fr) * D + u.pn * 256 + wc * 32 + 8 * fq + bj * 128;
                    f32x4 xa, xb, pa, pb; unpack8(xr[m][bj], xa, xb); unpack8(pr[m][bj], pa, pb);
                    constexpr float asc = FP8 ? 1.0f / 32.0f : 1.0f; f32x4 ra, rb;
                    { const f32x2 c2 = {-asc * LOG2E, -asc * LOG2E}, one2 = {1.0f, 1.0f}, al2 = {DN_ALPHA, DN_ALPHA};
#define PLE_HALF(accv, xv, pv, outv, H) do { const f32x2 t_ = (H ? hi2(accv) : lo2(accv)) * c2; const f32x2 d_ = (f32x2){fast_exp2(t_[0]), fast_exp2(t_[1])} + one2; \
                        const f32x2 r_ = {fast_rcp(d_[0]), fast_rcp(d_[1])}; const f32x2 q_ = (H ? hi2(xv) : lo2(xv)) * al2 + r_ * (H ? hi2(pv) : lo2(pv)); outv[2 * H] = q_[0]; outv[2 * H + 1] = q_[1]; } while (0)
                      PLE_HALF(acc[ai][bj][m][0], xa, pa, ra, 0); PLE_HALF(acc[ai][bj][m][0], xa, pa, ra, 1); PLE_HALF(acc[ai][bj][m][1], xb, pb, rb, 0); PLE_HALF(acc[ai][bj][m][1], xb, pb, rb, 1);
#undef PLE_HALF
                    }
                    *(u32x4*)(Z2 + o) = pack8(ra, rb); } }
    }
};
constexpr float W1_SCALE = 32.0f, W2_SCALE = 64.0f, H_SCALE = 4.0f;
__device__ __forceinline__ unsigned pack4_fp8(float a, float b, float c, float d) { int w = __builtin_amdgcn_cvt_pk_fp8_f32(a, b, 0, false); w = __builtin_amdgcn_cvt_pk_fp8_f32(c, d, w, true); return (unsigned)w; }
struct EpiMoeAct {
    static constexpr bool PERM = true, FP8 = (MOE_FP8 != 0);
    unsigned char* Hs; const float* bin;
    struct Pre { f32x4 g0, g1, l0, l1; };
    __device__ __forceinline__ Pre pre(const Unit& u, int wr, int wc) const { const int fq = lane_id_asm() >> 4; const float* bg = bin + (size_t)u.e * 2048 + u.pn * 128 + wc * 32 + 8 * fq;
        Pre p; p.g0 = *(const f32x4*)bg; p.g1 = *(const f32x4*)(bg + 4); p.l0 = *(const f32x4*)(bg + 1024); p.l1 = *(const f32x4*)(bg + 1028); return p; }
    __device__ __forceinline__ void operator()(AccRef acc, const Unit& u, int wr, int wc, int fr, int fq, const Pre& pr) const {
        { const int l_ = lane_id_asm(); fr = l_ & 15; fq = l_ >> 4; }
        const int cl = u.pn * 128 + wc * 32 + 8 * fq;
        const f32x4 g0 = pr.g0, g1 = pr.g1, l0 = pr.l0, l1 = pr.l1;
        constexpr float asc = FP8 ? 1.0f / W1_SCALE : 1.0f, osc = FP8 ? H_SCALE : 1.0f;
#pragma unroll
        EPI_FOR_AM { const int row = u.pm * 256 + ai * 128 + wr * 64 + m * 16 + fr; f32x4 o[2];
#pragma unroll
            for (int n = 0; n < 2; ++n) { const f32x4 ag = acc[ai][0][m][n], al = acc[ai][1][m][n], bg = n ? g1 : g0, bl = n ? l1 : l0;
#pragma unroll
                for (int h = 0; h < 2; ++h) {
                    const f32x2 a2 = {asc, asc}, o2 = {osc, osc}, c2 = {-1.702f * LOG2E, -1.702f * LOG2E}, one2 = {1.0f, 1.0f};
                    const f32x2 hg = (f32x2){ag[2 * h], ag[2 * h + 1]} * a2 + (f32x2){bg[2 * h], bg[2 * h + 1]}, hl = (f32x2){al[2 * h], al[2 * h + 1]} * a2 + (f32x2){bl[2 * h], bl[2 * h + 1]};
                    const f32x2 glu = {fminf(hg[0], 7.0f), fminf(hg[1], 7.0f)}, lin = {fminf(fmaxf(hl[0], -7.0f), 7.0f), fminf(fmaxf(hl[1], -7.0f), 7.0f)};
                    const f32x2 t = glu * c2; const f32x2 d = (f32x2){fast_exp2(t[0]), fast_exp2(t[1])} + one2; const f32x2 r = {fast_rcp(d[0]), fast_rcp(d[1])};
                    const f32x2 res = (glu * r) * (lin * o2 + o2);
                    o[n][2 * h] = res[0]; o[n][2 * h + 1] = res[1]; } }
            if constexpr (FP8) { u32x2 w; w.x = pack4_fp8(o[0][0], o[0][1], o[0][2], o[0][3]); w.y = pack4_fp8(o[1][0], o[1][1], o[1][2], o[1][3]); *(u32x2*)(Hs + (size_t)row * 1024 + cl) = w; }
            else *(u32x4*)((bf16_t*)Hs + (size_t)row * 1024 + cl) = pack8(o[0], o[1]); }
    }
};
struct EpiMoeDown {
    static constexpr bool PERM = true, FP8 = (MOE_FP8 != 0);
    bf16_t* Ys; const float* bout; const float* GATE;
    struct Pre { f32x4 bv[2][2]; float gtv[2][4]; };
    __device__ __forceinline__ Pre pre(const Unit& u, int wr, int wc) const { const int l_ = lane_id_asm(), fr = l_ & 15, fq = l_ >> 4; Pre p;
#pragma unroll
        for (int bj = 0; bj < 2; ++bj)
#pragma unroll
            for (int n = 0; n < 2; ++n) p.bv[bj][n] = *(const f32x4*)(bout + (size_t)u.e * 1024 + u.pn * 256 + bj * 128 + wc * 32 + 8 * fq + 4 * n);
#pragma unroll
        EPI_FOR_AM p.gtv[ai][m] = GATE[(size_t)u.e * S + u.aux * 256 + ai * 128 + wr * 64 + m * 16 + fr];
        return p; }
    __device__ __forceinline__ void operator()(AccRef acc, const Unit& u, int wr, int wc, int fr, int fq, const Pre& pr) const {
        { const int l_ = lane_id_asm(); fr = l_ & 15; fq = l_ >> 4; }
        constexpr float asc = FP8 ? 1.0f / (W2_SCALE * H_SCALE) : 1.0f;
        f32x4 bv[2][2];
#pragma unroll
        for (int bj = 0; bj < 2; ++bj)
#pragma unroll
            for (int n = 0; n < 2; ++n) bv[bj][n] = pr.bv[bj][n];
#pragma unroll
        EPI_FOR_AM { const int rl = ai * 128 + wr * 64 + m * 16 + fr; const float gt = pr.gtv[ai][m];
#pragma unroll
            for (int bj = 0; bj < 2; ++bj) *(u32x4*)(Ys + (size_t)(u.pm * 256 + rl) * 1024 + u.pn * 256 + bj * 128 + wc * 32 + 8 * fq) = pack8(pk_mul4(pk_fma4(acc[ai][bj][m][0], asc, bv[bj][0]), gt), pk_mul4(pk_fma4(acc[ai][bj][m][1], asc, bv[bj][1]), gt)); }
    }
};
template <bool GATHER_> struct MoeOrder {
    static constexpr bool GATHER = GATHER_;
    const LAS int* toff; const LAS int* cnt; const LAS int* t2e; const int* TOK; int NT, G, c;
    __device__ __forceinline__ bool next(int i, Unit& u) const {
        const int L = i * G + c; const int total = toff[32] * NT; if (L >= total) return false;
        const int tile = L / NT; u.pn = L - tile * NT; const int e = t2e[tile];
        u.pm = tile; u.e = e; u.aux = tile - toff[e]; return true;
    }
    __device__ __forceinline__ const int* tokbase(const Unit& u) const { return TOK + (size_t)u.e * S; }
    __device__ __forceinline__ unsigned tokidx(const Unit& u, int r) const { const int pos = u.aux * 256 + r; return (unsigned)(pos < cnt[u.e] ? pos : 0); }
    __device__ __forceinline__ int arow(const Unit& u, int r) const {
        if (!GATHER) return u.pm * 256 + r;
        const int pos = u.aux * 256 + r; const int* base = TOK + (size_t)u.e * S; return base[pos < cnt[u.e] ? pos : 0];
    }
};
}

namespace fa {
typedef float f32x16 __attribute__((ext_vector_type(16)));
template <int TYPE> struct Cfg;
template <> struct Cfg<0> { static constexpr int DQK = 64, DV = 64,  NSUB = 1, UROWS = 256, NKP = 1, NVP = 1, DQ8 = 64; static constexpr bool K8 = false; };
template <> struct Cfg<1> { static constexpr int DQK = 96, DV = 64,  NSUB = 1, UROWS = 256, NKP = (ATT_B_FP8 ? 1 : 2), NVP = 1, DQ8 = 128; static constexpr bool K8 = (ATT_B_FP8 != 0); };
template <> struct Cfg<2> { static constexpr int DQK = 64, DV = 128, NSUB = 2, UROWS = 128, NKP = (ATT_C_FP8 ? 1 : 2), NVP = 2, DQ8 = 64; static constexpr bool K8 = (ATT_C_FP8 != 0); };
constexpr float THR = 8.0f;
struct Desc { const bf16_t* Q; const bf16_t* K; const bf16_t* Vt; bf16_t* O; int ldq, ldk; int q0; const float* btab; float far; float lam, omli; const float* subln; };

__device__ __forceinline__ float pair_max(float v) { auto rr = __builtin_amdgcn_permlane32_swap(__float_as_uint(v), __float_as_uint(v), false, false); return fmaxf(__uint_as_float(rr[0]), __uint_as_float(rr[1])); }
__device__ __forceinline__ float pair_sum(float v) { auto rr = __builtin_amdgcn_permlane32_swap(__float_as_uint(v), __float_as_uint(v), false, false); return __uint_as_float(rr[0]) + __uint_as_float(rr[1]); }
__device__ __forceinline__ float max3f(float a, float b, float c) { return fmaxf(fmaxf(a, b), c); }
typedef __bf16 bf16x2_t __attribute__((ext_vector_type(2)));
__device__ __forceinline__ unsigned cvtpk_n(float lo, float hi) { f32x2 v = {lo, hi}; bf16x2_t b = __builtin_convertvector(v, bf16x2_t); return __builtin_bit_cast(unsigned, b); }
__device__ __forceinline__ bf16x8 pack_p(const f32x16& p, int b) { u32x4 w; w.x = cvtpk_n(p[b], p[b + 1]); w.y = cvtpk_n(p[b + 2], p[b + 3]); w.z = cvtpk_n(p[b + 4], p[b + 5]); w.w = cvtpk_n(p[b + 6], p[b + 7]); return __builtin_bit_cast(bf16x8, w); }
#define FA_WAITBAR(N) asm volatile("s_waitcnt vmcnt(" #N ") lgkmcnt(0)\n\ts_barrier" ::: "memory")

template <int TYPE, bool OPT>
__device__ __forceinline__ bool attn_unit(LAS unsigned char* lds, const int wave, const Desc ds) {
    typedef Cfg<TYPE> C;
    constexpr int DQK = C::DQK, DV = C::DV, KCH = C::K8 ? C::DQ8 / 16 : DQK / 8  , NQ8 = C::DQ8 / 64, KBYTES = C::NSUB * KCH * 1024, VBYTES = DV * 128, KRING = 0, VRING = 3 * KBYTES, NPW = C::NKP + C::NVP;
    constexpr int ND0 = DQK / 16, NDB = DV / 32, XCH = 0;
    const int lane = lane_id_asm(), q = lane & 31, hi = lane >> 5;
    const int rb = (TYPE == 2) ? (wave & 3) : wave, sub = (TYPE == 2) ? (wave >> 2) : 0;
    const int c0 = ds.q0 >> 6, T1 = c0 + C::UROWS / 64 - 1, T0 = (TYPE == 0) ? (c0 > 8 ? c0 - 8 : 0) : 0;
    const int cw = (ds.q0 + 32 * rb) >> 6, a_hi = cw, a_lo = (TYPE == 0) ? (cw > 8 ? cw - 8 : 0) : 0, near_lo = (TYPE == 1) ? (1 << 30) : cw - 2;
    const int qpos = ds.q0 + 32 * rb + q;
    const unsigned ldsb = (unsigned)(size_t)lds;
    int kdst[C::NKP], vdst[C::NVP]; const unsigned dvoff = (unsigned)lane * 16u;
#pragma unroll
    for (int i = 0; i < C::NKP; ++i) { int idx = wave + 8 * i; if (idx >= C::NSUB * KCH) idx -= C::NSUB * KCH; kdst[i] = idx * 1024; }
#pragma unroll
    for (int i = 0; i < C::NVP; ++i) vdst[i] = (wave + 8 * i) * 1024;
#define FA_ISSUE_K(u, slot) do { _Pragma("unroll") for (int _i = 0; _i < C::NKP; ++_i) \
        pg8::glds_sv(pg8::uniform_ptr((const char*)ds.K + (size_t)(u) * KBYTES + kdst[_i]), dvoff, (unsigned)__builtin_amdgcn_readfirstlane((int)(ldsb + KRING + (slot) * KBYTES + kdst[_i]))); } while (0)
#define FA_ISSUE_V(u, slot) do { _Pragma("unroll") for (int _i = 0; _i < C::NVP; ++_i) \
        pg8::glds_sv(pg8::uniform_ptr((const char*)ds.Vt + (size_t)(u) * VBYTES + vdst[_i]), dvoff, (unsigned)__builtin_amdgcn_readfirstlane((int)(ldsb + VRING + (slot) * VBYTES + vdst[_i]))); } while (0)
    const int pi = (q & ~12) | ((q & 4) << 1) | ((q & 8) >> 1);
    const int kfo = KRING + (C::K8 ? hi * 2048 : hi * 1024) + pi * 16 + sub * KCH * 1024, vfo = VRING + hi * DV * 16 + q * 16;
    FA_WAITBAR(0);
    if (TYPE != 1) { const int tid = wave * 64 + lane; if (tid < 256) *(LAS float*)(lds + LM_FREE + tid * 4) = ds.btab[tid] - ds.far; }
    FA_ISSUE_K(T0, 0); if (T0 + 1 <= T1) FA_ISSUE_K(T0 + 1, 1);
    bf16x8 qf[ND0]; pg8::i32x8 qf8[NQ8]; (void)qf8;
    if constexpr (C::K8) {
#pragma unroll
        for (int o8 = 0; o8 < NQ8; ++o8) { const int dbase = 64 * o8 + 32 * hi; const bf16_t* qp = ds.Q + (size_t)qpos * ds.ldq + sub * 64 + dbase;
#pragma unroll
            for (int j = 0; j < 4; ++j) { u32x4 w = {0u, 0u, 0u, 0u}; if (dbase + 8 * j < DQK) w = *(const u32x4*)(qp + 8 * j);
                qf8[o8][2 * j]     = (int)pg8::pack4_fp8(bf_lo(w.x) * 8.f, bf_hi(w.x) * 8.f, bf_lo(w.y) * 8.f, bf_hi(w.y) * 8.f);
                qf8[o8][2 * j + 1] = (int)pg8::pack4_fp8(bf_lo(w.z) * 8.f, bf_hi(w.z) * 8.f, bf_lo(w.w) * 8.f, bf_hi(w.w) * 8.f); } }
#pragma unroll
        for (int d0 = 0; d0 < ND0; ++d0) qf[d0] = bf16x8{};
    } else { const bf16_t* qp = ds.Q + (size_t)qpos * ds.ldq + sub * 64 + 8 * hi;
#pragma unroll
      for (int d0 = 0; d0 < ND0; ++d0) qf[d0] = *(const bf16x8*)(qp + 16 * d0); }
    f32x16 o[NDB];
#pragma unroll
    for (int db = 0; db < NDB; ++db) o[db] = f32x16{};
    f32x16 negm = f32x16{}; float m = 0.f, l = 0.f, fsc = 1.f; bool resc = false;
    f32x16 sA0 = f32x16{}, sA1 = f32x16{}, sB0 = f32x16{}, sB1 = f32x16{};
    bf16x8 pa[4], pb[4];
#pragma unroll
    for (int i = 0; i < 4; ++i) { pa[i] = bf16x8{}; pb[i] = bf16x8{}; }
    int s0 = 2;
#define FA_QK8_1(kb_, ka_, o8_, CIN) __builtin_amdgcn_mfma_scale_f32_32x32x64_f8f6f4(pg8::ld_pair(lds + (ka_) + (o8_) * 4096 + (kb_) * 512), qf8[o8_], CIN, 0, 0, 0, 0x7F7F7F7F, 0, 0x7C7C7C7C)
#define FA_QK8(kb_, ka_, CIN) (NQ8 == 1 ? FA_QK8_1(kb_, ka_, 0, CIN) : FA_QK8_1(kb_, ka_, NQ8 - 1, FA_QK8_1(kb_, ka_, 0, CIN)))
#define FA_QK(SN0, SN1) do { const int ka_ = kfo + ((s0 + 1) % 3) * KBYTES; \
        if constexpr (C::K8) { SN0 = FA_QK8(0, ka_, negm); SN1 = FA_QK8(1, ka_, negm); } else \
        _Pragma("unroll") for (int d0 = 0; d0 < ND0; ++d0) { const bf16x8 k0_ = *(const LAS bf16x8*)(lds + ka_ + d0 * 2048), k1_ = *(const LAS bf16x8*)(lds + ka_ + d0 * 2048 + 512); \
            SN0 = __builtin_amdgcn_mfma_f32_32x32x16_bf16(k0_, qf[d0], d0 == 0 ? negm : SN0, 0, 0, 0); SN1 = __builtin_amdgcn_mfma_f32_32x32x16_bf16(k1_, qf[d0], d0 == 0 ? negm : SN1, 0, 0, 0); } } while (0)
#define FA_ROWMAX(SC0, SC1, rm) do { float a_ = max3f(SC0[0], SC0[1], SC1[0]), b_ = max3f(SC0[2], SC0[3], SC1[1]); a_ = max3f(a_, SC1[2], SC1[3]); \
        _Pragma("unroll") for (int r = 4; r < 16; r += 4) { a_ = max3f(a_, SC0[r], SC0[r + 1]); b_ = max3f(b_, SC0[r + 2], SC0[r + 3]); a_ = max3f(a_, SC1[r], SC1[r + 1]); b_ = max3f(b_, SC1[r + 2], SC1[r + 3]); } \
        rm = pair_max(fmaxf(a_, b_)); } while (0)
#define FA_RESCALE_A(SC0, SC1, SN0, SN1, dl, HAVE_N) do { m += dl; \
        _Pragma("unroll") for (int r = 0; r < 16; ++r) { SC0[r] -= dl; SC1[r] -= dl; } \
        if (HAVE_N) { _Pragma("unroll") for (int r = 0; r < 16; ++r) { SN0[r] -= dl; SN1[r] -= dl; } } \
        _Pragma("unroll") for (int r = 0; r < 16; ++r) negm[r] = -m; \
        fsc = fast_exp2(-dl); l *= fsc; resc = true; } while (0)
#define FA_EXP(SC0, SC1, PC) do { \
        _Pragma("unroll") for (int r = 0; r < 16; ++r) { SC0[r] = fast_exp2(SC0[r]); SC1[r] = fast_exp2(SC1[r]); } \
        float s_ = 0.f, s2_ = 0.f, s3_ = 0.f, s4_ = 0.f; \
        _Pragma("unroll") for (int r = 0; r < 16; r += 2) { s_ += SC0[r]; s2_ += SC1[r]; s3_ += SC0[r + 1]; s4_ += SC1[r + 1]; } \
        l += (s_ + s2_) + (s3_ + s4_); \
        PC[0] = pack_p(SC0, 0); PC[1] = pack_p(SC0, 8); PC[2] = pack_p(SC1, 0); PC[3] = pack_p(SC1, 8); } while (0)
#define FA_PV(PP) do { const int va_ = vfo + ((s0 + 2) % 3) * VBYTES; \
        _Pragma("unroll") for (int ks = 0; ks < 4; ++ks) _Pragma("unroll") for (int db = 0; db < NDB; ++db) { const bf16x8 v_ = *(const LAS bf16x8*)(lds + va_ + ks * DV * 32 + db * 512); \
            o[db] = __builtin_amdgcn_mfma_f32_32x32x16_bf16(v_, PP[ks], o[db], 0, 0, 0); } } while (0)
#define FA_RESCALE_B() do { if (resc) { _Pragma("unroll") for (int db = 0; db < NDB; ++db) _Pragma("unroll") for (int r = 0; r < 16; ++r) o[db][r] *= fsc; resc = false; } } while (0)
#define FA_BIAS(SC0, SC1, t) do { const int bb_ = LM_FREE + (64 * (t) + 8 * hi - qpos + 192) * 4; \
        _Pragma("unroll") for (int r = 0; r < 16; ++r) { SC0[r] += *(const LAS float*)(lds + bb_ + (16 * (r >> 3) + (r & 7)) * 4); SC1[r] += *(const LAS float*)(lds + bb_ + (32 + 16 * (r >> 3) + (r & 7)) * 4); } } while (0)
#define FA_SB() __builtin_amdgcn_sched_barrier(0)
#define FA_X(SC0, SC1, e) ((e) < 16 ? SC0[(e) & 15] : SC1[(e) & 15])
#ifndef FA_FD
#define FA_FD 4
#endif
#define FA_QK_MAX(SC0, SC1, SN0, SN1, rm) do { const int ka_ = kfo + ((s0 + 1) % 3) * KBYTES; constexpr int NQ_ = 2 * ND0, VPC_ = (32 + NQ_ - 1) / NQ_, FD_ = FA_FD; \
        if constexpr (C::K8) { const f32x16 z8_ = f32x16{}; SN0 = FA_QK8(0, ka_, z8_); SN1 = FA_QK8(1, ka_, z8_); \
            if (__builtin_expect(__any(m != 0.f), 0)) { _Pragma("unroll") for (int r = 0; r < 16; ++r) { SN0[r] -= m; SN1[r] -= m; } } \
            FA_ROWMAX(SC0, SC1, rm); } else { \
        bf16x8 kf_[FD_]; _Pragma("unroll") for (int j_ = 0; j_ < FD_ - 1; ++j_) kf_[j_] = *(const LAS bf16x8*)(lds + ka_ + (j_ >> 1) * 2048 + (j_ & 1) * 512); \
        float a_ = -3.0e38f, b_ = -3.0e38f; const f32x16 z_ = f32x16{}; \
        _Pragma("unroll") for (int i_ = 0; i_ < NQ_; ++i_) { const int d0_ = i_ >> 1, kb_ = i_ & 1; \
            if (i_ + FD_ - 1 < NQ_) kf_[(i_ + FD_ - 1) % FD_] = *(const LAS bf16x8*)(lds + ka_ + ((i_ + FD_ - 1) >> 1) * 2048 + ((i_ + FD_ - 1) & 1) * 512); \
            if (kb_ == 0) SN0 = __builtin_amdgcn_mfma_f32_32x32x16_bf16(kf_[i_ % FD_], qf[d0_], d0_ == 0 ? z_ : SN0, 0, 0, 0); \
            else          SN1 = __builtin_amdgcn_mfma_f32_32x32x16_bf16(kf_[i_ % FD_], qf[d0_], d0_ == 0 ? z_ : SN1, 0, 0, 0); \
            _Pragma("unroll") for (int e_ = i_ * VPC_; e_ < (i_ + 1) * VPC_ && e_ < 32; e_ += 2) { \
                if (e_ + 1 < 32) { if ((e_ >> 1) & 1) b_ = max3f(b_, FA_X(SC0, SC1, e_), FA_X(SC0, SC1, e_ + 1)); else a_ = max3f(a_, FA_X(SC0, SC1, e_), FA_X(SC0, SC1, e_ + 1)); } \
                else a_ = fmaxf(a_, FA_X(SC0, SC1, e_)); } \
            FA_SB(); } \
        if (__builtin_expect(__any(m != 0.f), 0)) { _Pragma("unroll") for (int r = 0; r < 16; ++r) { SN0[r] -= m; SN1[r] -= m; } } \
        rm = pair_max(fmaxf(a_, b_)); } } while (0)
#define FA_QK_NOMAX(SN0, SN1) do { const int ka_ = kfo + ((s0 + 1) % 3) * KBYTES; constexpr int NQ_ = 2 * ND0, FD_ = FA_FD; \
        if constexpr (C::K8) { const f32x16 z8_ = f32x16{}; SN0 = FA_QK8(0, ka_, z8_); FA_SB(); SN1 = FA_QK8(1, ka_, z8_); FA_SB(); } else { \
        bf16x8 kf_[FD_]; _Pragma("unroll") for (int j_ = 0; j_ < FD_ - 1; ++j_) kf_[j_] = *(const LAS bf16x8*)(lds + ka_ + (j_ >> 1) * 2048 + (j_ & 1) * 512); \
        const f32x16 z_ = f32x16{}; \
        _Pragma("unroll") for (int i_ = 0; i_ < NQ_; ++i_) { const int d0_ = i_ >> 1, kb_ = i_ & 1; \
            if (i_ + FD_ - 1 < NQ_) kf_[(i_ + FD_ - 1) % FD_] = *(const LAS bf16x8*)(lds + ka_ + ((i_ + FD_ - 1) >> 1) * 2048 + ((i_ + FD_ - 1) & 1) * 512); \
            if (kb_ == 0) SN0 = __builtin_amdgcn_mfma_f32_32x32x16_bf16(kf_[i_ % FD_], qf[d0_], d0_ == 0 ? z_ : SN0, 0, 0, 0); \
            else          SN1 = __builtin_amdgcn_mfma_f32_32x32x16_bf16(kf_[i_ % FD_], qf[d0_], d0_ == 0 ? z_ : SN1, 0, 0, 0); \
            FA_SB(); } } } while (0)
#define FA_PIN(x) asm volatile("" : "+v"(x))
#define FA_PV_EXP(SC0, SC1, PP, PC) do { const int va_ = vfo + ((s0 + 2) % 3) * VBYTES; constexpr int NCH_ = 4 * NDB, EPC_ = 32 / NCH_, FD_ = FA_FD; \
        bf16x8 vf_[FD_]; _Pragma("unroll") for (int j_ = 0; j_ < FD_ - 1; ++j_) vf_[j_] = *(const LAS bf16x8*)(lds + va_ + (j_ / NDB) * DV * 32 + (j_ % NDB) * 512); \
        float s_[4] = {0.f, 0.f, 0.f, 0.f}; unsigned w_[16]; \
        _Pragma("unroll") for (int i_ = 0; i_ < NCH_; ++i_) { const int ks_ = i_ / NDB, db_ = i_ % NDB; \
            if (i_ + FD_ - 1 < NCH_) vf_[(i_ + FD_ - 1) % FD_] = *(const LAS bf16x8*)(lds + va_ + ((i_ + FD_ - 1) / NDB) * DV * 32 + ((i_ + FD_ - 1) % NDB) * 512); \
            o[db_] = __builtin_amdgcn_mfma_f32_32x32x16_bf16(vf_[i_ % FD_], PP[ks_], o[db_], 0, 0, 0); \
            _Pragma("unroll") for (int e_ = i_ * EPC_; e_ < (i_ + 1) * EPC_; ++e_) { if (e_ < 16) SC0[e_ & 15] = fast_exp2(SC0[e_ & 15]); else SC1[e_ & 15] = fast_exp2(SC1[e_ & 15]); } \
            if (i_ > 0) { _Pragma("unroll") for (int e_ = (i_ - 1) * EPC_; e_ < i_ * EPC_; ++e_) s_[e_ & 3] += FA_X(SC0, SC1, e_); \
                          _Pragma("unroll") for (int e_ = (i_ - 1) * EPC_; e_ < i_ * EPC_; e_ += 2) { w_[e_ >> 1] = cvtpk_n(FA_X(SC0, SC1, e_), FA_X(SC0, SC1, e_ + 1)); FA_PIN(w_[e_ >> 1]); } \
                          FA_PIN(s_[0]); FA_PIN(s_[1]); if (EPC_ > 2) { FA_PIN(s_[2]); FA_PIN(s_[3]); } } \
            FA_SB(); } \
        { _Pragma("unroll") for (int e_ = (NCH_ - 1) * EPC_; e_ < 32; ++e_) s_[e_ & 3] += FA_X(SC0, SC1, e_); \
          _Pragma("unroll") for (int e_ = (NCH_ - 1) * EPC_; e_ < 32; e_ += 2) { w_[e_ >> 1] = cvtpk_n(FA_X(SC0, SC1, e_), FA_X(SC0, SC1, e_ + 1)); FA_PIN(w_[e_ >> 1]); } } \
        l += (s_[0] + s_[1]) + (s_[2] + s_[3]); FA_PIN(l); \
        _Pragma("unroll") for (int g_ = 0; g_ < 4; ++g_) { u32x4 t_ = {w_[4 * g_], w_[4 * g_ + 1], w_[4 * g_ + 2], w_[4 * g_ + 3]}; PC[g_] = __builtin_bit_cast(bf16x8, t_); } \
        FA_SB(); } while (0)
#define FA_STEP(MODE, SC0, SC1, SN0, SN1, PP, PC) do { \
        const bool do_qk = (t + 1 >= a_lo && t + 1 <= a_hi), do_sm = (t >= a_lo && t <= a_hi), do_pv = (t - 1 >= a_lo && t - 1 <= a_hi); \
        if (MODE) {                                                              \
            if constexpr (OPT) { FA_QK_NOMAX(SN0, SN1); FA_PV_EXP(SC0, SC1, PP, PC); } \
            else { float rm; FA_QK_MAX(SC0, SC1, SN0, SN1, rm); \
                if (__builtin_expect(__any(rm > THR), 0)) { const float dl = fmaxf(rm, 0.f); FA_RESCALE_A(SC0, SC1, SN0, SN1, dl, true); } \
                FA_PV_EXP(SC0, SC1, PP, PC); FA_RESCALE_B(); } \
        } else {                                                                \
            if (do_qk) FA_QK(SN0, SN1); \
            if (do_sm) { if (TYPE != 1 && t >= near_lo) FA_BIAS(SC0, SC1, t); \
                if constexpr (!OPT) { float rm; FA_ROWMAX(SC0, SC1, rm); \
                    if (t == a_lo) { const float dl = (fabsf(rm) > 16.0f) ? rm : 0.f; FA_RESCALE_A(SC0, SC1, SN0, SN1, dl, do_qk); resc = false; l = 0.f; }     \
                    else if (__any(rm > THR)) { const float dl = fmaxf(rm, 0.f); FA_RESCALE_A(SC0, SC1, SN0, SN1, dl, do_qk); } } } \
            if (do_pv) FA_PV(PP); \
            if (do_sm) FA_EXP(SC0, SC1, PC); \
            if constexpr (!OPT) FA_RESCALE_B(); \
        } } while (0)
#define FA_ITER(MODE, t, SC0, SC1, SN0, SN1, PP, PC) do { \
        if ((t) >= T0 && (t) + 2 <= T1) { if (NPW == 2) FA_WAITBAR(2); else if (NPW == 3) FA_WAITBAR(3); else FA_WAITBAR(4); } else FA_WAITBAR(0); \
        if ((t) + 3 <= T1) FA_ISSUE_K((t) + 3, s0); \
        if ((t) + 1 <= T1) FA_ISSUE_V((t) + 1, (s0 + 1) % 3); \
        FA_STEP(MODE, SC0, SC1, SN0, SN1, PP, PC); \
        s0 = (s0 == 2) ? 0 : s0 + 1; } while (0)
#define FA_PAIR(MODE) do { { const int t = tt; FA_ITER(MODE, t, sA0, sA1, sB0, sB1, pa, pb); } { const int t = tt + 1; FA_ITER(MODE, t, sB0, sB1, sA0, sA1, pb, pa); } } while (0)
    int tt = T0 - 1;
    const int st_hi = (TYPE == 0) ? -(1 << 20) : c0 - 3;
    { FA_PAIR(0); tt += 2; }
    for (; tt + 1 <= st_hi; tt += 2) FA_PAIR(1);
#pragma unroll
    for (int r = 0; r < 16; ++r) negm[r] = -m;
    for (; tt <= T1 + 1; tt += 2) FA_PAIR(0);
    const float lt = pair_sum(l), inv = fast_rcp(lt);
    const bool ok_ = OPT ? (__all((lt > 7.9e-31f) && (lt < 1.2e30f)) != 0) : true;
    if (TYPE != 2) {
        bf16_t* op = ds.O + (size_t)qpos * D;
#pragma unroll
        for (int db = 0; db < NDB; ++db)
#pragma unroll
            for (int g = 0; g < 4; ++g) { u32x2 w; w.x = cvt_pk_bf16(o[db][4 * g] * inv, o[db][4 * g + 1] * inv); w.y = cvt_pk_bf16(o[db][4 * g + 2] * inv, o[db][4 * g + 3] * inv);
                *(u32x2*)(op + 32 * db + 8 * g + 4 * hi) = w; }
    } else {
        FA_WAITBAR(0);
        const int xb = XCH + ((rb * 32 + q) * 132) * 4;
        if (sub == 1) {
#pragma unroll
            for (int db = 0; db < NDB; ++db)
#pragma unroll
                for (int g = 0; g < 4; ++g) { f32x4 w = {o[db][4 * g] * inv, o[db][4 * g + 1] * inv, o[db][4 * g + 2] * inv, o[db][4 * g + 3] * inv}; *(LAS f32x4*)(lds + xb + (32 * db + 8 * g + 4 * hi) * 4) = w; }
        }
        FA_WAITBAR(0);
        if (sub == 0) {
            float ss = 0.f;
#pragma unroll
            for (int db = 0; db < NDB; ++db)
#pragma unroll
                for (int g = 0; g < 4; ++g) { const f32x4 w = *(const LAS f32x4*)(lds + xb + (32 * db + 8 * g + 4 * hi) * 4);
#pragma unroll
                    for (int jj = 0; jj < 4; ++jj) { const float a = o[db][4 * g + jj] * inv - ds.lam * w[jj]; o[db][4 * g + jj] = a; ss += a * a; } }
            ss = pair_sum(ss);
            const float rinv = ds.omli / sqrtf(ss * (1.0f / 128.0f) + RMS_EPS);
            bf16_t* op = ds.O + (size_t)qpos * D;
#pragma unroll
            for (int db = 0; db < NDB; ++db) { f32x4 sgv[4];
#pragma unroll
                for (int g = 0; g < 4; ++g) sgv[g] = *(const f32x4*)(ds.subln + 32 * db + 8 * g + 4 * hi);
#pragma unroll
                for (int g = 0; g < 4; ++g) { const int d = 32 * db + 8 * g + 4 * hi; const f32x4 sg = sgv[g];
                    u32x2 w; w.x = cvt_pk_bf16(o[db][4 * g] * rinv * sg[0], o[db][4 * g + 1] * rinv * sg[1]); w.y = cvt_pk_bf16(o[db][4 * g + 2] * rinv * sg[2], o[db][4 * g + 3] * rinv * sg[3]);
                    *(u32x2*)(op + d) = w; } }
        }
    }
#undef FA_ISSUE_K
#undef FA_ISSUE_V
    return ok_;
}
template <int TYPE>
__device__ __forceinline__ void attn_unit_checked(LAS unsigned char* lds, const int wave, const Desc ds) {
    const bool ok = attn_unit<TYPE, true>(lds, wave, ds);
    LAS int* flag = (LAS int*)(lds + LM_FLAG);
    if (!ok) *flag = 1;
    asm volatile("s_waitcnt vmcnt(0) lgkmcnt(0)\n\ts_barrier" ::: "memory");
    const int redo = *flag;
    asm volatile("s_waitcnt lgkmcnt(0)\n\ts_barrier" ::: "memory");
    if (redo) { if (wave == 0) *flag = 0; (void)attn_unit<TYPE, false>(lds, wave, ds); }
}
}

struct Args {
    const float* in[26];
    float* out; unsigned char* ws;
    float inv_freq[16];
    int ph_lo, ph_hi;
};
enum { I_X = 0, I_P, I_AB_WIN, I_AB_RELB, I_AB_QN, I_AB_KVN, I_AB_WUQ, I_AB_WUKV, I_AB_WOUT, I_C_WIN, I_C_LAM, I_C_SUBLN, I_C_WOUT, I_T5, I_LNMG, I_LNMB, I_LNFG, I_LNFB,
       I_RW, I_RB, I_EWIN, I_EBIN, I_EWOUT, I_EBOUT, I_PGW, I_PPW };

__device__ __forceinline__ void transpose_item(const float* W, int Nsrc, int c0, int k0, const float* kscale, bf16_t* WT, int K, int r0, LAS float* scr, int lane) {
#pragma unroll 8
    for (int i = 0; i < 32; ++i) { const int kk = 2 * i + (lane >> 5); float v = W[(size_t)(k0 + kk) * Nsrc + c0 + (lane & 31)]; if (kscale) v *= kscale[k0 + kk]; scr[kk * 33 + (lane & 31)] = v; }
    LDS_WAIT(); asm volatile("" ::: "memory");
    const int c = lane & 7;
#pragma unroll
    for (int j = 0; j < 4; ++j) { const int n = (lane >> 3) + 8 * j; const LAS float* s = scr + (8 * c) * 33 + n;
        u32x4 o; o.x = cvt_pk_bf16(s[0 * 33], s[1 * 33]); o.y = cvt_pk_bf16(s[2 * 33], s[3 * 33]); o.z = cvt_pk_bf16(s[4 * 33], s[5 * 33]); o.w = cvt_pk_bf16(s[6 * 33], s[7 * 33]);
        *(u32x4*)(WT + (size_t)(r0 + n) * K + k0 + 8 * c) = o; }
    LDS_WAIT(); asm volatile("" ::: "memory");
}
__device__ __forceinline__ void transpose_item_fp8(const float* W, int Nsrc, int c0, int k0, float sc, unsigned char* WT, int K, int r0, LAS float* scr, int lane) {
#pragma unroll 8
    for (int i = 0; i < 32; ++i) { const int kk = 2 * i + (lane >> 5); scr[kk * 33 + (lane & 31)] = W[(size_t)(k0 + kk) * Nsrc + c0 + (lane & 31)] * sc; }
    LDS_WAIT(); asm volatile("" ::: "memory");
    const int c = lane & 7;
#pragma unroll
    for (int j = 0; j < 4; ++j) { const int n = (lane >> 3) + 8 * j; const LAS float* s = scr + (8 * c) * 33 + n;
        u32x2 o; o.x = pg8::pack4_fp8(s[0 * 33], s[1 * 33], s[2 * 33], s[3 * 33]); o.y = pg8::pack4_fp8(s[4 * 33], s[5 * 33], s[6 * 33], s[7 * 33]);
        *(u32x2*)(WT + (size_t)(r0 + n) * K + k0 + 8 * c) = o; }
    LDS_WAIT(); asm volatile("" ::: "memory");
}
__device__ __forceinline__ void convert_tile_fp8(const float* W, int Nsrc, int c0, int k0, float sc, unsigned char* WT, int K, int r0, int lane) {
    const int q = lane & 7, g = lane >> 3;
    const float* src = W + (size_t)(k0 + 16 * g) * Nsrc + c0 + 4 * q;
    f32x4 v[16];
#pragma unroll
    for (int j = 0; j < 16; ++j) v[j] = __builtin_nontemporal_load((const f32x4*)(src + (size_t)j * Nsrc));
#pragma unroll
    for (int c = 0; c < 4; ++c) { u32x4 o;
        o.x = pg8::pack4_fp8(v[0][c] * sc, v[1][c] * sc, v[2][c] * sc, v[3][c] * sc); o.y = pg8::pack4_fp8(v[4][c] * sc, v[5][c] * sc, v[6][c] * sc, v[7][c] * sc);
        o.z = pg8::pack4_fp8(v[8][c] * sc, v[9][c] * sc, v[10][c] * sc, v[11][c] * sc); o.w = pg8::pack4_fp8(v[12][c] * sc, v[13][c] * sc, v[14][c] * sc, v[15][c] * sc);
        *(u32x4*)(WT + (size_t)(r0 + 4 * q + c) * K + k0 + 16 * g) = o; }
}
__device__ __forceinline__ void sincos_acc(float ang, float& sn, float& cs) {
    const double x = (double)ang; const double TWO_OVER_PI = 0.63661977236758134308, PIO2 = 1.57079632679489661923;
    const double kq = rint(x * TWO_OVER_PI); const double y = x - kq * PIO2; const double y2 = y * y;
    double s = y * (1.0 + y2 * (-1.0 / 6 + y2 * (1.0 / 120 + y2 * (-1.0 / 5040 + y2 * (1.0 / 362880 + y2 * (-1.0 / 39916800 + y2 * (1.0 / 6227020800.0)))))));
    double c = 1.0 + y2 * (-0.5 + y2 * (1.0 / 24 + y2 * (-1.0 / 720 + y2 * (1.0 / 40320 + y2 * (-1.0 / 3628800 + y2 * (1.0 / 479001600.0))))));
    const int q = ((int)(long long)kq) & 3;
    const double ss = (q == 0) ? s : (q == 1) ? c : (q == 2) ? -s : -c;
    const double cc = (q == 0) ? c : (q == 1) ? -s : (q == 2) ? -c : s;
    sn = (float)ss; cs = (float)cc;
}
__device__ __forceinline__ int t5_bucket_dev(int rel) {
    const int ret = rel > 0 ? 16 : 0; const int n = rel < 0 ? -rel : rel;
    if (n < 8) return ret + n;
    int large = 8 + (int)(__log2f((float)n * 0.125f) * 2.0f + 1e-4f);
    if (large > 15) large = 15;
    return ret + large;
}

__device__ __forceinline__ int opaque_s(int i) { asm volatile("" : "+s"(i)); return i; }
#define ARGIN(i) (args.in[opaque_s(i)])
struct Ctx { LAS unsigned char* lds; gu32* ctl; int wave, G, bx, vcu, gw, NGW, lo, hi; };
template <int L> __device__ __forceinline__ void layer_body(const Args& args, const Ctx cx, const XcdBarrier& bar);
__global__ void __launch_bounds__(NTHREADS, 2) mk_fwd(Args args) {
    extern __shared__ __attribute__((aligned(16))) unsigned char lds_raw[];
    LAS unsigned char* lds = (LAS unsigned char*)lds_raw;
    int wave_ = __builtin_amdgcn_readfirstlane(threadIdx.x >> 6); asm volatile("" : "+s"(wave_)); const int wave = wave_;
#define WS_DECL GAS unsigned char* wsg_ = (GAS unsigned char*)args.ws; asm volatile("" : "+s"(wsg_)); unsigned char* ws = (unsigned char*)wsg_
#define TID_DECL const int lane = lane_id_asm(), tid = wave * 64 + lane; (void)tid; (void)lane
    const int G = gridDim.x, bx = blockIdx.x;
    const int vcu = (G % 8 == 0) ? (bx % 8) * (G / 8) + bx / 8 : bx;
    const int gw = vcu * NWAVES + wave, NGW = G * NWAVES;
    gu32* ctl = (gu32*)(args.ws + WS_CTL);
    { TID_DECL; for (int u = tid; u < (LDS_BYTES - LM) / 4; u += NTHREADS) ((LAS unsigned*)(lds + LM))[u] = 0u; }
    __syncthreads();
#if MK_ONE_LAUNCH
    XcdBarrier bar = xcd_barrier_post((unsigned*)(ctl + CW_BAR), (volatile LAS unsigned*)(lds + LM_BAR));
#ifdef DOUBLE_BAR
#define GRID_BAR() do { xcd_barrier(bar); xcd_barrier(bar); } while (0)
#else
#define GRID_BAR() xcd_barrier(bar)
#endif
#else
#define GRID_BAR() do {} while (0)
#endif
    const int lo = args.ph_lo, hi = args.ph_hi;
#ifndef PH_MASK
#define PH_MASK 0xFFFF
#endif
#ifndef DUP_MASK
#define DUP_MASK 0
#endif
#define REP(b) for (int rep_ = 0; rep_ < (((DUP_MASK) >> (b)) & 1) + 1; ++rep_)
#define PHE(b) (((PH_MASK) >> (b)) & 1)
#define IN(k) (lo <= (k) && (k) < hi)
#define SEAM(k) do { if (IN(k) && IN((k) + 1)) GRID_BAR(); } while (0)

#define XB ((bf16_t*)(ws + WS_XB))
#define PB ((bf16_t*)(ws + WS_PB))
#define PP ((bf16_t*)(ws + WS_PP))
#define QA ((bf16_t*)(ws + WS_QA))
#define KA ((bf16_t*)(ws + WS_KA))
#define VAT ((bf16_t*)(ws + WS_VAT))
#define CQ ((bf16_t*)(ws + WS_CQ))
#define CKV ((bf16_t*)(ws + WS_CKV))
#define SSQQ ((float*)(ws + WS_SSQQ))
#define SSQKV ((float*)(ws + WS_SSQKV))
#define QB ((bf16_t*)(ws + WS_QB))
#define KB ((bf16_t*)(ws + WS_KB))
#define VBT ((bf16_t*)(ws + WS_VBT))
#define QC ((bf16_t*)(ws + WS_QC))
#define KC ((bf16_t*)(ws + WS_KC))
#define VCT ((bf16_t*)(ws + WS_VCT))
#define OAB ((bf16_t*)(ws + WS_OAB))
#define Z ((bf16_t*)(ws + WS_Z))
#define X1 ((float*)(ws + WS_X1))
#define XB1 ((bf16_t*)(ws + WS_XB1))
#define XF8 ((unsigned char*)(ws + WS_XF8))
#define Z2 ((bf16_t*)(ws + WS_Z2))
#define HS ((bf16_t*)(ws + WS_HS))
#define YS ((bf16_t*)(ws + WS_YS))
#define TOK ((int*)(ws + WS_TOK))
#define GATE ((float*)(ws + WS_GATE))
#define SLOT ((int*)(ws + WS_SLOT))
#define ROPE ((const f32x2*)(ws + WS_TAB + TAB_ROPE))
#define WRT ((float*)(ws + WS_TAB + TAB_WRT))
#define BIASA ((float*)(ws + WS_TAB + TAB_BIASA))
#define T5T ((float*)(ws + WS_TAB + TAB_T5))
#define LAMT ((float*)(ws + WS_TAB + TAB_LAM))
#define FATAB ((float*)(ws + WS_TAB + TAB_FA))
#define FAFAR ((float*)(ws + WS_TAB + TAB_FAFAR))
    if (PHE(0) && IN(0)) REP(0) { TID_DECL; WS_DECL;
        { const unsigned NT = (unsigned)(G * NTHREADS);
          for (unsigned i = (unsigned)(vcu * NTHREADS + wave * 64 + lane_id_asm()); i < (unsigned)(S * D / 8); i += NT) { const f32x4 a = *(const f32x4*)(args.in[I_X] + (size_t)i * 8), b = *(const f32x4*)(args.in[I_X] + (size_t)i * 8 + 4); *(u32x4*)(XB + (size_t)i * 8) = pg8::pack8(a, b); }
          for (unsigned i = (unsigned)(vcu * NTHREADS + wave * 64 + lane_id_asm()); i < (unsigned)(4 * S * PLE / 8); i += NT) { const f32x4 a = *(const f32x4*)(args.in[I_P] + (size_t)i * 8), b = *(const f32x4*)(args.in[I_P] + (size_t)i * 8 + 4); *(u32x4*)(PB + (size_t)i * 8) = pg8::pack8(a, b); }
          for (unsigned i = (unsigned)(vcu * NTHREADS + wave * 64 + lane_id_asm()); i < (unsigned)(S * 16); i += NT) { const int s = (int)(i >> 4), f = (int)(i & 15); const float ang = (float)s * args.inv_freq[f]; float sn, cs; sincos_acc(ang, sn, cs); ((f32x2*)(ws + WS_TAB + TAB_ROPE))[i] = (f32x2){cs, sn}; }
        }
        if (bx == 0) {
#if NAIVE_ATTN
          for (int i = tid; i < 2 * 8 * 260; i += NTHREADS) { const int j = i / (8 * 260), h = (i / 260) % 8, idx = i % 260; BIASA[i] = idx < 257 ? args.in[I_AB_RELB][((size_t)j * 257 + idx) * 8 + h] * LOG2E : 0.f; }
          for (int i = tid; i < 8 * 192; i += NTHREADS) { const int h = i / 192, rel = i % 192 - 128; T5T[i] = args.in[I_T5][t5_bucket_dev(rel) * 8 + h] * LOG2E; }
#endif
          if (tid < 16) { const int tb = tid >> 3, h = tid & 7; FAFAR[tid] = args.in[I_AB_RELB][((size_t)tb * 257 + 256) * 8 + h] * LOG2E; }
          else if (tid < 24) { FAFAR[tid] = args.in[I_T5][15 * 8 + (tid - 16)] * LOG2E; }
          if (wave < 2) { const int j = wave, d = lane_id_asm(); const float* lp = args.in[I_C_LAM] + j * 256; const float s01 = wave_sum(lp[d] * lp[64 + d]), s23 = wave_sum(lp[128 + d] * lp[192 + d]);
              const float li = 0.8f - 0.6f * fast_exp2(-0.3f * (float)(2 * j + 1) * LOG2E); if (d == 0) { LAMT[j * 2] = fast_exp2(s01 * LOG2E) - fast_exp2(s23 * LOG2E) + li; LAMT[j * 2 + 1] = 1.0f - li; } }
        }
        for (int i = vcu * NTHREADS + tid; i < 3 * 8 * 256; i += G * NTHREADS) {
          if (i < 2 * 8 * 256) { const int tb = i >> 11, h = (i >> 8) & 7, rel = (i & 255) - 192; int qk = -rel; qk = qk > 128 ? 128 : qk;
              FATAB[i] = args.in[I_AB_RELB][((size_t)tb * 257 + qk + 128) * 8 + h] * LOG2E; }
          else { const int i2 = i - 2 * 8 * 256, h = (i2 >> 8) & 7, rel = (i2 & 255) - 192; FATAB[i] = args.in[I_T5][t5_bucket_dev(rel) * 8 + h] * LOG2E; }
        }
        LAS float* scr = (LAS float*)(lds + wave * 16384);
        constexpr int J0 = 4 * 32 * (MOE_FP8 ? 8 : 16) * 64, J1 = 4 * 32 * (MOE_FP8 ? 8 : 16) * 32, J2 = 2 * 16 * 80, J3 = 2 * 8 * 24, J4 = 2 * 4 * 16, J5 = J4, J6 = 2 * 16 * 32, J7 = 2 * 16 * 96, J8 = J6, J9 = 4 * (MOE_FP8 ? 8 : 16) * 32, J10 = 4 * 4 * 32;
        constexpr int NITEMS = J0 + J1 + J2 + J3 + J4 + J5 + J6 + J7 + J8 + J9 + J10;
        for (int it = gw; it < NITEMS; it += NGW) {
            int r = it;
#if MOE_FP8
            if (r < J0) { const int mat = r / 512, q = r % 512, kb = q / 64, b = q % 64; const int t = b >> 3, s = (b >> 2) & 1, i32 = b & 3;
                convert_tile_fp8(args.in[I_EWIN] + (size_t)mat * 1024 * 2048, 2048, s * 1024 + 128 * t + 32 * i32, kb * 128, pg8::W1_SCALE, ws + WS_W1 + (size_t)mat * 2048 * 1024, 1024, b * 32, lane); continue; } r -= J0;
            if (r < J1) { const int mat = r / 256, q = r % 256, kb = q / 32, b = q % 32;
                convert_tile_fp8(args.in[I_EWOUT] + (size_t)mat * 1024 * 1024, 1024, b * 32, kb * 128, pg8::W2_SCALE, ws + WS_W2 + (size_t)mat * 1024 * 1024, 1024, b * 32, lane); continue; } r -= J1;
#else
            if (r < J0) { const int mat = r / 1024, q = r % 1024, kb = q / 64, b = q % 64; const int t = b >> 3, s = (b >> 2) & 1, i32 = b & 3;
                transpose_item(args.in[I_EWIN] + (size_t)mat * 1024 * 2048, 2048, s * 1024 + 128 * t + 32 * i32, kb * 64, nullptr, (bf16_t*)(ws + WS_W1) + (size_t)mat * 2048 * 1024, 1024, b * 32, scr, lane); continue; } r -= J0;
            if (r < J1) { const int mat = r / 512, q = r % 512, kb = q / 32, b = q % 32;
                transpose_item(args.in[I_EWOUT] + (size_t)mat * 1024 * 1024, 1024, b * 32, kb * 64, nullptr, (bf16_t*)(ws + WS_W2) + (size_t)mat * 1024 * 1024, 1024, b * 32, scr, lane); continue; } r -= J1;
#endif
            if (r < J2) { const int j = r / 1280, q = r % 1280, kb = q / 80, b = q % 80; int c0;
                if (b < 32) c0 = 32 * b; else if (b < 48) c0 = 1536 + 32 * (b - 32); else if (b < 56) c0 = 2048 + 32 * (b - 48); else if (b == 56) c0 = 2304; else if (b < 64) c0 = -1; else c0 = 1024 + 32 * (b - 64);
                if (c0 >= 0) transpose_item(args.in[I_AB_WIN] + (size_t)j * 1024 * AB_IN, AB_IN, c0, kb * 64, nullptr, (bf16_t*)(ws + WS_WABIN) + (size_t)j * 2560 * 1024, 1024, b * 32, scr, lane);
                continue; } r -= J2;
            if (r < J3) { const int j = r / 192, q = r % 192, kb = q / 24, b = q % 24;
                transpose_item(args.in[I_AB_WUQ] + (size_t)j * 512 * 768, 768, b * 32, kb * 64, args.in[I_AB_QN] + j * 512, (bf16_t*)(ws + WS_WUQ) + (size_t)j * 768 * 512, 512, b * 32, scr, lane); continue; } r -= J3;
            if (r < J4 + J5) { const int isv = r >= J4; if (isv) r -= J4; const int j = r / 64, q = r % 64, kb = q / 16, b = q % 16; const int h = b >> 1, hf = b & 1;
                transpose_item(args.in[I_AB_WUKV] + (size_t)j * 256 * 1024, 1024, h * 128 + 32 * hf + (isv ? 64 : 0), kb * 64, args.in[I_AB_KVN] + j * 256, (bf16_t*)(ws + (isv ? WS_WUKVV : WS_WUKVK)) + (size_t)j * 512 * 256, 256, b * 32, scr, lane); continue; } r -= J4 + J5;
            if (r < J6) { const int j = r / 512, q = r % 512, kb = q / 32, b = q % 32;
                transpose_item(args.in[I_AB_WOUT] + (size_t)j * 1024 * 1024, 1024, b * 32, kb * 64, nullptr, (bf16_t*)(ws + WS_WABOUT) + (size_t)j * 1024 * 1024, 1024, b * 32, scr, lane); continue; } r -= J6;
            if (r < J7) { const int j = r / 1536, q = r % 1536, kb = q / 96, b = q % 96;
                transpose_item(args.in[I_C_WIN] + (size_t)j * 1024 * 3072, 3072, b * 32, kb * 64, nullptr, (bf16_t*)(ws + WS_WCIN) + (size_t)j * 3072 * 1024, 1024, b * 32, scr, lane); continue; } r -= J7;
            if (r < J8) { const int j = r / 512, q = r % 512, kb = q / 32, b = q % 32;
                transpose_item(args.in[I_C_WOUT] + (size_t)j * 1024 * 1024, 1024, b * 32, kb * 64, nullptr, (bf16_t*)(ws + WS_WCOUT) + (size_t)j * 1024 * 1024, 1024, b * 32, scr, lane); continue; } r -= J8;
#if MOE_FP8
            if (r < J9) { const int j = r / 256, q = r % 256, kb = q / 32, b = q % 32;
                convert_tile_fp8(args.in[I_PGW] + (size_t)j * 1024 * 1024, 1024, b * 32, kb * 128, 32.0f, ws + WS_WPG + (size_t)j * 1024 * 1024, 1024, b * 32, lane); continue; } r -= J9;
#else
            if (r < J9) { const int j = r / 512, q = r % 512, kb = q / 32, b = q % 32;
                transpose_item(args.in[I_PGW] + (size_t)j * 1024 * 1024, 1024, b * 32, kb * 64, nullptr, (bf16_t*)(ws + WS_WPG) + (size_t)j * 1024 * 1024, 1024, b * 32, scr, lane); continue; } r -= J9;
#endif
            { const int j = r / 128, q = r % 128, kb = q / 32, b = q % 32;
                transpose_item(args.in[I_PPW] + (size_t)j * 256 * 1024, 1024, b * 32, kb * 64, nullptr, (bf16_t*)(ws + WS_WPP) + (size_t)j * 1024 * 256, 256, b * 32, scr, lane); }
        }
    }
    SEAM(0);
    if (PHE(1) && IN(1)) REP(1) { WS_DECL;
        { pg8::Gemm g{PB, (const bf16_t*)(ws + WS_WPP), 256, (size_t)1024 * 256, wave}; pg8::LayeredOrder So; So.so.init(4 * S, D, G, bx);
          pg8::EpiBf16Split E{PP, D, 1 << 20, 0, 1.0f};
          pg8::gemm_phase<pg8::EpiBf16Split, pg8::LayeredOrder, true>(lds, g, So, E); }
    }

    { Ctx cx{lds, ctl, wave, G, bx, vcu, gw, NGW, lo, hi};
#if MK_ONE_LAUNCH
      const XcdBarrier& barr = bar;
#else
      XcdBarrier barr{nullptr, 0u, nullptr};
#endif
      layer_body<0>(args, cx, barr); layer_body<1>(args, cx, barr); layer_body<2>(args, cx, barr); layer_body<3>(args, cx, barr); }
}

template <int L> __device__ __forceinline__ void layer_body(const Args& args, const Ctx cx, const XcdBarrier& bar) {
    LAS unsigned char* lds = cx.lds; gu32* ctl = cx.ctl; const int wave = cx.wave, G = cx.G, bx = cx.bx, vcu = cx.vcu, gw = cx.gw, NGW = cx.NGW, lo = cx.lo, hi = cx.hi;
    (void)bar; (void)ctl; (void)bx; (void)gw; (void)NGW; (void)vcu;
    {
        const int pb = 2 + 8 * L, j = L >> 1;
        if (pb + 8 <= lo || pb >= hi) return;
        if ((L & 1) == 0) {
            if (PHE(2) && IN(pb + 0)) REP(2) { WS_DECL;
                const bf16_t* W = (const bf16_t*)(ws + WS_WABIN) + (size_t)j * 2560 * 1024;
                { pg8::Gemm g{XB, W, 1024, 0, wave}; pg8::StaticOrder So; So.init(S, 2048, G, bx);
                  pg8::EpiABIn E{ws, 0.125f * LOG2E};
                  pg8::gemm_phase<pg8::EpiABIn, pg8::StaticOrder, true>(lds, g, So, E); }
                { pg8::Gemm g{W + (size_t)2048 * 1024, XB, 1024, 0, wave}; pg8::StaticOrder So; So.init(512, S, G, bx);
                  pg8::EpiVt<64, 0> E{VAT, nullptr, 0.f};
                  pg8::gemm_phase<pg8::EpiVt<64, 0>, pg8::StaticOrder, true>(lds, g, So, E); }
            }
            SEAM(pb + 0);
            if (PHE(3) && IN(pb + 1)) REP(3) { WS_DECL;
                { pg8::Gemm g{CQ, (const bf16_t*)(ws + WS_WUQ) + (size_t)j * 768 * 512, 512, 0, wave}; pg8::StaticOrder So; So.init(S, 768, G, bx);
                  pg8::EpiQUp E{ws, 0.10206207261596575f * LOG2E};
                  pg8::gemm_phase<pg8::EpiQUp, pg8::StaticOrder, true>(lds, g, So, E); }
                { pg8::Gemm g{CKV, (const bf16_t*)(ws + WS_WUKVK) + (size_t)j * 512 * 256, 256, 0, wave}; pg8::StaticOrder So; So.init(S, 512, G, (bx + 128) % G);
                  pg8::EpiKUp E{ws};
                  pg8::gemm_phase<pg8::EpiKUp, pg8::StaticOrder, true>(lds, g, So, E); }
                { pg8::Gemm g{(const bf16_t*)(ws + WS_WUKVV) + (size_t)j * 512 * 256, CKV, 256, 0, wave}; pg8::StaticOrder So; So.init(512, S, G, (bx + 64) % G);
                  pg8::EpiVt<64, 4> E{VBT, SSQKV, 1.0f / 256.0f};
                  pg8::gemm_phase<pg8::EpiVt<64, 4>, pg8::StaticOrder, true>(lds, g, So, E); }
            }
            SEAM(pb + 1);
        } else {
            if (PHE(4) && IN(pb + 0)) REP(4) { WS_DECL;
                const bf16_t* W = (const bf16_t*)(ws + WS_WCIN) + (size_t)j * 3072 * 1024;
                { pg8::Gemm g{XB, W, 1024, 0, wave}; pg8::StaticOrder So; So.init(S, 2048, G, bx);
                  pg8::EpiCIn E{ws, 0.125f * LOG2E};
                  pg8::gemm_phase<pg8::EpiCIn, pg8::StaticOrder, true>(lds, g, So, E); }
                { pg8::Gemm g{W + (size_t)2048 * 1024, XB, 1024, 0, wave}; pg8::StaticOrder So; So.init(1024, S, G, bx);
                  pg8::EpiVt<128, 0> E{VCT, nullptr, 0.f};
                  pg8::gemm_phase<pg8::EpiVt<128, 0>, pg8::StaticOrder, true>(lds, g, So, E); }
            }
            SEAM(pb + 0);
        }
#if !NAIVE_ATTN
        if (PHE(5) && IN(pb + 2)) REP(5 + (L & 1)) { WS_DECL;
            if ((L & 1) == 0) {
                for (int p = vcu; p < 256; p += G) { const int h = p >> 5, sidx = p & 31;
#pragma unroll 1
                    for (int k = 0; k < 2; ++k) { const int qb = k ? 63 - sidx : sidx;
                        fa::Desc ds{QB + h * 96, (const bf16_t*)((const unsigned char*)KB + (size_t)h * 256 * (ATT_B_FP8 ? 8192 : 12288)), VBT + (size_t)h * 256 * 64 * 64, OAB + 512 + h * 64, 768, 768, qb * 256, nullptr, 0.f, 0.f, 0.f, nullptr};
#if !defined(FA_ONLY) || FA_ONLY == 1
                        fa::attn_unit_checked<1>(lds, wave, ds);
#endif
                    } }
                for (int u = vcu; u < 512; u += G) { const int h = u >> 6, qb = u & 63;
                    fa::Desc ds{QA + h * 64, KA + (size_t)h * 256 * 64 * 64, VAT + (size_t)h * 256 * 64 * 64, OAB + h * 64, 512, 512, qb * 256, FATAB + (j * 8 + h) * 256, FAFAR[j * 8 + h], 0.f, 0.f, nullptr};
#if !defined(FA_ONLY) || FA_ONLY == 0
                    fa::attn_unit_checked<0>(lds, wave, ds);
#endif
                }
            } else {
                const float lam = LAMT[j * 2], omli = LAMT[j * 2 + 1];
                for (int p = vcu; p < 512; p += G) { const int h = p >> 6, sidx = p & 63;
#pragma unroll 1
                    for (int k = 0; k < 2; ++k) { const int qb = k ? 127 - sidx : sidx;
                        fa::Desc ds{QC + h * 128, (const bf16_t*)((const unsigned char*)KC + (size_t)h * 256 * (ATT_C_FP8 ? 8192 : 16384)), VCT + (size_t)h * 256 * 128 * 64, OAB + h * 128, 1024, 1024, qb * 128, FATAB + (16 + h) * 256, FAFAR[16 + h], lam, omli, ARGIN(I_C_SUBLN) + j * 128};
#if !defined(FA_ONLY) || FA_ONLY == 2
                        fa::attn_unit_checked<2>(lds, wave, ds);
#endif
                    } }
            }
            asm volatile("s_waitcnt vmcnt(0) lgkmcnt(0)\n\ts_barrier" ::: "memory");
        }
#else
        if (IN(pb + 2)) { TID_DECL; WS_DECL;
            if ((L & 1) == 0) { if (PHE(5)) {
                const float* bA = BIASA + (size_t)j * 8 * 260;
                for (int it = gw; it < 2 * 8 * S; it += NGW) {
                    const int typ = it / (8 * S), r2 = it % (8 * S), h = r2 / S, s = r2 % S, c = s >> 6;
                    const int dqk = typ ? 96 : 64; const bf16_t* Qp = typ ? QB + (size_t)s * 768 + h * 96 : QA + (size_t)s * 512 + h * 64;
                    const bf16_t* Kp = typ ? KB + h * 96 : KA + h * 64; const int kld = typ ? 768 : 512; const bf16_t* Vt = (typ ? VBT : VAT) + (size_t)h * 256 * 64 * 64;
                    float q[96];
#pragma unroll
                    for (int d = 0; d < 96; ++d) q[d] = d < dqk ? bf2f(Qp[d]) : 0.f;
                    float mx = -1e30f, l = 0.f, o = 0.f;
                    const int t0 = typ ? 0 : (c >= 8 ? c - 8 : 0);
                    for (int t = t0; t <= c; ++t) {
                        const int key = t * 64 + lane; const bf16_t* kr = Kp + (size_t)key * kld; float sc = 0.f;
#pragma unroll
                        for (int d8 = 0; d8 < 12; ++d8) if (d8 * 8 < dqk) { const u32x4 kk = *(const u32x4*)(kr + d8 * 8);
                            sc += q[d8 * 8] * bf_lo(kk.x) + q[d8 * 8 + 1] * bf_hi(kk.x) + q[d8 * 8 + 2] * bf_lo(kk.y) + q[d8 * 8 + 3] * bf_hi(kk.y) + q[d8 * 8 + 4] * bf_lo(kk.z) + q[d8 * 8 + 5] * bf_hi(kk.z) + q[d8 * 8 + 6] * bf_lo(kk.w) + q[d8 * 8 + 7] * bf_hi(kk.w); }
                        if (!typ) { int rel = s - key; rel = rel > 128 ? 128 : rel; sc += bA[h * 260 + rel + 128]; }
                        const float tm = wave_max(sc), mn = fmaxf(mx, tm), al_ = fast_exp2(mx - mn), p = fast_exp2(sc - mn);
                        l = l * al_ + wave_sum(p); o *= al_; mx = mn;
                        const bf16_t* vr = Vt + ((size_t)t * 64 + lane) * 64;
#pragma unroll
                        for (int k8 = 0; k8 < 8; ++k8) { const u32x4 vv = *(const u32x4*)(vr + k8 * 8);
                            o += rdlane(p, k8 * 8 + 0) * bf_lo(vv.x) + rdlane(p, k8 * 8 + 1) * bf_hi(vv.x) + rdlane(p, k8 * 8 + 2) * bf_lo(vv.y) + rdlane(p, k8 * 8 + 3) * bf_hi(vv.y)
                               + rdlane(p, k8 * 8 + 4) * bf_lo(vv.z) + rdlane(p, k8 * 8 + 5) * bf_hi(vv.z) + rdlane(p, k8 * 8 + 6) * bf_lo(vv.w) + rdlane(p, k8 * 8 + 7) * bf_hi(vv.w); }
                    }
                    const float r = o / l;
                    OAB[(size_t)s * D + typ * 512 + h * 64 + lane] = (bf16_t)(cvt_pk_bf16(r, r) & 0xffffu);
                }
            } } else if (PHE(6)) {
                const float lam = LAMT[j * 2], omli = LAMT[j * 2 + 1]; const float* sub = ARGIN(I_C_SUBLN) + j * 128;
                for (int it = gw; it < 8 * S; it += NGW) {
                    const int h = it / S, s = it % S, c = s >> 6; const bf16_t* Vt = VCT + (size_t)h * 256 * 128 * 64;
                    float ra0 = 0.f, ra1 = 0.f, rb0 = 0.f, rb1 = 0.f;
                    for (int sb = 0; sb < 2; ++sb) {
                        const bf16_t* Qp = QC + (size_t)s * D + h * 128 + sb * 64; const bf16_t* Kp = KC + h * 128 + sb * 64;
                        float q[64];
#pragma unroll
                        for (int d = 0; d < 64; ++d) q[d] = bf2f(Qp[d]);
                        float mx = -1e30f, l = 0.f, o0 = 0.f, o1 = 0.f;
                        for (int t = 0; t <= c; ++t) {
                            const int key = t * 64 + lane; const bf16_t* kr = Kp + (size_t)key * D; float sc = 0.f;
#pragma unroll
                            for (int d8 = 0; d8 < 8; ++d8) { const u32x4 kk = *(const u32x4*)(kr + d8 * 8);
                                sc += q[d8 * 8] * bf_lo(kk.x) + q[d8 * 8 + 1] * bf_hi(kk.x) + q[d8 * 8 + 2] * bf_lo(kk.y) + q[d8 * 8 + 3] * bf_hi(kk.y) + q[d8 * 8 + 4] * bf_lo(kk.z) + q[d8 * 8 + 5] * bf_hi(kk.z) + q[d8 * 8 + 6] * bf_lo(kk.w) + q[d8 * 8 + 7] * bf_hi(kk.w); }
                            { int rel = key - s; rel = rel < -128 ? -128 : rel; sc += T5T[h * 192 + rel + 128]; }
                            const float tm = wave_max(sc), mn = fmaxf(mx, tm), al_ = fast_exp2(mx - mn), p = fast_exp2(sc - mn);
                            l = l * al_ + wave_sum(p); o0 *= al_; o1 *= al_; mx = mn;
                            const bf16_t* vr0 = Vt + ((size_t)t * 128 + lane) * 64; const bf16_t* vr1 = vr0 + 64 * 64;
#pragma unroll
                            for (int k8 = 0; k8 < 8; ++k8) { const u32x4 va = *(const u32x4*)(vr0 + k8 * 8), vb = *(const u32x4*)(vr1 + k8 * 8);
                                const float p0 = rdlane(p, k8 * 8 + 0), p1 = rdlane(p, k8 * 8 + 1), p2 = rdlane(p, k8 * 8 + 2), p3 = rdlane(p, k8 * 8 + 3), p4 = rdlane(p, k8 * 8 + 4), p5 = rdlane(p, k8 * 8 + 5), p6 = rdlane(p, k8 * 8 + 6), p7 = rdlane(p, k8 * 8 + 7);
                                o0 += p0 * bf_lo(va.x) + p1 * bf_hi(va.x) + p2 * bf_lo(va.y) + p3 * bf_hi(va.y) + p4 * bf_lo(va.z) + p5 * bf_hi(va.z) + p6 * bf_lo(va.w) + p7 * bf_hi(va.w);
                                o1 += p0 * bf_lo(vb.x) + p1 * bf_hi(vb.x) + p2 * bf_lo(vb.y) + p3 * bf_hi(vb.y) + p4 * bf_lo(vb.z) + p5 * bf_hi(vb.z) + p6 * bf_lo(vb.w) + p7 * bf_hi(vb.w); }
                        }
                        if (sb == 0) { ra0 = o0 / l; ra1 = o1 / l; } else { rb0 = o0 / l; rb1 = o1 / l; }
                    }
                    const float a0 = ra0 - lam * rb0, a1 = ra1 - lam * rb1;
                    const float ms = wave_sum(a0 * a0 + a1 * a1) * (1.0f / 128.0f), inv = omli / sqrtf(ms + RMS_EPS);
                    const float r0 = a0 * inv * sub[lane], r1 = a1 * inv * sub[64 + lane];
                    OAB[(size_t)s * D + h * 128 + lane] = (bf16_t)(cvt_pk_bf16(r0, r0) & 0xffffu); OAB[(size_t)s * D + h * 128 + 64 + lane] = (bf16_t)(cvt_pk_bf16(r1, r1) & 0xffffu);
                }
            }
        }
#endif
        SEAM(pb + 2);
        if (PHE(7) && IN(pb + 3)) REP(7) { WS_DECL;
            pg8::Gemm g{OAB, (const bf16_t*)(ws + ((L & 1) ? WS_WCOUT : WS_WABOUT)) + (size_t)j * 1024 * 1024, 1024, 0, wave}; pg8::StaticOrder So; So.init(S, D, G, bx);
            if (L == 0) { pg8::EpiResid<true> E{ARGIN(I_X), Z}; pg8::gemm_phase<pg8::EpiResid<true>, pg8::StaticOrder, false>(lds, g, So, E); }
            else { pg8::EpiResid<false> E{XB, Z}; pg8::gemm_phase<pg8::EpiResid<false>, pg8::StaticOrder, false>(lds, g, So, E); }
        }
        SEAM(pb + 3);
        if (PHE(8) && IN(pb + 4)) { TID_DECL; WS_DECL;
            constexpr int XP = 1028;
            LAS float* XS = (LAS float*)lds;
            LAS float* PART = (LAS float*)(lds + 66048);
            LAS int* hist = (LAS int*)(lds + LM_HIST); LAS int* basep = (LAS int*)(lds + LM_BASE); LAS int* sel = (LAS int*)(lds + LM_SEL);
            if (tid < 32) hist[tid] = 0;
            __syncthreads();
            const float* gam = ARGIN(I_LNMG) + L * D; const float* bet = ARGIN(I_LNMB) + L * D; const float* rb = ARGIN(I_RB) + L * 32;
            const float* Wr = ARGIN(I_RW) + (size_t)L * D * 32;
            f32x4 gv[4], bv[4];
#pragma unroll
            for (int q = 0; q < 4; ++q) { gv[q] = *(const f32x4*)(gam + 4 * lane + 256 * q); bv[q] = *(const f32x4*)(bet + 4 * lane + 256 * q); }
            const int mi = lane & 15, kq = lane >> 4;
#define SPLIT8(src, H, Lw) do { u32x4 h_, l_; _Pragma("unroll") for (int i_ = 0; i_ < 4; ++i_) { const unsigned hp_ = cvt_pk_bf16(src[2 * i_], src[2 * i_ + 1]); h_[i_] = hp_; \
                l_[i_] = cvt_pk_bf16(src[2 * i_] - bf_lo(hp_), src[2 * i_ + 1] - bf_hi(hp_)); } H = __builtin_bit_cast(bf16x8, h_); Lw = __builtin_bit_cast(bf16x8, l_); } while (0)
            bf16x8 bh[4][2], bl[4][2];
            { const float* wp = Wr + (size_t)(128 * wave + 8 * kq) * 32 + mi;
#pragma unroll
              for (int ks = 0; ks < 4; ++ks)
#pragma unroll
                  for (int hf = 0; hf < 2; ++hf) { float w8[8];
#pragma unroll
                      for (int jj = 0; jj < 8; ++jj) w8[jj] = wp[(32 * ks + jj) * 32 + 16 * hf];
                      SPLIT8(w8, bh[ks][hf], bl[ks][hf]); } }
            for (int blk = vcu; blk < S / 64; blk += G) {
                u32x2 zr[2][4];
#pragma unroll
                for (int tt = 0; tt < 2; ++tt)
#pragma unroll
                    for (int q = 0; q < 4; ++q) zr[tt][q] = *(const u32x2*)(Z + (size_t)(blk * 64 + wave * 2 + tt) * D + 4 * lane + 256 * q);
#pragma unroll 1
                for (int g = 0; g < 4; ++g) {
#pragma unroll
                    for (int tt = 0; tt < 2; ++tt) { const int tl16 = wave * 2 + tt, tok = blk * 64 + g * 16 + tl16;
                        f32x4 v[4]; float s = 0.f;
#pragma unroll
                        for (int q = 0; q < 4; ++q) { const u32x2 zw = zr[tt][q]; v[q][0] = bf_lo(zw.x); v[q][1] = bf_hi(zw.x); v[q][2] = bf_lo(zw.y); v[q][3] = bf_hi(zw.y); s += (v[q][0] + v[q][1]) + (v[q][2] + v[q][3]); }
                        if (g < 3) {
#pragma unroll
                            for (int q = 0; q < 4; ++q) zr[tt][q] = *(const u32x2*)(Z + (size_t)(tok + 16) * D + 4 * lane + 256 * q); }
                        const float mean = wsum_fast(s) * (1.0f / D); float s2 = 0.f;
#pragma unroll
                        for (int q = 0; q < 4; ++q) { v[q] = v[q] - mean; s2 += (v[q][0] * v[q][0] + v[q][1] * v[q][1]) + (v[q][2] * v[q][2] + v[q][3] * v[q][3]); }
                        const float rstd = 1.0f / sqrtf(wsum_fast(s2) * (1.0f / D) + LN_EPS);
#pragma unroll
                        for (int q = 0; q < 4; ++q) { v[q] = v[q] * rstd * gv[q] + bv[q];
                            u32x2 w; w.x = cvt_pk_bf16(v[q][0], v[q][1]); w.y = cvt_pk_bf16(v[q][2], v[q][3]); *(u32x2*)(XB1 + (size_t)tok * D + 4 * lane + 256 * q) = w;
#if MOE_FP8
                            *(unsigned*)(XF8 + (size_t)tok * D + 4 * lane + 256 * q) = pg8::pack4_fp8(v[q][0], v[q][1], v[q][2], v[q][3]);
#endif
                            *(LAS f32x4*)(XS + tl16 * XP + 4 * lane + 256 * q) = v[q]; }
                    }
                    __syncthreads();
                    f32x4 acc0 = {0.f, 0.f, 0.f, 0.f}, acc1 = {0.f, 0.f, 0.f, 0.f};
#pragma unroll
                    for (int ks = 0; ks < 4; ++ks) { const f32x4 a0 = *(const LAS f32x4*)(XS + mi * XP + 128 * wave + 32 * ks + 8 * kq), a1 = *(const LAS f32x4*)(XS + mi * XP + 128 * wave + 32 * ks + 8 * kq + 4);
                        const float x8[8] = {a0[0], a0[1], a0[2], a0[3], a1[0], a1[1], a1[2], a1[3]}; bf16x8 xh, xl; SPLIT8(x8, xh, xl);
                        acc0 = __builtin_amdgcn_mfma_f32_16x16x32_bf16(xh, bh[ks][0], acc0, 0, 0, 0); acc1 = __builtin_amdgcn_mfma_f32_16x16x32_bf16(xh, bh[ks][1], acc1, 0, 0, 0);
                        acc0 = __builtin_amdgcn_mfma_f32_16x16x32_bf16(xh, bl[ks][0], acc0, 0, 0, 0); acc1 = __builtin_amdgcn_mfma_f32_16x16x32_bf16(xh, bl[ks][1], acc1, 0, 0, 0);
                        acc0 = __builtin_amdgcn_mfma_f32_16x16x32_bf16(xl, bh[ks][0], acc0, 0, 0, 0); acc1 = __builtin_amdgcn_mfma_f32_16x16x32_bf16(xl, bh[ks][1], acc1, 0, 0, 0); }
                    *(LAS f32x4*)(PART + (wave * 64 + lane) * 8) = acc0; *(LAS f32x4*)(PART + (wave * 64 + lane) * 8 + 4) = acc1;
                    __syncthreads();
                    const int tw = wave * 2 + (lane >> 5), e = lane & 31, sl = (e & 15) + 16 * (tw >> 2), sc = (e >> 4) * 4 + (tw & 3);
                    float lg = rb[e];
#pragma unroll
                    for (int w2 = 0; w2 < 8; ++w2) lg += PART[(w2 * 64 + sl) * 8 + sc];
                    const unsigned ub = __float_as_uint(lg); const unsigned key = (((ub & 0x80000000u) ? ~ub : (ub | 0x80000000u)) & ~31u) | (unsigned)(31 - e);
                    int rank = 4; unsigned kk = key;
#pragma unroll
                    for (int rd = 0; rd < 4; ++rd) { unsigned mx = kk, o_;
                        o_ = (unsigned)__builtin_amdgcn_update_dpp(0, (int)mx, 0xB1, 0xF, 0xF, true); mx = mx > o_ ? mx : o_;
                        o_ = (unsigned)__builtin_amdgcn_update_dpp(0, (int)mx, 0x4E, 0xF, 0xF, true); mx = mx > o_ ? mx : o_;
                        o_ = (unsigned)__builtin_amdgcn_update_dpp(0, (int)mx, 0x124, 0xF, 0xF, true); mx = mx > o_ ? mx : o_;
                        o_ = (unsigned)__builtin_amdgcn_update_dpp(0, (int)mx, 0x128, 0xF, 0xF, true); mx = mx > o_ ? mx : o_;
                        { const auto rr = __builtin_amdgcn_permlane16_swap(mx, mx, false, false); mx = rr[0] > rr[1] ? rr[0] : rr[1]; }
                        if (kk == mx) { rank = rd; kk = 0u; } }
                    const unsigned long long m0 = __ballot(rank == 0);
                    const float va = __uint_as_float((unsigned)__builtin_amdgcn_readlane((int)__float_as_uint(lg), __builtin_ctz((unsigned)m0)));
                    const float vb = __uint_as_float((unsigned)__builtin_amdgcn_readlane((int)__float_as_uint(lg), 32 + __builtin_ctz((unsigned)(m0 >> 32))));
                    const float v0 = (lane & 32) ? vb : va;
                    const float ex = (rank < 4) ? fast_exp2((lg - v0) * LOG2E) : 0.f;
                    float se = ex; se += dppx<0xB1>(se); se += dppx<0x4E>(se); se += dppx<0x124>(se); se += dppx<0x128>(se);
                    { auto rr = __builtin_amdgcn_permlane16_swap(__float_as_uint(se), __float_as_uint(se), false, false); se = __uint_as_float(rr[0]) + __uint_as_float(rr[1]); }
                    if (rank < 4) { const int tl = g * 16 + tw; const float ww = ex / se;
                        const int rk = __hip_atomic_fetch_add(&hist[e], 1, __ATOMIC_RELAXED, __HIP_MEMORY_SCOPE_WORKGROUP); sel[(tl * 4 + rank) * 3 + 0] = e; sel[(tl * 4 + rank) * 3 + 1] = rk; sel[(tl * 4 + rank) * 3 + 2] = __float_as_int(ww); }
                    __syncthreads();
                }
                if (tid < 32) { const int n = hist[tid]; basep[tid] = n ? (int)__hip_atomic_fetch_add((unsigned*)(ctl + CW_CNT + (L * 32 + tid) * 16), (unsigned)n, __ATOMIC_RELAXED, __HIP_MEMORY_SCOPE_AGENT) : 0; }
                __syncthreads();
                if (tid < 256) { const int ee = sel[tid * 3], pos = basep[ee] + sel[tid * 3 + 1]; const int tok = blk * 64 + (tid >> 2);
                    TOK[(size_t)ee * S + pos] = tok; GATE[(size_t)ee * S + pos] = __int_as_float(sel[tid * 3 + 2]); SLOT[((size_t)tok * 4 + (tid & 3)) * 2] = ee; SLOT[((size_t)tok * 4 + (tid & 3)) * 2 + 1] = pos; }
                __syncthreads();
                if (tid < 32) hist[tid] = 0;
                __syncthreads();
            }
        }
        SEAM(pb + 4);
        if (IN(pb + 5) || IN(pb + 6) || IN(pb + 7)) { TID_DECL;
            LAS int* toff = (LAS int*)(lds + LM_TOFF); LAS int* cntl = (LAS int*)(lds + LM_CNT);
            __syncthreads();
            if (wave == 0) { const int e = tid & 31;
                const int c = (int)__hip_atomic_load((unsigned*)(ctl + CW_CNT + (L * 32 + e) * 16), __ATOMIC_RELAXED, __HIP_MEMORY_SCOPE_AGENT); const int nt = (tid < 32) ? (c + 255) >> 8 : 0;
                int incl = nt;
#pragma unroll
                for (int dlt = 1; dlt < 32; dlt <<= 1) { const int o = __shfl_up(incl, dlt); if ((tid & 63) >= dlt) incl += o; }
                if (tid < 32) { cntl[e] = c; toff[e] = incl - nt; if (tid == 31) toff[32] = incl; } }
            __syncthreads();
            if (tid < 320) { int e = 0;
#pragma unroll
                for (int stp = 16; stp >= 1; stp >>= 1) { if (e + stp <= 31 && toff[e + stp] <= tid) e += stp; }
                ((LAS int*)(lds + LM_T2E))[tid] = e; }
            __syncthreads();
        }
        if (PHE(9) && IN(pb + 5)) REP(9) { WS_DECL;
#if MOE_FP8
            { pg8::Gemm g{(const bf16_t*)XF8, (const bf16_t*)(ws + WS_W1 + (size_t)L * 32 * 2048 * 1024), 512, (size_t)2048 * 512, wave};
#else
            { pg8::Gemm g{XB1, (const bf16_t*)(ws + WS_W1) + (size_t)L * 32 * 2048 * 1024, 1024, (size_t)2048 * 1024, wave};
#endif
              pg8::MoeOrder<true> So{(const LAS int*)(lds + LM_TOFF), (const LAS int*)(lds + LM_CNT), (const LAS int*)(lds + LM_T2E), TOK, 8, G, vcu};
              pg8::EpiMoeAct E{(unsigned char*)HS, ARGIN(I_EBIN) + (size_t)L * 32 * 2048};
              pg8::gemm_phase<pg8::EpiMoeAct, pg8::MoeOrder<true>, true>(lds, g, So, E); }
#if MOE_FP8
            { pg8::Gemm g{(const bf16_t*)XF8, (const bf16_t*)(ws + WS_WPG + (size_t)L * 1024 * 1024), 512, 0, wave}; pg8::StaticOrder So; So.init(S, D, G, bx);
#else
            { pg8::Gemm g{XB1, (const bf16_t*)(ws + WS_WPG) + (size_t)L * 1024 * 1024, 1024, 0, wave}; pg8::StaticOrder So; So.init(S, D, G, bx);
#endif
              pg8::EpiPle E{XB1, PP + (size_t)L * S * D, Z2};
              pg8::gemm_phase<pg8::EpiPle, pg8::StaticOrder, false>(lds, g, So, E); }
        }
        SEAM(pb + 5);
        if (PHE(10) && IN(pb + 6)) REP(10) { WS_DECL;
#if MOE_FP8
            pg8::Gemm g{HS, (const bf16_t*)(ws + WS_W2 + (size_t)L * 32 * 1024 * 1024), 512, (size_t)1024 * 512, wave};
#else
            pg8::Gemm g{HS, (const bf16_t*)(ws + WS_W2) + (size_t)L * 32 * 1024 * 1024, 1024, (size_t)1024 * 1024, wave};
#endif
            pg8::MoeOrder<false> So{(const LAS int*)(lds + LM_TOFF), (const LAS int*)(lds + LM_CNT), (const LAS int*)(lds + LM_T2E), TOK, 4, G, vcu};
            pg8::EpiMoeDown E{YS, ARGIN(I_EBOUT) + (size_t)L * 32 * 1024, GATE};
            pg8::gemm_phase<pg8::EpiMoeDown, pg8::MoeOrder<false>, true>(lds, g, So, E);
        }
        SEAM(pb + 6);
        if (PHE(11) && IN(pb + 7)) REP(11) { TID_DECL; WS_DECL;
            const LAS int* toff = (const LAS int*)(lds + LM_TOFF);
            const float* gam = ARGIN(I_LNFG) + L * D; const float* bet = ARGIN(I_LNFB) + L * D;
            f32x4 gv[4], bv[4];
#pragma unroll
            for (int q = 0; q < 4; ++q) { gv[q] = *(const f32x4*)(gam + 4 * lane + 256 * q); bv[q] = *(const f32x4*)(bet + 4 * lane + 256 * q); }
            for (int t0 = gw; t0 < S; t0 += 8 * NGW) {
              const int tl = t0 + (lane >> 3) * NGW; const int sw = (tl < S) ? SLOT[(size_t)tl * 8 + (lane & 7)] : 0;
#pragma unroll 1
              for (int i8 = 0; i8 < 8; ++i8) { const int tok = t0 + i8 * NGW; if (tok >= S) break;
                f32x4 v[4];
#pragma unroll
                for (int q = 0; q < 4; ++q) { const u32x2 zw = *(const u32x2*)(Z2 + (size_t)tok * D + 4 * lane + 256 * q); v[q][0] = bf_lo(zw.x); v[q][1] = bf_hi(zw.x); v[q][2] = bf_lo(zw.y); v[q][3] = bf_hi(zw.y); }
#pragma unroll
                for (int k = 0; k < 4; ++k) { const int ee = __builtin_amdgcn_readlane(sw, i8 * 8 + 2 * k), pos = __builtin_amdgcn_readlane(sw, i8 * 8 + 2 * k + 1); const bf16_t* yr = YS + ((size_t)toff[ee] * 256 + pos) * 1024;
#pragma unroll
                    for (int q = 0; q < 4; ++q) { const u32x2 w = *(const u32x2*)(yr + 4 * lane + 256 * q); v[q][0] += bf_lo(w.x); v[q][1] += bf_hi(w.x); v[q][2] += bf_lo(w.y); v[q][3] += bf_hi(w.y); } }
                float s = 0.f;
#pragma unroll
                for (int q = 0; q < 4; ++q) s += (v[q][0] + v[q][1]) + (v[q][2] + v[q][3]);
                const float mean = wave_sum(s) * (1.0f / D); float s2 = 0.f;
#pragma unroll
                for (int q = 0; q < 4; ++q) { v[q] = v[q] - mean; s2 += (v[q][0] * v[q][0] + v[q][1] * v[q][1]) + (v[q][2] * v[q][2] + v[q][3] * v[q][3]); }
                const float rstd = 1.0f / sqrtf(wave_sum(s2) * (1.0f / D) + LN_EPS);
#pragma unroll
                for (int q = 0; q < 4; ++q) { v[q] = v[q] * rstd * gv[q] + bv[q]; if (L == DEPTH - 1) *(f32x4*)(args.out + (size_t)tok * D + 4 * lane + 256 * q) = v[q];
                    u32x2 w; w.x = cvt_pk_bf16(v[q][0], v[q][1]); w.y = cvt_pk_bf16(v[q][2], v[q][3]); *(u32x2*)(XB + (size_t)tok * D + 4 * lane + 256 * q) = w; }
              }
            }
        }
        SEAM(pb + 7);
    }
}

extern "C" void kernel_launch(void* const* d_in, const int* in_sizes, int n_in, void* d_out, int out_size, void* d_ws, size_t ws_size, hipStream_t stream) {
    static int grid = 0;
    if (grid == 0) {
        if (n_in != 26 || out_size != S * D || ws_size < WS_END) { fprintf(stderr, "kernel_launch: unexpected shapes (n_in %d out %d ws %zu need %zu)\n", n_in, out_size, ws_size, (size_t)WS_END); grid = -1; return; }
        int dev = 0, cus = 0, per_cu = 0;
        if (hipGetDevice(&dev) != hipSuccess || hipDeviceGetAttribute(&cus, hipDeviceAttributeMultiprocessorCount, dev) != hipSuccess) { grid = -1; return; }
        if (hipFuncSetAttribute((const void*)mk_fwd, hipFuncAttributeMaxDynamicSharedMemorySize, LDS_BYTES) != hipSuccess) { fprintf(stderr, "kernel_launch: hipFuncSetAttribute failed\n"); grid = -1; return; }
        if (hipOccupancyMaxActiveBlocksPerMultiprocessor(&per_cu, (const void*)mk_fwd, NTHREADS, LDS_BYTES) != hipSuccess || per_cu < 1) { fprintf(stderr, "kernel_launch: occupancy query says %d\n", per_cu); }
        (void)hipGetLastError();
        grid = cus;
    }
    if (grid < 0) return;
    hipMemsetAsync((char*)d_ws + WS_CTL, 0, CTL_BYTES, stream);
    Args a{};
    for (int i = 0; i < 26; ++i) a.in[i] = (const float*)d_in[i];
    a.out = (float*)d_out; a.ws = (unsigned char*)d_ws;
    for (int i = 0; i < 16; ++i) a.inv_freq[i] = powf(10000.0f, -(float)(2 * i) / 32.0f);
    const int NPH = 2 + 8 * DEPTH;
#if MK_ONE_LAUNCH
    a.ph_lo = 0; a.ph_hi = NPH;
    hipLaunchKernelGGL(mk_fwd, dim3(grid), dim3(NTHREADS), LDS_BYTES, stream, a);
#else
    for (int ph = 0; ph < NPH; ++ph) {
        if (ph >= 2 && ((ph - 2) % 8) == 1 && (((ph - 2) / 8) & 1)) continue;
        a.ph_lo = ph; a.ph_hi = ph + 1;
        hipLaunchKernelGGL(mk_fwd, dim3(grid), dim3(NTHREADS), LDS_BYTES, stream, a);
    }
#endif
}
```

```cpp
#include <hip/hip_runtime.h>
#include <cstdio>
#include <cstdint>
#include <cmath>

#ifndef MK_ONE_LAUNCH
#define MK_ONE_LAUNCH 1
#endif
#ifndef NAIVE_ATTN
#define NAIVE_ATTN 0
#endif
#ifndef MOE_FP8
#define MOE_FP8 1
#endif
#ifndef ATT_C_FP8
#define ATT_C_FP8 1
#endif
#ifndef ATT_B_FP8
#define ATT_B_FP8 1
#endif
#ifndef REF_GEMM
#define REF_GEMM 0
#endif

#define LAS __attribute__((address_space(3)))
#define GAS __attribute__((address_space(1)))
typedef unsigned short bf16_t;
typedef short bf16x8 __attribute__((ext_vector_type(8)));
typedef float f32x4 __attribute__((ext_vector_type(4)));
typedef float f32x2 __attribute__((ext_vector_type(2)));
typedef unsigned u32x4 __attribute__((ext_vector_type(4)));
typedef unsigned u32x2 __attribute__((ext_vector_type(2)));
typedef GAS unsigned gu32;

constexpr int S = 16384, D = 1024, DEPTH = 4, PLE = 256;
constexpr int NE = 32, TOPK = 4, DFF = 1024;
constexpr int AB_IN = 2336;
constexpr float LOG2E = 1.4426950408889634f;
constexpr float DN_ALPHA = 1.681792830507429f;
constexpr float LN_EPS = 1e-5f, RMS_EPS = 1e-6f;
constexpr int NWAVES = 8, NTHREADS = 512;
constexpr int SLOT_ROWS = 65536 + NE * 256;

constexpr size_t MiB = 1u << 20;
constexpr size_t CTL_BYTES = 1 * MiB;
constexpr size_t al(size_t x) { return (x + MiB - 1) / MiB * MiB; }
constexpr size_t WS_CTL = 0;
constexpr size_t WS_TAB = WS_CTL + CTL_BYTES;
constexpr size_t TAB_ROPE = 0;
constexpr size_t TAB_WRT = 2 * MiB;
constexpr size_t TAB_BIASA = TAB_WRT + 512 * 1024;
constexpr size_t TAB_T5 = TAB_BIASA + 32 * 1024;
constexpr size_t TAB_LAM = TAB_T5 + 8 * 1024;
constexpr size_t TAB_FA = TAB_LAM + 1024;
constexpr size_t TAB_FAFAR = TAB_FA + 3 * 8 * 256 * 4;
constexpr size_t WS_WABIN = WS_TAB + 4 * MiB;
constexpr size_t WS_WUQ = WS_WABIN + al((size_t)2 * 2560 * 1024 * 2);
constexpr size_t WS_WUKVK = WS_WUQ + al((size_t)2 * 768 * 512 * 2);
constexpr size_t WS_WUKVV = WS_WUKVK + al((size_t)2 * 512 * 256 * 2);
constexpr size_t WS_WABOUT = WS_WUKVV + al((size_t)2 * 512 * 256 * 2);
constexpr size_t WS_WCIN = WS_WABOUT + al((size_t)2 * 1024 * 1024 * 2);
constexpr size_t WS_WCOUT = WS_WCIN + al((size_t)2 * 3072 * 1024 * 2);
constexpr size_t WS_WPG = WS_WCOUT + al((size_t)2 * 1024 * 1024 * 2);
constexpr size_t WS_WPP = WS_WPG + al((size_t)4 * 1024 * 1024 * 2);
constexpr size_t WS_W1 = WS_WPP + al((size_t)4 * 1024 * 256 * 2);
constexpr size_t WS_W2 = WS_W1 + al((size_t)4 * 32 * 2048 * 1024 * 2);
constexpr size_t WS_XB = WS_W2 + al((size_t)4 * 32 * 1024 * 1024 * 2);
constexpr size_t WS_PB = WS_XB + al((size_t)S * D * 2);
constexpr size_t WS_PP = WS_PB + al((size_t)4 * S * 256 * 2);
constexpr size_t WS_QA = WS_PP + al((size_t)4 * S * D * 2);
constexpr size_t WS_KA = WS_QA + al((size_t)S * 512 * 2);
constexpr size_t WS_VAT = WS_KA + al((size_t)S * 512 * 2);
constexpr size_t WS_CQ = WS_VAT + al((size_t)S * 512 * 2);
constexpr size_t WS_CKV = WS_CQ + al((size_t)S * 512 * 2);
constexpr size_t WS_SSQQ = WS_CKV + al((size_t)S * 256 * 2);
constexpr size_t WS_SSQKV = WS_SSQQ + al((size_t)S * 8 * 4);
constexpr size_t WS_QB = WS_SSQKV + al((size_t)S * 4 * 4);
constexpr size_t WS_KB = WS_QB + al((size_t)S * 768 * 2);
constexpr size_t WS_VBT = WS_KB + al((size_t)S * 768 * 2);
constexpr size_t WS_QC = WS_VBT + al((size_t)S * 512 * 2);
constexpr size_t WS_KC = WS_QC + al((size_t)S * D * 2);
constexpr size_t WS_VCT = WS_KC + al((size_t)S * D * 2);
constexpr size_t WS_OAB = WS_VCT + al((size_t)S * D * 2);
constexpr size_t WS_Z = WS_OAB + al((size_t)S * D * 2);
constexpr size_t WS_X1 = WS_Z + al((size_t)S * D * 4);
constexpr size_t WS_XB1 = WS_X1 + al((size_t)S * D * 4);
constexpr size_t WS_Z2 = WS_XB1 + al((size_t)S * D * 2);
constexpr size_t WS_HS = WS_Z2 + al((size_t)S * D * 4);
constexpr size_t WS_YS = WS_HS + al((size_t)SLOT_ROWS * 1024 * 2);
constexpr size_t WS_TOK = WS_YS + al((size_t)SLOT_ROWS * 1024 * 2);
constexpr size_t WS_GATE = WS_TOK + al((size_t)NE * S * 4);
constexpr size_t WS_SLOT = WS_GATE + al((size_t)NE * S * 4);
constexpr size_t WS_XF8 = WS_SLOT + al((size_t)S * 4 * 8);
constexpr size_t WS_END = WS_XF8 + al((size_t)S * D);

constexpr int CW_BAR = 4096;
constexpr int CW_CNT = 16384;

constexpr int LDS_BYTES = 147456;
constexpr int LM = 131072;
constexpr int LM_BAR = LM + 0;
constexpr int LM_TOFF = LM + 64;
constexpr int LM_CNT = LM + 256;
constexpr int LM_HIST = LM + 512;
constexpr int LM_BASE = LM + 640;
constexpr int LM_SEL = LM + 1024;
constexpr int LM_FLAG = LM + 32;
constexpr int LM_T2E = LM + 4608;
constexpr int LM_FREE = LM + 8192;

__device__ __forceinline__ unsigned cvt_pk_bf16(float lo, float hi) { unsigned r; asm volatile("v_cvt_pk_bf16_f32 %0, %1, %2" : "=v"(r) : "v"(lo), "v"(hi)); return r; }
__device__ __forceinline__ float bf_lo(unsigned w) { return __uint_as_float(w << 16); }
__device__ __forceinline__ float bf_hi(unsigned w) { return __uint_as_float(w & 0xffff0000u); }
__device__ __forceinline__ float bf2f(bf16_t h) { return __uint_as_float(((unsigned)h) << 16); }
__device__ __forceinline__ float wave_sum(float v) {
#pragma unroll
    for (int o = 1; o < 64; o <<= 1) v += __shfl_xor(v, o);
    return v;
}
__device__ __forceinline__ float wave_max(float v) {
#pragma unroll
    for (int o = 1; o < 64; o <<= 1) v = fmaxf(v, __shfl_xor(v, o));
    return v;
}
__device__ __forceinline__ float rdlane(float v, int l) { return __uint_as_float((unsigned)__builtin_amdgcn_readlane((int)__float_as_uint(v), l)); }
__device__ __forceinline__ float fast_exp2(float x) { return __builtin_amdgcn_exp2f(x); }
__device__ __forceinline__ float fast_rcp(float x) { return __builtin_amdgcn_rcpf(x); }
__device__ __forceinline__ float sigmoidf_(float x) { return fast_rcp(1.0f + fast_exp2(-x * LOG2E)); }
__device__ __forceinline__ int lane_id_asm() { int l; asm volatile("v_mbcnt_lo_u32_b32 %0, -1, 0\n\tv_mbcnt_hi_u32_b32 %0, -1, %0" : "=v"(l)); return l; }
template <int CTRL> __device__ __forceinline__ float dppx(float v) { return __uint_as_float((unsigned)__builtin_amdgcn_update_dpp(0, (int)__float_as_uint(v), CTRL, 0xF, 0xF, true)); }
__device__ __forceinline__ float xpart16(float v, int lane) { auto rr = __builtin_amdgcn_permlane16_swap(__float_as_uint(v), __float_as_uint(v), false, false); return __uint_as_float((lane & 16) ? rr[0] : rr[1]); }
__device__ __forceinline__ float xpart32(float v, int lane) { auto rr = __builtin_amdgcn_permlane32_swap(__float_as_uint(v), __float_as_uint(v), false, false); return __uint_as_float((lane & 32) ? rr[0] : rr[1]); }
__device__ __forceinline__ float wsum_fast(float v) {
    v += dppx<0xB1>(v); v += dppx<0x4E>(v); v += dppx<0x124>(v); v += dppx<0x128>(v);
    { auto rr = __builtin_amdgcn_permlane16_swap(__float_as_uint(v), __float_as_uint(v), false, false); v = __uint_as_float(rr[0]) + __uint_as_float(rr[1]); }
    { auto rr = __builtin_amdgcn_permlane32_swap(__float_as_uint(v), __float_as_uint(v), false, false); v = __uint_as_float(rr[0]) + __uint_as_float(rr[1]); }
    return v;
}
#define LDS_WAIT() asm volatile("s_waitcnt lgkmcnt(0)" ::: "memory")
#define VM_WAIT() asm volatile("s_waitcnt vmcnt(0)" ::: "memory")

#define XB_TMO      128
#define XB_XCNT(j)  (256  + 64 * (j))
#define XB_XSUB(j)  (1280 + 64 * (j))
#define XB_XGEN(j)  (2304 + 64 * (j))
#define XB_TOP      3328
#define XB_TOPGEN   3392
#define XCD_BAR_WORDS 3456
#define XB_SPIN_CAP (1u << 22)
__device__ __forceinline__ unsigned xb_ld(unsigned* p)              { return __hip_atomic_load(p, __ATOMIC_RELAXED, __HIP_MEMORY_SCOPE_AGENT); }
__device__ __forceinline__ unsigned xb_add(unsigned* p, unsigned v) { return __hip_atomic_fetch_add(p, v, __ATOMIC_RELAXED, __HIP_MEMORY_SCOPE_AGENT); }
__device__ __forceinline__ unsigned xb_xcc_id() { return (unsigned)__builtin_amdgcn_s_getreg((3 << 11) | 20) & 0xFu; }
#define XB_SPIN(cond, bar) do { unsigned _sp = 0; while (cond) { __builtin_amdgcn_s_sleep(1); \
    if ((++_sp & 255u) == 0u) { if (xb_ld(&(bar)[XB_TMO])) break; if (_sp > XB_SPIN_CAP) { atomicAdd(&(bar)[XB_TMO], 1u); break; } } } } while (0)
struct XcdBarrier { unsigned* bar; unsigned x; volatile LAS unsigned* st; };
__device__ __forceinline__ XcdBarrier xcd_barrier_post(unsigned* bar, volatile LAS unsigned* st) {
    XcdBarrier b; b.bar = bar; b.x = xb_xcc_id(); b.st = st;
    if (threadIdx.x == 0) (void)xb_add(&bar[XB_XCNT(b.x)], 1u);
    return b;
}
__device__ __forceinline__ void xcd_barrier_complete(unsigned* bar, unsigned x, unsigned& nloc, unsigned& nx) {
    const unsigned G = gridDim.x * gridDim.y * gridDim.z;
    unsigned sum, cnt, mine, sp = 0u;
    for (;;) {
        sum = 0u; cnt = 0u; mine = 0u;
#pragma unroll
        for (unsigned j = 0; j < 16; ++j) { const unsigned c = xb_ld(&bar[XB_XCNT(j)]); sum += c; cnt += (c > 0u) ? 1u : 0u; mine = (j == x) ? c : mine; }
        if (sum == G) break;
        __builtin_amdgcn_s_sleep(1);
        if ((++sp & 255u) == 0u) { if (xb_ld(&bar[XB_TMO])) break; if (sp > XB_SPIN_CAP) { atomicAdd(&bar[XB_TMO], 1u); break; } }
    }
    nloc = mine > 0u ? mine : 1u; nx = cnt > 0u ? cnt : 1u;
}
__device__ __forceinline__ void xcd_barrier(const XcdBarrier& b) {
    asm volatile("s_waitcnt vmcnt(0)" ::: "memory");
    __syncthreads();
    if (threadIdx.x == 0) {
        unsigned* bar = b.bar;
        __builtin_amdgcn_s_waitcnt(0);
        unsigned nloc = b.st[0], nx = b.st[1];
        if (nloc == 0u) { xcd_barrier_complete(bar, b.x, nloc, nx); b.st[0] = nloc; b.st[1] = nx; }
        const unsigned old = xb_add(&bar[XB_XSUB(b.x)], 1u);
        const unsigned gen = old / nloc;
        if (old + 1u == (gen + 1u) * nloc) {
            __builtin_amdgcn_fence(__ATOMIC_RELEASE, "agent");
            asm volatile("s_waitcnt vmcnt(0)" ::: "memory");
            const unsigned og = xb_add(&bar[XB_TOP], 1u);
            const unsigned tg = og / nx;
            if (og + 1u == (tg + 1u) * nx) xb_add(&bar[XB_TOPGEN], 1u);
            else XB_SPIN(xb_ld(&bar[XB_TOPGEN]) == tg, bar);
            __builtin_amdgcn_fence(__ATOMIC_ACQUIRE, "agent");
            xb_add(&bar[XB_XGEN(b.x)], 1u);
            asm volatile("s_waitcnt vmcnt(0)" ::: "memory");
        } else {
            XB_SPIN(xb_ld(&bar[XB_XGEN(b.x)]) == gen, bar);
            __builtin_amdgcn_fence(__ATOMIC_ACQUIRE, "agent");
            asm volatile("s_waitcnt vmcnt(0)" ::: "memory");
        }
    }
    __syncthreads();
}

namespace pg8 {
constexpr int BM = 256, BK = 64, HALF = 128, HTB = HALF * BK * 2, STAGE_BYTES = 8 * HTB, NXCD = 8, WGM = 8;
__host__ __device__ __forceinline__ int lds_byte(int r, int c) { const int st = (r >> 4) * 2 + (c >> 5), rr = r & 15, cc = c & 31, ob = rr * 64 + cc * 2; return st * 1024 + (ob ^ (((ob >> 9) & 1) << 5)); }
__host__ __device__ __forceinline__ void stage_rc(int b, int& R, int& C) { const int st = b / 1024, sb = b % 1024, swz = sb ^ (((sb >> 9) & 1) << 5); R = (st >> 1) * 16 + swz / 64; C = (st & 1) * 32 + (swz % 64) / 2; }
__host__ __device__ __forceinline__ int perm32(int rho) { const int n = rho >> 4, i = rho & 15; return 8 * (i >> 2) + 4 * n + (i & 3); }

struct Unit { int pm, pn, e, aux; };
struct Gemm { const bf16_t* A; const bf16_t* Bt; int K; size_t strideBe; int wave; };

struct StaticOrder {
    static constexpr bool GATHER = false;
    int nM, nN, nwg, G, c;
    __device__ __forceinline__ void init(int M, int N, int G_, int c_) { nM = M / BM; nN = N / BM; nwg = nM * nN; G = G_; c = c_; }
    __device__ __forceinline__ bool next(int i, Unit& u) const {
        const long L = (long)i * G + c; if (L >= nwg) return false;
        int wgid = (int)L; { const int q = nwg / NXCD, r = nwg % NXCD, xcd = wgid % NXCD, off = wgid / NXCD; wgid = (xcd < r ? xcd * (q + 1) : r * (q + 1) + (xcd - r) * q) + off; }
        const int nig = WGM * nN, gid = wgid / nig, fm = gid * WGM, gsz = (nM - fm) < WGM ? (nM - fm) : WGM;
        u.pm = fm + ((wgid % nig) % gsz); u.pn = (wgid % nig) / gsz; u.e = 0; u.aux = 0; return true;
    }
    __device__ __forceinline__ int arow(const Unit& u, int r) const { return u.pm * BM + r; }
};

#define PG8_SA(b, h) (((b) * 2 + (h)) * HTB)
#define PG8_SB(b, h) ((4 + (b) * 2 + (h)) * HTB)
__device__ __forceinline__ const char* uniform_ptr(const void* p) { const unsigned long long a = (unsigned long long)p; const unsigned lo = (unsigned)__builtin_amdgcn_readfirstlane((int)(unsigned)a), hi = (unsigned)__builtin_amdgcn_readfirstlane((int)(unsigned)(a >> 32)); return (const char*)(((unsigned long long)hi << 32) | lo); }
__device__ __forceinline__ void glds_sv(const void* base, unsigned voff, unsigned ldsaddr) { unsigned keep;
    asm volatile("s_mov_b32 %0, m0\n\ts_mov_b32 m0, %3\n\ts_nop 0\n\tglobal_load_lds_dwordx4 %1, %2\n\ts_mov_b32 m0, %0" : "=&s"(keep) : "v"(voff), "s"(base), "s"(ldsaddr) : "memory"); }
__device__ __forceinline__ void glds_dw(const void* base, unsigned voff, unsigned ldsaddr) { unsigned keep;
    asm volatile("s_mov_b32 %0, m0\n\ts_mov_b32 m0, %3\n\ts_nop 0\n\tglobal_load_lds_dword %1, %2\n\ts_mov_b32 m0, %0" : "=&s"(keep) : "v"(voff), "s"(base), "s"(ldsaddr) : "memory"); }
#define PG8_STAGE_B(bufoff, gbase) do { _Pragma("unroll") for (int _i = 0; _i < 2; ++_i) \
        glds_sv((const char*)(gbase), voffB[_i], ldsbase + (unsigned)((bufoff) + _i * 8192)); } while (0)
#define PG8_STAGE_A(bufoff, kofs, W, h) do { _Pragma("unroll") for (int _i = 0; _i < 2; ++_i) { \
        if constexpr (GATH) glds_sv(gA + (kofs), v##W[(h) % NH][_i], ldsbase + (unsigned)((bufoff) + _i * 8192)); \
        else glds_sv(u##W + (kofs) + (size_t)(h) * hstep, voffA[_i], ldsbase + (unsigned)((bufoff) + _i * 8192)); } } while (0)
typedef int i32x8 __attribute__((ext_vector_type(8)));
typedef int i32x4 __attribute__((ext_vector_type(4)));
__device__ __forceinline__ i32x8 ld_pair(const LAS unsigned char* p) { const i32x4 x = *(const LAS i32x4*)p, y = *(const LAS i32x4*)(p + 1024); return __builtin_shufflevector(x, y, 0, 1, 2, 3, 4, 5, 6, 7); }
__device__ __forceinline__ bf16x8 half_lo(i32x8 v) { const i32x4 x = __builtin_shufflevector(v, v, 0, 1, 2, 3); return __builtin_bit_cast(bf16x8, x); }
__device__ __forceinline__ bf16x8 half_hi(i32x8 v) { const i32x4 x = __builtin_shufflevector(v, v, 4, 5, 6, 7); return __builtin_bit_cast(bf16x8, x); }
#define PG8_LDA(dst, b, h) do { _Pragma("unroll") for (int m = 0; m < 4; ++m) dst[m] = ld_pair(lds + PG8_SA(b, h) + aoff + m * 2048); } while (0)
#define PG8_LDB(dst, b, h) do { _Pragma("unroll") for (int n = 0; n < 2; ++n) dst[n] = ld_pair(lds + PG8_SB(b, h) + boff + n * 2048); } while (0)
#define PG8_MMA(ai, bj, At, Bt) do { __builtin_amdgcn_s_setprio(1); _Pragma("unroll") for (int m = 0; m < 4; ++m) _Pragma("unroll") for (int n = 0; n < 2; ++n) { \
        if constexpr (Epi::FP8) asm volatile("v_mfma_scale_f32_16x16x128_f8f6f4 %0, %1, %2, %0, %3, %3 op_sel_hi:[0,0,0]" : "+v"(acc[ai][bj][m][n]) : "v"(Bt[n]), "v"(At[m]), "v"(0x7F7F7F7F)); \
        else { acc[ai][bj][m][n] = __builtin_amdgcn_mfma_f32_16x16x32_bf16(half_lo(Bt[n]), half_lo(At[m]), acc[ai][bj][m][n], 0, 0, 0); \
               acc[ai][bj][m][n] = __builtin_amdgcn_mfma_f32_16x16x32_bf16(half_hi(Bt[n]), half_hi(At[m]), acc[ai][bj][m][n], 0, 0, 0); } } \
        __builtin_amdgcn_s_setprio(0); } while (0)
#define PG8_WAIT_V(n) asm volatile("s_waitcnt vmcnt(" #n ")" ::: "memory")
#define PG8_WAIT_L(n) asm volatile("s_waitcnt lgkmcnt(" #n ")" ::: "memory")
#define PG8_BAR __builtin_amdgcn_s_barrier()
#define PG8_SCHED __builtin_amdgcn_sched_barrier(0)
#define PG8_SETOFF(W, UN) do { if constexpr (GATH) { _Pragma("unroll") for (int _i = 0; _i < 2; ++_i) { int _R, _C; stage_rc(tid * 16 + _i * 8192, _R, _C); \
        _Pragma("unroll") for (int _h = 0; _h < 2; ++_h) v##W[_h][_i] = (unsigned)S.arow((UN), _h * HALF + _R) * (unsigned)(K * 2) + (unsigned)_C * 2u; } } \
        else { u##W = gA + (size_t)S.arow((UN), 0) * (size_t)(K * 2); } } while (0)
#define PG8_ZERO_ACC() do { _Pragma("unroll") for (int a = 0; a < 2; ++a) _Pragma("unroll") for (int b = 0; b < 2; ++b) _Pragma("unroll") for (int m = 0; m < 4; ++m) _Pragma("unroll") for (int n = 0; n < 2; ++n) acc[a][b][m][n] = (f32x4){0.f, 0.f, 0.f, 0.f}; } while (0)
#define PG8_KPASS(k1, k2, b2, b3, W) do { \
            PG8_LDB(B0, 0, 0); PG8_LDB(B1, 0, 1); PG8_SCHED; PG8_LDA(At, 0, 0); PG8_STAGE_A(PG8_SA(1, 1), k1, cur, 1); \
            PG8_WAIT_V(8); PG8_WAIT_L(0); PG8_BAR; PG8_MMA(0, 0, At, B0); PG8_MMA(0, 1, At, B1); PG8_BAR; PG8_SCHED; \
            PG8_LDA(At, 0, 1); PG8_STAGE_B(PG8_SB(0, 0), b2); PG8_STAGE_B(PG8_SB(0, 1), (b2) + hstep); PG8_STAGE_A(PG8_SA(0, 0), k2, W, 0); \
            PG8_WAIT_V(8); PG8_WAIT_L(0); PG8_BAR; PG8_MMA(1, 0, At, B0); PG8_MMA(1, 1, At, B1); PG8_BAR; PG8_SCHED; \
            PG8_LDB(B0, 1, 0); PG8_LDB(B1, 1, 1); PG8_SCHED; PG8_LDA(At, 1, 0); PG8_STAGE_A(PG8_SA(0, 1), k2, W, 1); \
            PG8_WAIT_V(8); PG8_WAIT_L(0); PG8_BAR; PG8_MMA(0, 0, At, B0); PG8_MMA(0, 1, At, B1); PG8_BAR; PG8_SCHED; \
            PG8_LDA(At, 1, 1); PG8_STAGE_B(PG8_SB(1, 0), b3); PG8_STAGE_B(PG8_SB(1, 1), (b3) + hstep); PG8_STAGE_A(PG8_SA(1, 0), (k2) + kstep, W, 0); \
            PG8_WAIT_V(8); PG8_WAIT_L(0); PG8_BAR; PG8_MMA(1, 0, At, B0); PG8_MMA(1, 1, At, B1); PG8_BAR; PG8_SCHED; } while (0)

struct NoPre {};
template <class T, class = void> struct EpiHasPre { static constexpr bool value = false; };
template <class T> struct EpiHasPre<T, decltype((void)sizeof(typename T::Pre))> { static constexpr bool value = true; };
template <class Epi> __device__ __forceinline__ auto epi_pre(const Epi& E, const Unit& u, int wr, int wc) { if constexpr (EpiHasPre<Epi>::value) return E.pre(u, wr, wc); else return NoPre{}; }
#if !REF_GEMM
template <class Epi, class Sched, bool ALIGN_EPI>
__device__ __forceinline__ void gemm_phase(LAS unsigned char* lds, const Gemm g, const Sched& S, const Epi& E) {
    const int wid = g.wave, lane = lane_id_asm(), tid = wid * 64 + lane,
              wr = wid >> 2, wc = wid & 3, fr = lane & 15, fq = lane >> 4;
    const int K = g.K, nt = K / BK;
    constexpr bool GATH = Sched::GATHER; constexpr int NH = GATH ? 2 : 1;
    unsigned voffA[2], voffB[2];
#pragma unroll
    for (int i = 0; i < 2; ++i) { int R, C; stage_rc(tid * 16 + i * 8192, R, C); const int Rb = Epi::PERM ? ((R & ~31) + perm32(R & 31)) : R; voffA[i] = (unsigned)(R * K + C) * 2u; voffB[i] = (unsigned)(Rb * K + C) * 2u; }
    const size_t kstep = (size_t)(BK * 2);
    const size_t hstep = (size_t)HALF * K * 2;
    const size_t tstep = 2 * hstep;
    const unsigned ldsbase = (unsigned)__builtin_amdgcn_readfirstlane((int)((unsigned)(size_t)lds + (unsigned)wid * 1024u));
    const int aoff = lds_byte(wr * 64 + fr, fq * 8), boff = lds_byte(wc * 32 + fr, fq * 8);
    Unit cur, nxt; int ui = 0;
    if (!S.next(0, cur)) return;
    f32x4 acc[2][2][4][2];
    PG8_ZERO_ACC();
    i32x8 At[4], B0[2], B1[2];
    const char* gA = (const char*)g.A;
    const char* cB = (const char*)(g.Bt + (size_t)cur.e * g.strideBe) + (size_t)cur.pn * tstep;
    unsigned vcur[NH][2], vnxt[NH][2]; const char* ucur = gA; const char* unxt = gA;
    (void)vcur; (void)vnxt; (void)ucur; (void)unxt; (void)voffA;
    PG8_SETOFF(cur, cur);
    PG8_STAGE_B(PG8_SB(0, 0), cB); PG8_STAGE_B(PG8_SB(0, 1), cB + hstep); PG8_STAGE_A(PG8_SA(0, 0), 0, cur, 0); PG8_STAGE_A(PG8_SA(0, 1), 0, cur, 1);
    if (wr == 1) PG8_BAR;
    PG8_WAIT_V(2); PG8_BAR;
    PG8_STAGE_B(PG8_SB(1, 0), cB + kstep); PG8_STAGE_A(PG8_SA(1, 0), kstep, cur, 0); PG8_STAGE_B(PG8_SB(1, 1), cB + hstep + kstep);
    PG8_WAIT_V(6); PG8_BAR;
    for (;;) {
        const bool has_next = S.next(ui + 1, nxt);
        const char* nB = cB;
        if (has_next) { nB = (const char*)(g.Bt + (size_t)nxt.e * g.strideBe) + (size_t)nxt.pn * tstep;
            if constexpr (GATH) {
                const unsigned scr = (unsigned)(LM_FREE + wid * 1024 + lane * 4);
                if (ui == 0) { PG8_SETOFF(nxt, nxt); }
                else {
#pragma unroll
                    for (int _i = 0; _i < 2; ++_i) { int _R, _C; stage_rc(tid * 16 + _i * 8192, _R, _C);
#pragma unroll
                        for (int _h = 0; _h < 2; ++_h) vnxt[_h][_i] = (unsigned)(*(const LAS int*)(lds + scr + (_h * 2 + _i) * 256)) * (unsigned)(K * 2) + (unsigned)_C * 2u; }
                }
                Unit n2;
                if (S.next(ui + 2, n2)) { asm volatile("s_waitcnt lgkmcnt(0)" ::: "memory");
#pragma unroll
                    for (int _i = 0; _i < 2; ++_i) { int _R, _C; stage_rc(tid * 16 + _i * 8192, _R, _C);
#pragma unroll
                        for (int _h = 0; _h < 2; ++_h) glds_dw(uniform_ptr(S.tokbase(n2)), S.tokidx(n2, _h * HALF + _R) * 4u, (unsigned)__builtin_amdgcn_readfirstlane((int)((unsigned)(size_t)lds + (unsigned)(LM_FREE + wid * 1024 + (_h * 2 + _i) * 256)))); }
                }
            } else { PG8_SETOFF(nxt, nxt); }
        }
        else { unxt = ucur;
#pragma unroll
            for (int h = 0; h < NH; ++h)
#pragma unroll
                for (int i = 0; i < 2; ++i) vnxt[h][i] = vcur[h][i];
        }
        int t = 0;
#pragma clang loop unroll(disable)
        for (; t < nt - 2; t += 2) {
            const size_t k1 = (size_t)(t + 1) * kstep, k2 = (size_t)(t + 2) * kstep; const char* b2 = cB + k2; const char* b3 = b2 + kstep;
            PG8_KPASS(k1, k2, b2, b3, cur);
        }
        const auto pre = epi_pre(E, cur, wr, wc);
        {
            const size_t k1 = (size_t)(t + 1) * kstep; const char* b3 = nB + kstep;
            PG8_KPASS(k1, (size_t)0, nB, b3, nxt);
            cB = nB;
        }
        if constexpr (ALIGN_EPI) { if (wr == 0) PG8_BAR; }
        if constexpr (Epi::FP8) asm volatile("s_nop 15\n\ts_nop 15" ::: "memory");
        if constexpr (EpiHasPre<Epi>::value) E(acc, cur, wr, wc, fr, fq, pre); else E(acc, cur, wr, wc, fr, fq);
        if (!has_next) break;
        PG8_ZERO_ACC();
        cur = nxt; ++ui; ucur = unxt;
#pragma unroll
        for (int h = 0; h < NH; ++h)
#pragma unroll
            for (int i = 0; i < 2; ++i) vcur[h][i] = vnxt[h][i];
        if constexpr (ALIGN_EPI) { if (wr == 1) PG8_BAR; }
    }
    PG8_WAIT_V(0);
    if constexpr (!ALIGN_EPI) { if (wr == 0) PG8_BAR; }
    PG8_BAR;
}
#else
template <class Epi, class Sched, bool ALIGN_EPI>
__device__ __forceinline__ void gemm_phase(LAS unsigned char* lds, const Gemm g, const Sched& S, const Epi& E) {
    const int wid = g.wave, lane = lane_id_asm(), wr = wid >> 2, wc = wid & 3, fr = lane & 15, fq = lane >> 4;
    const int K = g.K;
    Unit u;
    for (int ui = 0; S.next(ui, u); ++ui) {
        f32x4 acc[2][2][4][2];
        const bf16_t* Bb = g.Bt + (size_t)u.e * g.strideBe + (size_t)u.pn * 256 * K;
        for (int ai = 0; ai < 2; ++ai) for (int m = 0; m < 4; ++m) {
            const bf16_t* ap = g.A + (size_t)S.arow(u, ai * 128 + wr * 64 + m * 16 + fr) * K;
            for (int bj = 0; bj < 2; ++bj) for (int n = 0; n < 2; ++n) { f32x4 r;
                for (int j = 0; j < 4; ++j) {
                    const int col = 128 * bj + 32 * wc + (Epi::PERM ? 8 * fq + 4 * n + j : 16 * n + 4 * fq + j);
                    const bf16_t* bp = Bb + (size_t)col * K; float s = 0.f;
                    for (int k = 0; k < K; k += 8) { const u32x4 a = *(const u32x4*)(ap + k), b = *(const u32x4*)(bp + k);
                        s += bf_lo(a.x) * bf_lo(b.x) + bf_hi(a.x) * bf_hi(b.x) + bf_lo(a.y) * bf_lo(b.y) + bf_hi(a.y) * bf_hi(b.y) + bf_lo(a.z) * bf_lo(b.z) + bf_hi(a.z) * bf_hi(b.z) + bf_lo(a.w) * bf_lo(b.w) + bf_hi(a.w) * bf_hi(b.w); }
                    r[j] = s; }
                acc[ai][bj][m][n] = r; } }
        E(acc, u, wr, wc, fr, fq);
    }
}
#endif

typedef const f32x4 (&AccRef)[2][2][4][2];
__device__ __forceinline__ u32x4 pack8(f32x4 v0, f32x4 v1) { u32x4 w; w.x = cvt_pk_bf16(v0[0], v0[1]); w.y = cvt_pk_bf16(v0[2], v0[3]); w.z = cvt_pk_bf16(v1[0], v1[1]); w.w = cvt_pk_bf16(v1[2], v1[3]); return w; }
#define EPI_FOR_AM for (int ai = 0; ai < 2; ++ai) _Pragma("unroll") for (int m = 0; m < 4; ++m)

__device__ __forceinline__ void rope8(f32x4& v0, f32x4& v1, const f32x2* cs  , int fq) {
    const int i0 = 8 * (fq & 1);
    const bool second = (fq & 2) != 0;
#pragma unroll
    for (int j = 0; j < 4; ++j) {
        const float o0 = __shfl_xor(v0[j], 32), o1 = __shfl_xor(v1[j], 32);
        const f32x2 c0 = cs[i0 + j], c1 = cs[i0 + 4 + j];
        v0[j] = second ? (v0[j] * c0.x + o0 * c0.y) : (v0[j] * c0.x - o0 * c0.y);
        v1[j] = second ? (v1[j] * c1.x + o1 * c1.y) : (v1[j] * c1.x - o1 * c1.y);
    }
}
__device__ __forceinline__ void rope8r(f32x4& v0, f32x4& v1, const f32x4* ct, int fq) {
    const bool second = (fq & 2) != 0;
#pragma unroll
    for (int j = 0; j < 4; ++j) {
        const float o0 = __shfl_xor(v0[j], 32), o1 = __shfl_xor(v1[j], 32);
        const float c0x = ct[j >> 1][2 * (j & 1)], c0y = ct[j >> 1][2 * (j & 1) + 1], c1x = ct[2 + (j >> 1)][2 * (j & 1)], c1y = ct[2 + (j >> 1)][2 * (j & 1) + 1];
        v0[j] = second ? (v0[j] * c0x + o0 * c0y) : (v0[j] * c0x - o0 * c0y);
        v1[j] = second ? (v1[j] * c1x + o1 * c1y) : (v1[j] * c1x - o1 * c1y);
    }
}

__device__ __forceinline__ size_t kimg(int h, int s, int cc, int NCH) { return ((((size_t)h * 256 + (s >> 6)) * NCH + cc) * 64 + (s & 63)) * 8; }
__device__ __forceinline__ size_t vimg(int h, int d, int s, int DV) { return ((((size_t)h * 256 + (s >> 6)) * 8 + ((s & 63) >> 3)) * DV + d) * 8; }
__device__ __forceinline__ size_t kimg8b(int h, int s, int c16) { return ((((size_t)h * 256 + (s >> 6)) * 8 + c16) * 64 + (s & 63)) * 16; }
__device__ __forceinline__ unsigned pack4_fp8(float a, float b, float c, float d);
__device__ __forceinline__ f32x2 lo2(const f32x4 v) { return __builtin_shufflevector(v, v, 0, 1); }
__device__ __forceinline__ f32x2 hi2(const f32x4 v) { return __builtin_shufflevector(v, v, 2, 3); }
__device__ __forceinline__ f32x4 cat2(const f32x2 a, const f32x2 b) { return __builtin_shufflevector(a, b, 0, 1, 2, 3); }
__device__ __forceinline__ f32x4 pk_fma4(const f32x4 a, const float b, const f32x4 c) { const f32x2 b2 = {b, b}; return cat2(lo2(a) * b2 + lo2(c), hi2(a) * b2 + hi2(c)); }
__device__ __forceinline__ f32x4 pk_mul4(const f32x4 a, const float b) { const f32x2 b2 = {b, b}; return cat2(lo2(a) * b2, hi2(a) * b2); }
struct EpiABIn {
    static constexpr bool PERM = true, FP8 = false;
    unsigned char* ws; float qscale;
    __device__ __forceinline__ void operator()(AccRef acc, const Unit& u, int wr, int wc, int fr, int fq) const {
        { const int l_ = lane_id_asm(); fr = l_ & 15; fq = l_ >> 4; }
        bf16_t* QA = (bf16_t*)(ws + WS_QA); bf16_t* KA = (bf16_t*)(ws + WS_KA); bf16_t* CQ = (bf16_t*)(ws + WS_CQ); bf16_t* CKV = (bf16_t*)(ws + WS_CKV); bf16_t* KB = (bf16_t*)(ws + WS_KB);
        float* SSQQ = (float*)(ws + WS_SSQQ); float* SSQKV = (float*)(ws + WS_SSQKV); const f32x2* ROPE = (const f32x2*)(ws + WS_TAB + TAB_ROPE);
        const int pn = u.pn, row0 = u.pm * 256 + wr * 64 + fr;
        if (pn < 2) {
            const int cb = (pn & 1) * 256 + wc * 32 + 8 * fq;
#pragma unroll
            EPI_FOR_AM { const int row = row0 + ai * 128 + m * 16;
#pragma unroll
                for (int bj = 0; bj < 2; ++bj) *(u32x4*)(QA + (size_t)row * 512 + cb + bj * 128) = pack8(acc[ai][bj][m][0] * qscale, acc[ai][bj][m][1] * qscale); }
        } else if (pn < 4) {
#pragma unroll
            EPI_FOR_AM { const int row = row0 + ai * 128 + m * 16;
#pragma unroll
                for (int bj = 0; bj < 2; ++bj) { const int col = (pn & 1) * 256 + bj * 128 + wc * 32 + 8 * fq; *(u32x4*)(KA + kimg(col >> 6, row, (col & 63) >> 3, 8)) = pack8(acc[ai][bj][m][0], acc[ai][bj][m][1]); } }
        } else if (pn < 7) {
            const bool isq = pn < 6; bf16_t* dst = isq ? CQ : CKV; const int ld = isq ? 512 : 256; const int cb = (isq ? (pn - 4) * 256 : 0) + wc * 32 + 8 * fq;
#pragma unroll
            EPI_FOR_AM { const int row = row0 + ai * 128 + m * 16; float s = 0.f;
#pragma unroll
                for (int bj = 0; bj < 2; ++bj) { const f32x4 a = acc[ai][bj][m][0], b = acc[ai][bj][m][1];
                    s += (a[0] * a[0] + a[1] * a[1]) + (a[2] * a[2] + a[3] * a[3]) + (b[0] * b[0] + b[1] * b[1]) + (b[2] * b[2] + b[3] * b[3]);
                    *(u32x4*)(dst + (size_t)row * ld + cb + bj * 128) = pack8(a, b); }
                s += __shfl_xor(s, 16); s += __shfl_xor(s, 32);
                if (fq == 0) { if (isq) SSQQ[(size_t)row * 8 + (pn - 4) * 4 + wc] = s; else SSQKV[(size_t)row * 4 + wc] = s; } }
        } else if (wc == 0) {
#pragma unroll
            EPI_FOR_AM rope8(const_cast<f32x4&>(acc[ai][0][m][0]), const_cast<f32x4&>(acc[ai][0][m][1]), ROPE + (size_t)(row0 + ai * 128 + m * 16) * 16, fq);
#pragma unroll
            EPI_FOR_AM { const int row = row0 + ai * 128 + m * 16; const f32x4 v0 = acc[ai][0][m][0], v1 = acc[ai][0][m][1];
                const u32x4 w = pack8(v0, v1);
#if ATT_B_FP8
                { u32x2 w8; w8.x = pack4_fp8(v0[0], v0[1], v0[2], v0[3]); w8.y = pack4_fp8(v1[0], v1[1], v1[2], v1[3]); const u32x2 z8 = {0u, 0u};
#pragma unroll
                  for (int h = 0; h < 8; ++h) { unsigned char* kp = (unsigned char*)KB + kimg8b(h, row, 4 + (fq >> 1)) + 8 * (fq & 1); *(u32x2*)kp = w8; *(u32x2*)(kp + 2 * 1024) = z8; } }
                (void)w; }
#else
#pragma unroll
                for (int h = 0; h < 8; ++h) *(u32x4*)(KB + kimg(h, row, 8 + fq, 12)) = w; }
#endif
        }
    }
};
template <int DV, int NP> struct EpiVt {
    static constexpr bool PERM = true, FP8 = false;
    bf16_t* Vt; const float* ssq; float inv_n;
    __device__ __forceinline__ void operator()(AccRef acc, const Unit& u, int wr, int wc, int fr, int fq) const {
        { const int l_ = lane_id_asm(); fr = l_ & 15; fq = l_ >> 4; }
        float sc[2][8];
#pragma unroll
        for (int bj = 0; bj < 2; ++bj)
#pragma unroll
            for (int j = 0; j < 8; ++j) { sc[bj][j] = 1.0f;
                if (NP > 0) { const int tok = u.pn * 256 + bj * 128 + wc * 32 + 8 * fq + j; float s = 0.f;
#pragma unroll
                    for (int p = 0; p < (NP > 0 ? NP : 1); ++p) s += ssq[(size_t)tok * NP + p];
                    sc[bj][j] = 1.0f / sqrtf(s * inv_n + RMS_EPS); } }
#pragma unroll
        EPI_FOR_AM { const int f = u.pm * 256 + ai * 128 + wr * 64 + m * 16 + fr, h = f / DV, d = f % DV;
#pragma unroll
            for (int bj = 0; bj < 2; ++bj) { const int tok = u.pn * 256 + bj * 128 + wc * 32 + 8 * fq; f32x4 a = acc[ai][bj][m][0], b = acc[ai][bj][m][1];
                if (NP > 0) { a[0] *= sc[bj][0]; a[1] *= sc[bj][1]; a[2] *= sc[bj][2]; a[3] *= sc[bj][3]; b[0] *= sc[bj][4]; b[1] *= sc[bj][5]; b[2] *= sc[bj][6]; b[3] *= sc[bj][7]; }
                *(u32x4*)(Vt + vimg(h, d, tok, DV)) = pack8(a, b); } }
    }
};
struct EpiQUp {
    static constexpr bool PERM = true, FP8 = false;
    unsigned char* ws; float qscale;
    __device__ __forceinline__ void operator()(AccRef acc, const Unit& u, int wr, int wc, int fr, int fq) const {
        { const int l_ = lane_id_asm(); fr = l_ & 15; fq = l_ >> 4; }
        bf16_t* QB = (bf16_t*)(ws + WS_QB); const float* SSQQ = (const float*)(ws + WS_SSQQ); const f32x2* ROPE = (const f32x2*)(ws + WS_TAB + TAB_ROPE);
        float rqv[2][4];
#pragma unroll
        EPI_FOR_AM { const int row = u.pm * 256 + ai * 128 + wr * 64 + m * 16 + fr;
            const f32x4 p0 = *(const f32x4*)(SSQQ + (size_t)row * 8), p1 = *(const f32x4*)(SSQQ + (size_t)row * 8 + 4);
            const float ss = ((p0[0] + p0[1]) + (p0[2] + p0[3])) + ((p1[0] + p1[1]) + (p1[2] + p1[3]));
            rqv[ai][m] = qscale / sqrtf(ss * (1.0f / 512.0f) + RMS_EPS); }
#pragma unroll
        EPI_FOR_AM { const int row = u.pm * 256 + ai * 128 + wr * 64 + m * 16 + fr;
#pragma unroll
            for (int bj = 0; bj < 2; ++bj) { const int g32 = u.pn * 8 + bj * 4 + wc; if (g32 % 3 == 2) rope8(const_cast<f32x4&>(acc[ai][bj][m][0]), const_cast<f32x4&>(acc[ai][bj][m][1]), ROPE + (size_t)row * 16, fq); } }
#pragma unroll
        EPI_FOR_AM { const int row = u.pm * 256 + ai * 128 + wr * 64 + m * 16 + fr; const float rq = rqv[ai][m];
#pragma unroll
            for (int bj = 0; bj < 2; ++bj) { const int g32 = u.pn * 8 + bj * 4 + wc; const f32x4 a = acc[ai][bj][m][0] * rq, b = acc[ai][bj][m][1] * rq;
                *(u32x4*)(QB + (size_t)row * 768 + g32 * 32 + 8 * fq) = pack8(a, b); } }
    }
};
struct EpiKUp {
    static constexpr bool PERM = true, FP8 = false;
    unsigned char* ws;
    __device__ __forceinline__ void operator()(AccRef acc, const Unit& u, int wr, int wc, int fr, int fq) const {
        { const int l_ = lane_id_asm(); fr = l_ & 15; fq = l_ >> 4; }
        bf16_t* KB = (bf16_t*)(ws + WS_KB); const float* SSQKV = (const float*)(ws + WS_SSQKV);
        float rkv[2][4];
#pragma unroll
        EPI_FOR_AM { const int row = u.pm * 256 + ai * 128 + wr * 64 + m * 16 + fr; const f32x4 p0 = *(const f32x4*)(SSQKV + (size_t)row * 4);
            rkv[ai][m] = 1.0f / sqrtf(((p0[0] + p0[1]) + (p0[2] + p0[3])) * (1.0f / 256.0f) + RMS_EPS); }
#pragma unroll
        EPI_FOR_AM { const int row = u.pm * 256 + ai * 128 + wr * 64 + m * 16 + fr; const float rk = rkv[ai][m];
#pragma unroll
            for (int bj = 0; bj < 2; ++bj) { const int col = u.pn * 256 + bj * 128 + wc * 32 + 8 * fq, h = col >> 6, d = col & 63;
#if ATT_B_FP8
                { const f32x4 a = acc[ai][bj][m][0] * rk, b = acc[ai][bj][m][1] * rk; u32x2 w8; w8.x = pack4_fp8(a[0], a[1], a[2], a[3]); w8.y = pack4_fp8(b[0], b[1], b[2], b[3]);
                  *(u32x2*)((unsigned char*)KB + kimg8b(h, row, d >> 4) + (d & 15)) = w8; } } }
#else
                *(u32x4*)(KB + kimg(h, row, d >> 3, 12)) = pack8(acc[ai][bj][m][0] * rk, acc[ai][bj][m][1] * rk); } }
#endif
    }
};
struct EpiBf16Split {
    static constexpr bool PERM = true, FP8 = false;
    bf16_t* O; int ldc; int split; size_t stride; float scale0;
    __device__ __forceinline__ void operator()(AccRef acc, const Unit& u, int wr, int wc, int fr, int fq) const {
        { const int l_ = lane_id_asm(); fr = l_ & 15; fq = l_ >> 4; }
        int colt = u.pn * 256; bf16_t* base = O; float sc = 1.0f;
        { const int t = colt / split; base += (size_t)t * stride; colt -= t * split; if (t == 0) sc = scale0; }
#pragma unroll
        EPI_FOR_AM { const int row = u.pm * 256 + ai * 128 + wr * 64 + m * 16 + fr;
#pragma unroll
            for (int bj = 0; bj < 2; ++bj) *(u32x4*)(base + (size_t)row * ldc + colt + bj * 128 + wc * 32 + 8 * fq) = pack8(acc[ai][bj][m][0] * sc, acc[ai][bj][m][1] * sc); }
    }
};
__device__ __forceinline__ unsigned pack4_fp8(float a, float b, float c, float d);
struct EpiCIn {
    static constexpr bool PERM = true, FP8 = false;
    unsigned char* ws; float qscale;
    __device__ __forceinline__ void operator()(AccRef acc, const Unit& u, int wr, int wc, int fr, int fq) const {
        { const int l_ = lane_id_asm(); fr = l_ & 15; fq = l_ >> 4; }
        bf16_t* QC = (bf16_t*)(ws + WS_QC); bf16_t* KC = (bf16_t*)(ws + WS_KC);
#pragma unroll
        EPI_FOR_AM { const int row = u.pm * 256 + ai * 128 + wr * 64 + m * 16 + fr;
#pragma unroll
            for (int bj = 0; bj < 2; ++bj) { const int col = (u.pn & 3) * 256 + bj * 128 + wc * 32 + 8 * fq;
                if (u.pn < 4) *(u32x4*)(QC + (size_t)row * D + col) = pack8(acc[ai][bj][m][0] * qscale, acc[ai][bj][m][1] * qscale);
                else {
#if ATT_C_FP8
                    const int h = col >> 7, dd = col & 127, sb = dd >> 6, d = dd & 63;
                    unsigned char* kp = (unsigned char*)KC + (((((size_t)h * 256 + (row >> 6)) * 2 + sb) * 4 + (d >> 4)) * 64 + (row & 63)) * 16 + (d & 15);
                    const f32x4 a = acc[ai][bj][m][0], b = acc[ai][bj][m][1]; u32x2 w; w.x = pack4_fp8(a[0], a[1], a[2], a[3]); w.y = pack4_fp8(b[0], b[1], b[2], b[3]); *(u32x2*)kp = w;
#else
                    *(u32x4*)(KC + kimg(col >> 7, row, (col & 127) >> 3, 16)) = pack8(acc[ai][bj][m][0], acc[ai][bj][m][1]);
#endif
                } } }
    }
};
__device__ __forceinline__ void unpack8(const u32x4 w, f32x4& a, f32x4& b) { a[0] = bf_lo(w.x); a[1] = bf_hi(w.x); a[2] = bf_lo(w.y); a[3] = bf_hi(w.y); b[0] = bf_lo(w.z); b[1] = bf_hi(w.z); b[2] = bf_lo(w.w); b[3] = bf_hi(w.w); }
template <bool XF32> struct EpiResid {
    static constexpr bool PERM = true, FP8 = false;
    const void* X; bf16_t* Z;
    __device__ __forceinline__ void operator()(AccRef acc, const Unit& u, int wr, int wc, int fr, int fq) const {
        { const int l_ = lane_id_asm(); fr = l_ & 15; fq = l_ >> 4; }
        if constexpr (XF32) {
#pragma unroll
            for (int ai = 0; ai < 2; ++ai) { f32x4 xf[4][2][2];
#pragma unroll
                for (int m = 0; m < 4; ++m)
#pragma unroll
                    for (int bj = 0; bj < 2; ++bj) { const size_t o = (size_t)(u.pm * 256 + ai * 128 + wr * 64 + m * 16 + fr) * D + u.pn * 256 + wc * 32 + 8 * fq + bj * 128;
                        xf[m][bj][0] = *(const f32x4*)((const float*)X + o); xf[m][bj][1] = *(const f32x4*)((const float*)X + o + 4); }
#pragma unroll
                for (int m = 0; m < 4; ++m)
#pragma unroll
                    for (int bj = 0; bj < 2; ++bj) { const size_t o = (size_t)(u.pm * 256 + ai * 128 + wr * 64 + m * 16 + fr) * D + u.pn * 256 + wc * 32 + 8 * fq + bj * 128;
                        *(u32x4*)(Z + o) = pack8(pk_fma4(xf[m][bj][0], DN_ALPHA, acc[ai][bj][m][0]), pk_fma4(xf[m][bj][1], DN_ALPHA, acc[ai][bj][m][1])); } }
        } else {
            u32x4 xr[2][4][2];
#pragma unroll
            EPI_FOR_AM { const size_t off = (size_t)(u.pm * 256 + ai * 128 + wr * 64 + m * 16 + fr) * D + u.pn * 256 + wc * 32 + 8 * fq;
#pragma unroll
                for (int bj = 0; bj < 2; ++bj) xr[ai][m][bj] = *(const u32x4*)((const bf16_t*)X + off + bj * 128); }
#pragma unroll
            EPI_FOR_AM { const size_t off = (size_t)(u.pm * 256 + ai * 128 + wr * 64 + m * 16 + fr) * D + u.pn * 256 + wc * 32 + 8 * fq;
#pragma unroll
                for (int bj = 0; bj < 2; ++bj) { const size_t o = off + bj * 128; f32x4 xa, xb; unpack8(xr[ai][m][bj], xa, xb);
                    *(u32x4*)(Z + o) = pack8(pk_fma4(xa, DN_ALPHA, acc[ai][bj][m][0]), pk_fma4(xb, DN_ALPHA, acc[ai][bj][m][1])); } }
        }
    }
};
struct EpiPle {
    static constexpr bool PERM = true, FP8 = (MOE_FP8 != 0);
    const bf16_t* X1; const bf16_t* PP; bf16_t* Z2;
    __device__ __forceinline__ void operator()(AccRef acc, const Unit& u, int wr, int wc, int fr, int fq) const {
        { const int l_ = lane_id_asm(); fr = l_ & 15; fq = l_ >> 4; }
#pragma unroll
        for (int ai = 0; ai < 2; ++ai) { u32x4 xr[4][2], pr[4][2];
#pragma unroll
            for (int m = 0; m < 4; ++m)
#pragma unroll
                for (int bj = 0; bj < 2; ++bj) { const size_t o = (size_t)(u.pm * 256 + ai * 128 + wr * 64 + m * 16 + fr) * D + u.pn * 256 + wc * 32 + 8 * fq + bj * 128;
                    xr[m][bj] = *(const u32x4*)(X1 + o); pr[m][bj] = *(const u32x4*)(PP + o); }
#pragma unroll
            for (int m = 0; m < 4; ++m)
#pragma unroll
                for (int bj = 0; bj < 2; ++bj) { const size_t o = (size_t)(u.pm * 256 + ai * 128 + wr * 64 + m * 16 + fr) * D + u.pn * 256 + wc * 32 + 8 * fq + bj * 128;
                    f32x4 xa, xb, pa, pb; unpack8(xr[m][bj], xa, xb); unpack8(pr[m][bj], pa, pb);
                    constexpr float asc = FP8 ? 1.0f / 32.0f : 1.0f; f32x4 ra, rb;
                    { const f32x2 c2 = {-asc * LOG2E, -asc * LOG2E}, one2 = {1.0f, 1.0f}, al2 = {DN_ALPHA, DN_ALPHA};
#define PLE_HALF(accv, xv, pv, outv, H) do { const f32x2 t_ = (H ? hi2(accv) : lo2(accv)) * c2; const f32x2 d_ = (f32x2){fast_exp2(t_[0]), fast_exp2(t_[1])} + one2; \
                        const f32x2 r_ = {fast_rcp(d_[0]), fast_rcp(d_[1])}; const f32x2 q_ = (H ? hi2(xv) : lo2(xv)) * al2 + r_ * (H ? hi2(pv) : lo2(pv)); outv[2 * H] = q_[0]; outv[2 * H + 1] = q_[1]; } while (0)
                      PLE_HALF(acc[ai][bj][m][0], xa, pa, ra, 0); PLE_HALF(acc[ai][bj][m][0], xa, pa, ra, 1); PLE_HALF(acc[ai][bj][m][1], xb, pb, rb, 0); PLE_HALF(acc[ai][bj][m][1], xb, pb, rb, 1);
#undef PLE_HALF
                    }
                    *(u32x4*)(Z2 + o) = pack8(ra, rb); } }
    }
};
constexpr float W1_SCALE = 32.0f, W2_SCALE = 64.0f, H_SCALE = 4.0f;
__device__ __forceinline__ unsigned pack4_fp8(float a, float b, float c, float d) { int w = __builtin_amdgcn_cvt_pk_fp8_f32(a, b, 0, false); w = __builtin_amdgcn_cvt_pk_fp8_f32(c, d, w, true); return (unsigned)w; }
struct EpiMoeAct {
    static constexpr bool PERM = true, FP8 = (MOE_FP8 != 0);
    unsigned char* Hs; const float* bin;
    struct Pre { f32x4 g0, g1, l0, l1; };
    __device__ __forceinline__ Pre pre(const Unit& u, int wr, int wc) const { const int fq = lane_id_asm() >> 4; const float* bg = bin + (size_t)u.e * 2048 + u.pn * 128 + wc * 32 + 8 * fq;
        Pre p; p.g0 = *(const f32x4*)bg; p.g1 = *(const f32x4*)(bg + 4); p.l0 = *(const f32x4*)(bg + 1024); p.l1 = *(const f32x4*)(bg + 1028); return p; }
    __device__ __forceinline__ void operator()(AccRef acc, const Unit& u, int wr, int wc, int fr, int fq, const Pre& pr) const {
        { const int l_ = lane_id_asm(); fr = l_ & 15; fq = l_ >> 4; }
        const int cl = u.pn * 128 + wc * 32 + 8 * fq;
        const f32x4 g0 = pr.g0, g1 = pr.g1, l0 = pr.l0, l1 = pr.l1;
        constexpr float asc = FP8 ? 1.0f / W1_SCALE : 1.0f, osc = FP8 ? H_SCALE : 1.0f;
#pragma unroll
        EPI_FOR_AM { const int row = u.pm * 256 + ai * 128 + wr * 64 + m * 16 + fr; f32x4 o[2];
#pragma unroll
            for (int n = 0; n < 2; ++n) { const f32x4 ag = acc[ai][0][m][n], al = acc[ai][1][m][n], bg = n ? g1 : g0, bl = n ? l1 : l0;
#pragma unroll
                for (int h = 0; h < 2; ++h) {
                    const f32x2 a2 = {asc, asc}, o2 = {osc, osc}, c2 = {-1.702f * LOG2E, -1.702f * LOG2E}, one2 = {1.0f, 1.0f};
                    const f32x2 hg = (f32x2){ag[2 * h], ag[2 * h + 1]} * a2 + (f32x2){bg[2 * h], bg[2 * h + 1]}, hl = (f32x2){al[2 * h], al[2 * h + 1]} * a2 + (f32x2){bl[2 * h], bl[2 * h + 1]};
                    const f32x2 glu = {fminf(hg[0], 7.0f), fminf(hg[1], 7.0f)}, lin = {fminf(fmaxf(hl[0], -7.0f), 7.0f), fminf(fmaxf(hl[1], -7.0f), 7.0f)};
                    const f32x2 t = glu * c2; const f32x2 d = (f32x2){fast_exp2(t[0]), fast_exp2(t[1])} + one2; const f32x2 r = {fast_rcp(d[0]), fast_rcp(d[1])};
                    const f32x2 res = (glu * r) * (lin * o2 + o2);
                    o[n][2 * h] = res[0]; o[n][2 * h + 1] = res[1]; } }
            if constexpr (FP8) { u32x2 w; w.x = pack4_fp8(o[0][0], o[0][1], o[0][2], o[0][3]); w.y = pack4_fp8(o[1][0], o[1][1], o[1][2], o[1][3]); *(u32x2*)(Hs + (size_t)row * 1024 + cl) = w; }
            else *(u32x4*)((bf16_t*)Hs + (size_t)row * 1024 + cl) = pack8(o[0], o[1]); }
    }
};
struct EpiMoeDown {
    static constexpr bool PERM = true, FP8 = (MOE_FP8 != 0);
    bf16_t* Ys; const float* bout; const float* GATE;
    struct Pre { f32x4 bv[2][2]; float gtv[2][4]; };
    __device__ __forceinline__ Pre pre(const Unit& u, int wr, int wc) const { const int l_ = lane_id_asm(), fr = l_ & 15, fq = l_ >> 4; Pre p;
#pragma unroll
        for (int bj = 0; bj < 2; ++bj)
#pragma unroll
            for (int n = 0; n < 2; ++n) p.bv[bj][n] = *(const f32x4*)(bout + (size_t)u.e * 1024 + u.pn * 256 + bj * 128 + wc * 32 + 8 * fq + 4 * n);
#pragma unroll
        EPI_FOR_AM p.gtv[ai][m] = GATE[(size_t)u.e * S + u.aux * 256 + ai * 128 + wr * 64 + m * 16 + fr];
        return p; }
    __device__ __forceinline__ void operator()(AccRef acc, const Unit& u, int wr, int wc, int fr, int fq, const Pre& pr) const {
        { const int l_ = lane_id_asm(); fr = l_ & 15; fq = l_ >> 4; }
        constexpr float asc = FP8 ? 1.0f / (W2_SCALE * H_SCALE) : 1.0f;
        f32x4 bv[2][2];
#pragma unroll
        for (int bj = 0; bj < 2; ++bj)
#pragma unroll
            for (int n = 0; n < 2; ++n) bv[bj][n] = pr.bv[bj][n];
#pragma unroll
        EPI_FOR_AM { const int rl = ai * 128 + wr * 64 + m * 16 + fr; const float gt = pr.gtv[ai][m];
#pragma unroll
            for (int bj = 0; bj < 2; ++bj) *(u32x4*)(Ys + (size_t)(u.pm * 256 + rl) * 1024 + u.pn * 256 + bj * 128 + wc * 32 + 8 * fq) = pack8(pk_mul4(pk_fma4(acc[ai][bj][m][0], asc, bv[bj][0]), gt), pk_mul4(pk_fma4(acc[ai][bj][m][1], asc, bv[bj][1]), gt)); }
    }
};
template <bool GATHER_> struct MoeOrder {
    static constexpr bool GATHER = GATHER_;
    const LAS int* toff; const LAS int* cnt; const LAS int* t2e; const int* TOK; int NT, G, c;
    __device__ __forceinline__ bool next(int i, Unit& u) const {
        const int L = i * G + c; const int total = toff[32] * NT; if (L >= total) return false;
        const int tile = L / NT; u.pn = L - tile * NT; const int e = t2e[tile];
        u.pm = tile; u.e = e; u.aux = tile - toff[e]; return true;
    }
    __device__ __forceinline__ const int* tokbase(const Unit& u) const { return TOK + (size_t)u.e * S; }
    __device__ __forceinline__ unsigned tokidx(const Unit& u, int r) const { const int pos = u.aux * 256 + r; return (unsigned)(pos < cnt[u.e] ? pos : 0); }
    __device__ __forceinline__ int arow(const Unit& u, int r) const {
        if (!GATHER) return u.pm * 256 + r;
        const int pos = u.aux * 256 + r; const int* base = TOK + (size_t)u.e * S; return base[pos < cnt[u.e] ? pos : 0];
    }
};
}

namespace fa {
typedef float f32x16 __attribute__((ext_vector_type(16)));
template <int TYPE> struct Cfg;
template <> struct Cfg<0> { static constexpr int DQK = 64, DV = 64,  NSUB = 1, UROWS = 256, NKP = 1, NVP = 1, DQ8 = 64; static constexpr bool K8 = false; };
template <> struct Cfg<1> { static constexpr int DQK = 96, DV = 64,  NSUB = 1, UROWS = 256, NKP = (ATT_B_FP8 ? 1 : 2), NVP = 1, DQ8 = 128; static constexpr bool K8 = (ATT_B_FP8 != 0); };
template <> struct Cfg<2> { static constexpr int DQK = 64, DV = 128, NSUB = 2, UROWS = 128, NKP = (ATT_C_FP8 ? 1 : 2), NVP = 2, DQ8 = 64; static constexpr bool K8 = (ATT_C_FP8 != 0); };
constexpr float THR = 8.0f;
struct Desc { const bf16_t* Q; const bf16_t* K; const bf16_t* Vt; bf16_t* O; int ldq, ldk; int q0; const float* btab; float far; float lam, omli; const float* subln; };

__device__ __forceinline__ float pair_max(float v) { auto rr = __builtin_amdgcn_permlane32_swap(__float_as_uint(v), __float_as_uint(v), false, false); return fmaxf(__uint_as_float(rr[0]), __uint_as_float(rr[1])); }
__device__ __forceinline__ float pair_sum(float v) { auto rr = __builtin_amdgcn_permlane32_swap(__float_as_uint(v), __float_as_uint(v), false, false); return __uint_as_float(rr[0]) + __uint_as_float(rr[1]); }
__device__ __forceinline__ float max3f(float a, float b, float c) { return fmaxf(fmaxf(a, b), c); }
typedef __bf16 bf16x2_t __attribute__((ext_vector_type(2)));
__device__ __forceinline__ unsigned cvtpk_n(float lo, float hi) { f32x2 v = {lo, hi}; bf16x2_t b = __builtin_convertvector(v, bf16x2_t); return __builtin_bit_cast(unsigned, b); }
__device__ __forceinline__ bf16x8 pack_p(const f32x16& p, int b) { u32x4 w; w.x = cvtpk_n(p[b], p[b + 1]); w.y = cvtpk_n(p[b + 2], p[b + 3]); w.z = cvtpk_n(p[b + 4], p[b + 5]); w.w = cvtpk_n(p[b + 6], p[b + 7]); return __builtin_bit_cast(bf16x8, w); }
#define FA_WAITBAR(N) asm volatile("s_waitcnt vmcnt(" #N ") lgkmcnt(0)\n\ts_barrier" ::: "memory")

template <int TYPE, bool OPT>
__device__ __forceinline__ bool attn_unit(LAS unsigned char* lds, const int wave, const Desc ds) {
    typedef Cfg<TYPE> C;
    constexpr int DQK = C::DQK, DV = C::DV, KCH = C::K8 ? C::DQ8 / 16 : DQK / 8  , NQ8 = C::DQ8 / 64, KBYTES = C::NSUB * KCH * 1024, VBYTES = DV * 128, KRING = 0, VRING = 3 * KBYTES, NPW = C::NKP + C::NVP;
    constexpr int ND0 = DQK / 16, NDB = DV / 32, XCH = 0;
    const int lane = lane_id_asm(), q = lane & 31, hi = lane >> 5;
    const int rb = (TYPE == 2) ? (wave & 3) : wave, sub = (TYPE == 2) ? (wave >> 2) : 0;
    const int c0 = ds.q0 >> 6, T1 = c0 + C::UROWS / 64 - 1, T0 = (TYPE == 0) ? (c0 > 8 ? c0 - 8 : 0) : 0;
    const int cw = (ds.q0 + 32 * rb) >> 6, a_hi = cw, a_lo = (TYPE == 0) ? (cw > 8 ? cw - 8 : 0) : 0, near_lo = (TYPE == 1) ? (1 << 30) : cw - 2;
    const int qpos = ds.q0 + 32 * rb + q;
    const unsigned ldsb = (unsigned)(size_t)lds;
    int kdst[C::NKP], vdst[C::NVP]; const unsigned dvoff = (unsigned)lane * 16u;
#pragma unroll
    for (int i = 0; i < C::NKP; ++i) { int idx = wave + 8 * i; if (idx >= C::NSUB * KCH) idx -= C::NSUB * KCH; kdst[i] = idx * 1024; }
#pragma unroll
    for (int i = 0; i < C::NVP; ++i) vdst[i] = (wave + 8 * i) * 1024;
#define FA_ISSUE_K(u, slot) do { _Pragma("unroll") for (int _i = 0; _i < C::NKP; ++_i) \
        pg8::glds_sv(pg8::uniform_ptr((const char*)ds.K + (size_t)(u) * KBYTES + kdst[_i]), dvoff, (unsigned)__builtin_amdgcn_readfirstlane((int)(ldsb + KRING + (slot) * KBYTES + kdst[_i]))); } while (0)
#define FA_ISSUE_V(u, slot) do { _Pragma("unroll") for (int _i = 0; _i < C::NVP; ++_i) \
        pg8::glds_sv(pg8::uniform_ptr((const char*)ds.Vt + (size_t)(u) * VBYTES + vdst[_i]), dvoff, (unsigned)__builtin_amdgcn_readfirstlane((int)(ldsb + VRING + (slot) * VBYTES + vdst[_i]))); } while (0)
    const int pi = (q & ~12) | ((q & 4) << 1) | ((q & 8) >> 1);
    const int kfo = KRING + (C::K8 ? hi * 2048 : hi * 1024) + pi * 16 + sub * KCH * 1024, vfo = VRING + hi * DV * 16 + q * 16;
    FA_WAITBAR(0);
    if (TYPE != 1) { const int tid = wave * 64 + lane; if (tid < 256) *(LAS float*)(lds + LM_FREE + tid * 4) = ds.btab[tid] - ds.far; }
    FA_ISSUE_K(T0, 0); if (T0 + 1 <= T1) FA_ISSUE_K(T0 + 1, 1);
    bf16x8 qf[ND0]; pg8::i32x8 qf8[NQ8]; (void)qf8;
    if constexpr (C::K8) {
#pragma unroll
        for (int o8 = 0; o8 < NQ8; ++o8) { const int dbase = 64 * o8 + 32 * hi; const bf16_t* qp = ds.Q + (size_t)qpos * ds.ldq + sub * 64 + dbase;
#pragma unroll
            for (int j = 0; j < 4; ++j) { u32x4 w = {0u, 0u, 0u, 0u}; if (dbase + 8 * j < DQK) w = *(const u32x4*)(qp + 8 * j);
                qf8[o8][2 * j]     = (int)pg8::pack4_fp8(bf_lo(w.x) * 8.f, bf_hi(w.x) * 8.f, bf_lo(w.y) * 8.f, bf_hi(w.y) * 8.f);
                qf8[o8][2 * j + 1] = (int)pg8::pack4_fp8(bf_lo(w.z) * 8.f, bf_hi(w.z) * 8.f, bf_lo(w.w) * 8.f, bf_hi(w.w) * 8.f); } }
#pragma unroll
        for (int d0 = 0; d0 < ND0; ++d0) qf[d0] = bf16x8{};
    } else { const bf16_t* qp = ds.Q + (size_t)qpos * ds.ldq + sub * 64 + 8 * hi;
#pragma unroll
      for (int d0 = 0; d0 < ND0; ++d0) qf[d0] = *(const bf16x8*)(qp + 16 * d0); }
    f32x16 o[NDB];
#pragma unroll
    for (int db = 0; db < NDB; ++db) o[db] = f32x16{};
    f32x16 negm = f32x16{}; float m = 0.f, l = 0.f, fsc = 1.f; bool resc = false;
    f32x16 sA0 = f32x16{}, sA1 = f32x16{}, sB0 = f32x16{}, sB1 = f32x16{};
    bf16x8 pa[4], pb[4];
#pragma unroll
    for (int i = 0; i < 4; ++i) { pa[i] = bf16x8{}; pb[i] = bf16x8{}; }
    int s0 = 2;
#define FA_QK8_1(kb_, ka_, o8_, CIN) __builtin_amdgcn_mfma_scale_f32_32x32x64_f8f6f4(pg8::ld_pair(lds + (ka_) + (o8_) * 4096 + (kb_) * 512), qf8[o8_], CIN, 0, 0, 0, 0x7F7F7F7F, 0, 0x7C7C7C7C)
#define FA_QK8(kb_, ka_, CIN) (NQ8 == 1 ? FA_QK8_1(kb_, ka_, 0, CIN) : FA_QK8_1(kb_, ka_, NQ8 - 1, FA_QK8_1(kb_, ka_, 0, CIN)))
#define FA_QK(SN0, SN1) do { const int ka_ = kfo + ((s0 + 1) % 3) * KBYTES; \
        if constexpr (C::K8) { SN0 = FA_QK8(0, ka_, negm); SN1 = FA_QK8(1, ka_, negm); } else \
        _Pragma("unroll") for (int d0 = 0; d0 < ND0; ++d0) { const bf16x8 k0_ = *(const LAS bf16x8*)(lds + ka_ + d0 * 2048), k1_ = *(const LAS bf16x8*)(lds + ka_ + d0 * 2048 + 512); \
            SN0 = __builtin_amdgcn_mfma_f32_32x32x16_bf16(k0_, qf[d0], d0 == 0 ? negm : SN0, 0, 0, 0); SN1 = __builtin_amdgcn_mfma_f32_32x32x16_bf16(k1_, qf[d0], d0 == 0 ? negm : SN1, 0, 0, 0); } } while (0)
#define FA_ROWMAX(SC0, SC1, rm) do { float a_ = max3f(SC0[0], SC0[1], SC1[0]), b_ = max3f(SC0[2], SC0[3], SC1[1]); a_ = max3f(a_, SC1[2], SC1[3]); \
        _Pragma("unroll") for (int r = 4; r < 16; r += 4) { a_ = max3f(a_, SC0[r], SC0[r + 1]); b_ = max3f(b_, SC0[r + 2], SC0[r + 3]); a_ = max3f(a_, SC1[r], SC1[r + 1]); b_ = max3f(b_, SC1[r + 2], SC1[r + 3]); } \
        rm = pair_max(fmaxf(a_, b_)); } while (0)
#define FA_RESCALE_A(SC0, SC1, SN0, SN1, dl, HAVE_N) do { m += dl; \
        _Pragma("unroll") for (int r = 0; r < 16; ++r) { SC0[r] -= dl; SC1[r] -= dl; } \
        if (HAVE_N) { _Pragma("unroll") for (int r = 0; r < 16; ++r) { SN0[r] -= dl; SN1[r] -= dl; } } \
        _Pragma("unroll") for (int r = 0; r < 16; ++r) negm[r] = -m; \
        fsc = fast_exp2(-dl); l *= fsc; resc = true; } while (0)
#define FA_EXP(SC0, SC1, PC) do { \
        _Pragma("unroll") for (int r = 0; r < 16; ++r) { SC0[r] = fast_exp2(SC0[r]); SC1[r] = fast_exp2(SC1[r]); } \
        float s_ = 0.f, s2_ = 0.f, s3_ = 0.f, s4_ = 0.f; \
        _Pragma("unroll") for (int r = 0; r < 16; r += 2) { s_ += SC0[r]; s2_ += SC1[r]; s3_ += SC0[r + 1]; s4_ += SC1[r + 1]; } \
        l += (s_ + s2_) + (s3_ + s4_); \
        PC[0] = pack_p(SC0, 0); PC[1] = pack_p(SC0, 8); PC[2] = pack_p(SC1, 0); PC[3] = pack_p(SC1, 8); } while (0)
#define FA_PV(PP) do { const int va_ = vfo + ((s0 + 2) % 3) * VBYTES; \
        _Pragma("unroll") for (int ks = 0; ks < 4; ++ks) _Pragma("unroll") for (int db = 0; db < NDB; ++db) { const bf16x8 v_ = *(const LAS bf16x8*)(lds + va_ + ks * DV * 32 + db * 512); \
            o[db] = __builtin_amdgcn_mfma_f32_32x32x16_bf16(v_, PP[ks], o[db], 0, 0, 0); } } while (0)
#define FA_RESCALE_B() do { if (resc) { _Pragma("unroll") for (int db = 0; db < NDB; ++db) _Pragma("unroll") for (int r = 0; r < 16; ++r) o[db][r] *= fsc; resc = false; } } while (0)
#define FA_BIAS(SC0, SC1, t) do { const int bb_ = LM_FREE + (64 * (t) + 8 * hi - qpos + 192) * 4; \
        _Pragma("unroll") for (int r = 0; r < 16; ++r) { SC0[r] += *(const LAS float*)(lds + bb_ + (16 * (r >> 3) + (r & 7)) * 4); SC1[r] += *(const LAS float*)(lds + bb_ + (32 + 16 * (r >> 3) + (r & 7)) * 4); } } while (0)
#define FA_SB() __builtin_amdgcn_sched_barrier(0)
#define FA_X(SC0, SC1, e) ((e) < 16 ? SC0[(e) & 15] : SC1[(e) & 15])
#ifndef FA_FD
#define FA_FD 4
#endif
#define FA_QK_MAX(SC0, SC1, SN0, SN1, rm) do { const int ka_ = kfo + ((s0 + 1) % 3) * KBYTES; constexpr int NQ_ = 2 * ND0, VPC_ = (32 + NQ_ - 1) / NQ_, FD_ = FA_FD; \
        if constexpr (C::K8) { const f32x16 z8_ = f32x16{}; SN0 = FA_QK8(0, ka_, z8_); SN1 = FA_QK8(1, ka_, z8_); \
            if (__builtin_expect(__any(m != 0.f), 0)) { _Pragma("unroll") for (int r = 0; r < 16; ++r) { SN0[r] -= m; SN1[r] -= m; } } \
            FA_ROWMAX(SC0, SC1, rm); } else { \
        bf16x8 kf_[FD_]; _Pragma("unroll") for (int j_ = 0; j_ < FD_ - 1; ++j_) kf_[j_] = *(const LAS bf16x8*)(lds + ka_ + (j_ >> 1) * 2048 + (j_ & 1) * 512); \
        float a_ = -3.0e38f, b_ = -3.0e38f; const f32x16 z_ = f32x16{}; \
        _Pragma("unroll") for (int i_ = 0; i_ < NQ_; ++i_) { const int d0_ = i_ >> 1, kb_ = i_ & 1; \
            if (i_ + FD_ - 1 < NQ_) kf_[(i_ + FD_ - 1) % FD_] = *(const LAS bf16x8*)(lds + ka_ + ((i_ + FD_ - 1) >> 1) * 2048 + ((i_ + FD_ - 1) & 1) * 512); \
            if (kb_ == 0) SN0 = __builtin_amdgcn_mfma_f32_32x32x16_bf16(kf_[i_ % FD_], qf[d0_], d0_ == 0 ? z_ : SN0, 0, 0, 0); \
            else          SN1 = __builtin_amdgcn_mfma_f32_32x32x16_bf16(kf_[i_ % FD_], qf[d0_], d0_ == 0 ? z_ : SN1, 0, 0, 0); \
            _Pragma("unroll") for (int e_ = i_ * VPC_; e_ < (i_ + 1) * VPC_ && e_ < 32; e_ += 2) { \
                if (e_ + 1 < 32) { if ((e_ >> 1) & 1) b_ = max3f(b_, FA_X(SC0, SC1, e_), FA_X(SC0, SC1, e_ + 1)); else a_ = max3f(a_, FA_X(SC0, SC1, e_), FA_X(SC0, SC1, e_ + 1)); } \
                else a_ = fmaxf(a_, FA_X(SC0, SC1, e_)); } \
            FA_SB(); } \
        if (__builtin_expect(__any(m != 0.f), 0)) { _Pragma("unroll") for (int r = 0; r < 16; ++r) { SN0[r] -= m; SN1[r] -= m; } } \
        rm = pair_max(fmaxf(a_, b_)); } } while (0)
#define FA_QK_NOMAX(SN0, SN1) do { const int ka_ = kfo + ((s0 + 1) % 3) * KBYTES; constexpr int NQ_ = 2 * ND0, FD_ = FA_FD; \
        if constexpr (C::K8) { const f32x16 z8_ = f32x16{}; SN0 = FA_QK8(0, ka_, z8_); FA_SB(); SN1 = FA_QK8(1, ka_, z8_); FA_SB(); } else { \
        bf16x8 kf_[FD_]; _Pragma("unroll") for (int j_ = 0; j_ < FD_ - 1; ++j_) kf_[j_] = *(const LAS bf16x8*)(lds + ka_ + (j_ >> 1) * 2048 + (j_ & 1) * 512); \
        const f32x16 z_ = f32x16{}; \
        _Pragma("unroll") for (int i_ = 0; i_ < NQ_; ++i_) { const int d0_ = i_ >> 1, kb_ = i_ & 1; \
            if (i_ + FD_ - 1 < NQ_) kf_[(i_ + FD_ - 1) % FD_] = *(const LAS bf16x8*)(lds + ka_ + ((i_ + FD_ - 1) >> 1) * 2048 + ((i_ + FD_ - 1) & 1) * 512); \
            if (kb_ == 0) SN0 = __builtin_amdgcn_mfma_f32_32x32x16_bf16(kf_[i_ % FD_], qf[d0_], d0_ == 0 ? z_ : SN0, 0, 0, 0); \
            else          SN1 = __builtin_amdgcn_mfma_f32_32x32x16_bf16(kf_[i_ % FD_], qf[d0_], d0_ == 0 ? z_ : SN1, 0, 0, 0); \
            FA_SB(); } } } while (0)
#define FA_PIN(x) asm volatile("" : "+v"(x))
#define FA_PV_EXP(SC0, SC1, PP, PC) do { const int va_ = vfo + ((s0 + 2) % 3) * VBYTES; constexpr int NCH_ = 4 * NDB, EPC_ = 32 / NCH_, FD_ = FA_FD; \
        bf16x8 vf_[FD_]; _Pragma("unroll") for (int j_ = 0; j_ < FD_ - 1; ++j_) vf_[j_] = *(const LAS bf16x8*)(lds + va_ + (j_ / NDB) * DV * 32 + (j_ % NDB) * 512); \
        float s_[4] = {0.f, 0.f, 0.f, 0.f}; unsigned w_[16]; \
        _Pragma("unroll") for (int i_ = 0; i_ < NCH_; ++i_) { const int ks_ = i_ / NDB, db_ = i_ % NDB; \
            if (i_ + FD_ - 1 < NCH_) vf_[(i_ + FD_ - 1) % FD_] = *(const LAS bf16x8*)(lds + va_ + ((i_ + FD_ - 1) / NDB) * DV * 32 + ((i_ + FD_ - 1) % NDB) * 512); \
            o[db_] = __builtin_amdgcn_mfma_f32_32x32x16_bf16(vf_[i_ % FD_], PP[ks_], o[db_], 0, 0, 0); \
            _Pragma("unroll") for (int e_ = i_ * EPC_; e_ < (i_ + 1) * EPC_; ++e_) { if (e_ < 16) SC0[e_ & 15] = fast_exp2(SC0[e_ & 15]); else SC1[e_ & 15] = fast_exp2(SC1[e_ & 15]); } \
            if (i_ > 0) { _Pragma("unroll") for (int e_ = (i_ - 1) * EPC_; e_ < i_ * EPC_; ++e_) s_[e_ & 3] += FA_X(SC0, SC1, e_); \
                          _Pragma("unroll") for (int e_ = (i_ - 1) * EPC_; e_ < i_ * EPC_; e_ += 2) { w_[e_ >> 1] = cvtpk_n(FA_X(SC0, SC1, e_), FA_X(SC0, SC1, e_ + 1)); FA_PIN(w_[e_ >> 1]); } \
                          FA_PIN(s_[0]); FA_PIN(s_[1]); if (EPC_ > 2) { FA_PIN(s_[2]); FA_PIN(s_[3]); } } \
            FA_SB(); } \
        { _Pragma("unroll") for (int e_ = (NCH_ - 1) * EPC_; e_ < 32; ++e_) s_[e_ & 3] += FA_X(SC0, SC1, e_); \
          _Pragma("unroll") for (int e_ = (NCH_ - 1) * EPC_; e_ < 32; e_ += 2) { w_[e_ >> 1] = cvtpk_n(FA_X(SC0, SC1, e_), FA_X(SC0, SC1, e_ + 1)); FA_PIN(w_[e_ >> 1]); } } \
        l += (s_[0] + s_[1]) + (s_[2] + s_[3]); FA_PIN(l); \
        _Pragma("unroll") for (int g_ = 0; g_ < 4; ++g_) { u32x4 t_ = {w_[4 * g_], w_[4 * g_ + 1], w_[4 * g_ + 2], w_[4 * g_ + 3]}; PC[g_] = __builtin_bit_cast(bf16x8, t_); } \
        FA_SB(); } while (0)
#define FA_STEP(MODE, SC0, SC1, SN0, SN1, PP, PC) do { \
        const bool do_qk = (t + 1 >= a_lo && t + 1 <= a_hi), do_sm = (t >= a_lo && t <= a_hi), do_pv = (t - 1 >= a_lo && t - 1 <= a_hi); \
        if (MODE) {                                                              \
            if constexpr (OPT) { FA_QK_NOMAX(SN0, SN1); FA_PV_EXP(SC0, SC1, PP, PC); } \
            else { float rm; FA_QK_MAX(SC0, SC1, SN0, SN1, rm); \
                if (__builtin_expect(__any(rm > THR), 0)) { const float dl = fmaxf(rm, 0.f); FA_RESCALE_A(SC0, SC1, SN0, SN1, dl, true); } \
                FA_PV_EXP(SC0, SC1, PP, PC); FA_RESCALE_B(); } \
        } else {                                                                \
            if (do_qk) FA_QK(SN0, SN1); \
            if (do_sm) { if (TYPE != 1 && t >= near_lo) FA_BIAS(SC0, SC1, t); \
                if constexpr (!OPT) { float rm; FA_ROWMAX(SC0, SC1, rm); \
                    if (t == a_lo) { const float dl = (fabsf(rm) > 16.0f) ? rm : 0.f; FA_RESCALE_A(SC0, SC1, SN0, SN1, dl, do_qk); resc = false; l = 0.f; }     \
                    else if (__any(rm > THR)) { const float dl = fmaxf(rm, 0.f); FA_RESCALE_A(SC0, SC1, SN0, SN1, dl, do_qk); } } } \
            if (do_pv) FA_PV(PP); \
            if (do_sm) FA_EXP(SC0, SC1, PC); \
            if constexpr (!OPT) FA_RESCALE_B(); \
        } } while (0)
#define FA_ITER(MODE, t, SC0, SC1, SN0, SN1, PP, PC) do { \
        if ((t) >= T0 && (t) + 2 <= T1) { if (NPW == 2) FA_WAITBAR(2); else if (NPW == 3) FA_WAITBAR(3); else FA_WAITBAR(4); } else FA_WAITBAR(0); \
        if ((t) + 3 <= T1) FA_ISSUE_K((t) + 3, s0); \
        if ((t) + 1 <= T1) FA_ISSUE_V((t) + 1, (s0 + 1) % 3); \
        FA_STEP(MODE, SC0, SC1, SN0, SN1, PP, PC); \
        s0 = (s0 == 2) ? 0 : s0 + 1; } while (0)
#define FA_PAIR(MODE) do { { const int t = tt; FA_ITER(MODE, t, sA0, sA1, sB0, sB1, pa, pb); } { const int t = tt + 1; FA_ITER(MODE, t, sB0, sB1, sA0, sA1, pb, pa); } } while (0)
    int tt = T0 - 1;
    const int st_hi = (TYPE == 0) ? -(1 << 20) : c0 - 3;
    { FA_PAIR(0); tt += 2; }
    for (; tt + 1 <= st_hi; tt += 2) FA_PAIR(1);
#pragma unroll
    for (int r = 0; r < 16; ++r) negm[r] = -m;
    for (; tt <= T1 + 1; tt += 2) FA_PAIR(0);
    const float lt = pair_sum(l), inv = fast_rcp(lt);
    const bool ok_ = OPT ? (__all((lt > 7.9e-31f) && (lt < 1.2e30f)) != 0) : true;
    if (TYPE != 2) {
        bf16_t* op = ds.O + (size_t)qpos * D;
#pragma unroll
        for (int db = 0; db < NDB; ++db)
#pragma unroll
            for (int g = 0; g < 4; ++g) { u32x2 w; w.x = cvt_pk_bf16(o[db][4 * g] * inv, o[db][4 * g + 1] * inv); w.y = cvt_pk_bf16(o[db][4 * g + 2] * inv, o[db][4 * g + 3] * inv);
                *(u32x2*)(op + 32 * db + 8 * g + 4 * hi) = w; }
    } else {
        FA_WAITBAR(0);
        const int xb = XCH + ((rb * 32 + q) * 132) * 4;
        if (sub == 1) {
#pragma unroll
            for (int db = 0; db < NDB; ++db)
#pragma unroll
                for (int g = 0; g < 4; ++g) { f32x4 w = {o[db][4 * g] * inv, o[db][4 * g + 1] * inv, o[db][4 * g + 2] * inv, o[db][4 * g + 3] * inv}; *(LAS f32x4*)(lds + xb + (32 * db + 8 * g + 4 * hi) * 4) = w; }
        }
        FA_WAITBAR(0);
        if (sub == 0) {
            float ss = 0.f;
#pragma unroll
            for (int db = 0; db < NDB; ++db)
#pragma unroll
                for (int g = 0; g < 4; ++g) { const f32x4 w = *(const LAS f32x4*)(lds + xb + (32 * db + 8 * g + 4 * hi) * 4);
#pragma unroll
                    for (int jj = 0; jj < 4; ++jj) { const float a = o[db][4 * g + jj] * inv - ds.lam * w[jj]; o[db][4 * g + jj] = a; ss += a * a; } }
            ss = pair_sum(ss);
            const float rinv = ds.omli / sqrtf(ss * (1.0f / 128.0f) + RMS_EPS);
            bf16_t* op = ds.O + (size_t)qpos * D;
#pragma unroll
            for (int db = 0; db < NDB; ++db) { f32x4 sgv[4];
#pragma unroll
                for (int g = 0; g < 4; ++g) sgv[g] = *(const f32x4*)(ds.subln + 32 * db + 8 * g + 4 * hi);
#pragma unroll
                for (int g = 0; g < 4; ++g) { const int d = 32 * db + 8 * g + 4 * hi; const f32x4 sg = sgv[g];
                    u32x2 w; w.x = cvt_pk_bf16(o[db][4 * g] * rinv * sg[0], o[db][4 * g + 1] * rinv * sg[1]); w.y = cvt_pk_bf16(o[db][4 * g + 2] * rinv * sg[2], o[db][4 * g + 3] * rinv * sg[3]);
                    *(u32x2*)(op + d) = w; } }
        }
    }
#undef FA_ISSUE_K
#undef FA_ISSUE_V
    return ok_;
}
template <int TYPE>
__device__ __forceinline__ void attn_unit_checked(LAS unsigned char* lds, const int wave, const Desc ds) {
    const bool ok = attn_unit<TYPE, true>(lds, wave, ds);
    LAS int* flag = (LAS int*)(lds + LM_FLAG);
    if (!ok) *flag = 1;
    asm volatile("s_waitcnt vmcnt(0) lgkmcnt(0)\n\ts_barrier" ::: "memory");
    const int redo = *flag;
    asm volatile("s_waitcnt lgkmcnt(0)\n\ts_barrier" ::: "memory");
    if (redo) { if (wave == 0) *flag = 0; (void)attn_unit<TYPE, false>(lds, wave, ds); }
}
}

struct Args {
    const float* in[26];
    float* out; unsigned char* ws;
    float inv_freq[16];
    int ph_lo, ph_hi;
};
enum { I_X = 0, I_P, I_AB_WIN, I_AB_RELB, I_AB_QN, I_AB_KVN, I_AB_WUQ, I_AB_WUKV, I_AB_WOUT, I_C_WIN, I_C_LAM, I_C_SUBLN, I_C_WOUT, I_T5, I_LNMG, I_LNMB, I_LNFG, I_LNFB,
       I_RW, I_RB, I_EWIN, I_EBIN, I_EWOUT, I_EBOUT, I_PGW, I_PPW };

__device__ __forceinline__ void transpose_item(const float* W, int Nsrc, int c0, int k0, const float* kscale, bf16_t* WT, int K, int r0, LAS float* scr, int lane) {
#pragma unroll 8
    for (int i = 0; i < 32; ++i) { const int kk = 2 * i + (lane >> 5); float v = W[(size_t)(k0 + kk) * Nsrc + c0 + (lane & 31)]; if (kscale) v *= kscale[k0 + kk]; scr[kk * 33 + (lane & 31)] = v; }
    LDS_WAIT(); asm volatile("" ::: "memory");
    const int c = lane & 7;
#pragma unroll
    for (int j = 0; j < 4; ++j) { const int n = (lane >> 3) + 8 * j; const LAS float* s = scr + (8 * c) * 33 + n;
        u32x4 o; o.x = cvt_pk_bf16(s[0 * 33], s[1 * 33]); o.y = cvt_pk_bf16(s[2 * 33], s[3 * 33]); o.z = cvt_pk_bf16(s[4 * 33], s[5 * 33]); o.w = cvt_pk_bf16(s[6 * 33], s[7 * 33]);
        *(u32x4*)(WT + (size_t)(r0 + n) * K + k0 + 8 * c) = o; }
    LDS_WAIT(); asm volatile("" ::: "memory");
}
__device__ __forceinline__ void transpose_item_fp8(const float* W, int Nsrc, int c0, int k0, float sc, unsigned char* WT, int K, int r0, LAS float* scr, int lane) {
#pragma unroll 8
    for (int i = 0; i < 32; ++i) { const int kk = 2 * i + (lane >> 5); scr[kk * 33 + (lane & 31)] = W[(size_t)(k0 + kk) * Nsrc + c0 + (lane & 31)] * sc; }
    LDS_WAIT(); asm volatile("" ::: "memory");
    const int c = lane & 7;
#pragma unroll
    for (int j = 0; j < 4; ++j) { const int n = (lane >> 3) + 8 * j; const LAS float* s = scr + (8 * c) * 33 + n;
        u32x2 o; o.x = pg8::pack4_fp8(s[0 * 33], s[1 * 33], s[2 * 33], s[3 * 33]); o.y = pg8::pack4_fp8(s[4 * 33], s[5 * 33], s[6 * 33], s[7 * 33]);
        *(u32x2*)(WT + (size_t)(r0 + n) * K + k0 + 8 * c) = o; }
    LDS_WAIT(); asm volatile("" ::: "memory");
}
__device__ __forceinline__ void convert_tile_fp8(const float* W, int Nsrc, int c0, int k0, float sc, unsigned char* WT, int K, int r0, int lane) {
    const int q = lane & 7, g = lane >> 3;
    const float* src = W + (size_t)(k0 + 16 * g) * Nsrc + c0 + 4 * q;
    f32x4 v[16];
#pragma unroll
    for (int j = 0; j < 16; ++j) v[j] = __builtin_nontemporal_load((const f32x4*)(src + (size_t)j * Nsrc));
#pragma unroll
    for (int c = 0; c < 4; ++c) { u32x4 o;
        o.x = pg8::pack4_fp8(v[0][c] * sc, v[1][c] * sc, v[2][c] * sc, v[3][c] * sc); o.y = pg8::pack4_fp8(v[4][c] * sc, v[5][c] * sc, v[6][c] * sc, v[7][c] * sc);
        o.z = pg8::pack4_fp8(v[8][c] * sc, v[9][c] * sc, v[10][c] * sc, v[11][c] * sc); o.w = pg8::pack4_fp8(v[12][c] * sc, v[13][c] * sc, v[14][c] * sc, v[15][c] * sc);
        *(u32x4*)(WT + (size_t)(r0 + 4 * q + c) * K + k0 + 16 * g) = o; }
}
__device__ __forceinline__ void sincos_acc(float ang, float& sn, float& cs) {
    const double x = (double)ang; const double TWO_OVER_PI = 0.63661977236758134308, PIO2 = 1.57079632679489661923;
    const double kq = rint(x * TWO_OVER_PI); const double y = x - kq * PIO2; const double y2 = y * y;
    double s = y * (1.0 + y2 * (-1.0 / 6 + y2 * (1.0 / 120 + y2 * (-1.0 / 5040 + y2 * (1.0 / 362880 + y2 * (-1.0 / 39916800 + y2 * (1.0 / 6227020800.0)))))));
    double c = 1.0 + y2 * (-0.5 + y2 * (1.0 / 24 + y2 * (-1.0 / 720 + y2 * (1.0 / 40320 + y2 * (-1.0 / 3628800 + y2 * (1.0 / 479001600.0))))));
    const int q = ((int)(long long)kq) & 3;
    const double ss = (q == 0) ? s : (q == 1) ? c : (q == 2) ? -s : -c;
    const double cc = (q == 0) ? c : (q == 1) ? -s : (q == 2) ? -c : s;
    sn = (float)ss; cs = (float)cc;
}
__device__ __forceinline__ int t5_bucket_dev(int rel) {
    const int ret = rel > 0 ? 16 : 0; const int n = rel < 0 ? -rel : rel;
    if (n < 8) return ret + n;
    int large = 8 + (int)(__log2f((float)n * 0.125f) * 2.0f + 1e-4f);
    if (large > 15) large = 15;
    return ret + large;
}

__device__ __forceinline__ int opaque_s(int i) { asm volatile("" : "+s"(i)); return i; }
#define ARGIN(i) (args.in[opaque_s(i)])
struct Ctx { LAS unsigned char* lds; gu32* ctl; int wave, G, bx, vcu, gw, NGW, lo, hi; };
template <int L> __device__ __forceinline__ void layer_body(const Args& args, const Ctx cx, const XcdBarrier& bar);
__global__ void __launch_bounds__(NTHREADS, 2) mk_fwd(Args args) {
    extern __shared__ __attribute__((aligned(16))) unsigned char lds_raw[];
    LAS unsigned char* lds = (LAS unsigned char*)lds_raw;
    int wave_ = __builtin_amdgcn_readfirstlane(threadIdx.x >> 6); asm volatile("" : "+s"(wave_)); const int wave = wave_;
#define WS_DECL GAS unsigned char* wsg_ = (GAS unsigned char*)args.ws; asm volatile("" : "+s"(wsg_)); unsigned char* ws = (unsigned char*)wsg_
#define TID_DECL const int lane = lane_id_asm(), tid = wave * 64 + lane; (void)tid; (void)lane
    const int G = gridDim.x, bx = blockIdx.x;
    const int vcu = (G % 8 == 0) ? (bx % 8) * (G / 8) + bx / 8 : bx;
    const int gw = vcu * NWAVES + wave, NGW = G * NWAVES;
    gu32* ctl = (gu32*)(args.ws + WS_CTL);
    { TID_DECL; for (int u = tid; u < (LDS_BYTES - LM) / 4; u += NTHREADS) ((LAS unsigned*)(lds + LM))[u] = 0u; }
    __syncthreads();
#if MK_ONE_LAUNCH
    XcdBarrier bar = xcd_barrier_post((unsigned*)(ctl + CW_BAR), (volatile LAS unsigned*)(lds + LM_BAR));
#ifdef DOUBLE_BAR
#define GRID_BAR() do { xcd_barrier(bar); xcd_barrier(bar); } while (0)
#else
#define GRID_BAR() xcd_barrier(bar)
#endif
#else
#define GRID_BAR() do {} while (0)
#endif
    const int lo = args.ph_lo, hi = args.ph_hi;
#ifndef PH_MASK
#define PH_MASK 0xFFFF
#endif
#ifndef DUP_MASK
#define DUP_MASK 0
#endif
#define REP(b) for (int rep_ = 0; rep_ < (((DUP_MASK) >> (b)) & 1) + 1; ++rep_)
#define PHE(b) (((PH_MASK) >> (b)) & 1)
#define IN(k) (lo <= (k) && (k) < hi)
#define SEAM(k) do { if (IN(k) && IN((k) + 1)) GRID_BAR(); } while (0)

#define XB ((bf16_t*)(ws + WS_XB))
#define PB ((bf16_t*)(ws + WS_PB))
#define PP ((bf16_t*)(ws + WS_PP))
#define QA ((bf16_t*)(ws + WS_QA))
#define KA ((bf16_t*)(ws + WS_KA))
#define VAT ((bf16_t*)(ws + WS_VAT))
#define CQ ((bf16_t*)(ws + WS_CQ))
#define CKV ((bf16_t*)(ws + WS_CKV))
#define SSQQ ((float*)(ws + WS_SSQQ))
#define SSQKV ((float*)(ws + WS_SSQKV))
#define QB ((bf16_t*)(ws + WS_QB))
#define KB ((bf16_t*)(ws + WS_KB))
#define VBT ((bf16_t*)(ws + WS_VBT))
#define QC ((bf16_t*)(ws + WS_QC))
#define KC ((bf16_t*)(ws + WS_KC))
#define VCT ((bf16_t*)(ws + WS_VCT))
#define OAB ((bf16_t*)(ws + WS_OAB))
#define Z ((bf16_t*)(ws + WS_Z))
#define X1 ((float*)(ws + WS_X1))
#define XB1 ((bf16_t*)(ws + WS_XB1))
#define XF8 ((unsigned char*)(ws + WS_XF8))
#define Z2 ((bf16_t*)(ws + WS_Z2))
#define HS ((bf16_t*)(ws + WS_HS))
#define YS ((bf16_t*)(ws + WS_YS))
#define TOK ((int*)(ws + WS_TOK))
#define GATE ((float*)(ws + WS_GATE))
#define SLOT ((int*)(ws + WS_SLOT))
#define ROPE ((const f32x2*)(ws + WS_TAB + TAB_ROPE))
#define WRT ((float*)(ws + WS_TAB + TAB_WRT))
#define BIASA ((float*)(ws + WS_TAB + TAB_BIASA))
#define T5T ((float*)(ws + WS_TAB + TAB_T5))
#define LAMT ((float*)(ws + WS_TAB + TAB_LAM))
#define FATAB ((float*)(ws + WS_TAB + TAB_FA))
#define FAFAR ((float*)(ws + WS_TAB + TAB_FAFAR))
    if (PHE(0) && IN(0)) REP(0) { TID_DECL; WS_DECL;
        { const unsigned NT = (unsigned)(G * NTHREADS);
          for (unsigned i = (unsigned)(vcu * NTHREADS + wave * 64 + lane_id_asm()); i < (unsigned)(S * D / 8); i += NT) { const f32x4 a = *(const f32x4*)(args.in[I_X] + (size_t)i * 8), b = *(const f32x4*)(args.in[I_X] + (size_t)i * 8 + 4); *(u32x4*)(XB + (size_t)i * 8) = pg8::pack8(a, b); }
          for (unsigned i = (unsigned)(vcu * NTHREADS + wave * 64 + lane_id_asm()); i < (unsigned)(4 * S * PLE / 8); i += NT) { const f32x4 a = *(const f32x4*)(args.in[I_P] + (size_t)i * 8), b = *(const f32x4*)(args.in[I_P] + (size_t)i * 8 + 4); *(u32x4*)(PB + (size_t)i * 8) = pg8::pack8(a, b); }
          for (unsigned i = (unsigned)(vcu * NTHREADS + wave * 64 + lane_id_asm()); i < (unsigned)(S * 16); i += NT) { const int s = (int)(i >> 4), f = (int)(i & 15); const float ang = (float)s * args.inv_freq[f]; float sn, cs; sincos_acc(ang, sn, cs); ((f32x2*)(ws + WS_TAB + TAB_ROPE))[i] = (f32x2){cs, sn}; }
        }
        if (bx == 0) {
#if NAIVE_ATTN
          for (int i = tid; i < 2 * 8 * 260; i += NTHREADS) { const int j = i / (8 * 260), h = (i / 260) % 8, idx = i % 260; BIASA[i] = idx < 257 ? args.in[I_AB_RELB][((size_t)j * 257 + idx) * 8 + h] * LOG2E : 0.f; }
          for (int i = tid; i < 8 * 192; i += NTHREADS) { const int h = i / 192, rel = i % 192 - 128; T5T[i] = args.in[I_T5][t5_bucket_dev(rel) * 8 + h] * LOG2E; }
#endif
          if (tid < 16) { const int tb = tid >> 3, h = tid & 7; FAFAR[tid] = args.in[I_AB_RELB][((size_t)tb * 257 + 256) * 8 + h] * LOG2E; }
          else if (tid < 24) { FAFAR[tid] = args.in[I_T5][15 * 8 + (tid - 16)] * LOG2E; }
          if (wave < 2) { const int j = wave, d = lane_id_asm(); const float* lp = args.in[I_C_LAM] + j * 256; const float s01 = wave_sum(lp[d] * lp[64 + d]), s23 = wave_sum(lp[128 + d] * lp[192 + d]);
              const float li = 0.8f - 0.6f * fast_exp2(-0.3f * (float)(2 * j + 1) * LOG2E); if (d == 0) { LAMT[j * 2] = fast_exp2(s01 * LOG2E) - fast_exp2(s23 * LOG2E) + li; LAMT[j * 2 + 1] = 1.0f - li; } }
        }
        for (int i = vcu * NTHREADS + tid; i < 3 * 8 * 256; i += G * NTHREADS) {
          if (i < 2 * 8 * 256) { const int tb = i >> 11, h = (i >> 8) & 7, rel = (i & 255) - 192; int qk = -rel; qk = qk > 128 ? 128 : qk;
              FATAB[i] = args.in[I_AB_RELB][((size_t)tb * 257 + qk + 128) * 8 + h] * LOG2E; }
          else { const int i2 = i - 2 * 8 * 256, h = (i2 >> 8) & 7, rel = (i2 & 255) - 192; FATAB[i] = args.in[I_T5][t5_bucket_dev(rel) * 8 + h] * LOG2E; }
        }
        LAS float* scr = (LAS float*)(lds + wave * 16384);
        constexpr int J0 = 4 * 32 * (MOE_FP8 ? 8 : 16) * 64, J1 = 4 * 32 * (MOE_FP8 ? 8 : 16) * 32, J2 = 2 * 16 * 80, J3 = 2 * 8 * 24, J4 = 2 * 4 * 16, J5 = J4, J6 = 2 * 16 * 32, J7 = 2 * 16 * 96, J8 = J6, J9 = 4 * (MOE_FP8 ? 8 : 16) * 32, J10 = 4 * 4 * 32;
        constexpr int NITEMS = J0 + J1 + J2 + J3 + J4 + J5 + J6 + J7 + J8 + J9 + J10;
        for (int it = gw; it < NITEMS; it += NGW) {
            int r = it;
#if MOE_FP8
            if (r < J0) { const int mat = r / 512, q = r % 512, kb = q / 64, b = q % 64; const int t = b >> 3, s = (b >> 2) & 1, i32 = b & 3;
                convert_tile_fp8(args.in[I_EWIN] + (size_t)mat * 1024 * 2048, 2048, s * 1024 + 128 * t + 32 * i32, kb * 128, pg8::W1_SCALE, ws + WS_W1 + (size_t)mat * 2048 * 1024, 1024, b * 32, lane); continue; } r -= J0;
            if (r < J1) { const int mat = r / 256, q = r % 256, kb = q / 32, b = q % 32;
                convert_tile_fp8(args.in[I_EWOUT] + (size_t)mat * 1024 * 1024, 1024, b * 32, kb * 128, pg8::W2_SCALE, ws + WS_W2 + (size_t)mat * 1024 * 1024, 1024, b * 32, lane); continue; } r -= J1;
#else
            if (r < J0) { const int mat = r / 1024, q = r % 1024, kb = q / 64, b = q % 64; const int t = b >> 3, s = (b >> 2) & 1, i32 = b & 3;
                transpose_item(args.in[I_EWIN] + (size_t)mat * 1024 * 2048, 2048, s * 1024 + 128 * t + 32 * i32, kb * 64, nullptr, (bf16_t*)(ws + WS_W1) + (size_t)mat * 2048 * 1024, 1024, b * 32, scr, lane); continue; } r -= J0;
            if (r < J1) { const int mat = r / 512, q = r % 512, kb = q / 32, b = q % 32;
                transpose_item(args.in[I_EWOUT] + (size_t)mat * 1024 * 1024, 1024, b * 32, kb * 64, nullptr, (bf16_t*)(ws + WS_W2) + (size_t)mat * 1024 * 1024, 1024, b * 32, scr, lane); continue; } r -= J1;
#endif
            if (r < J2) { const int j = r / 1280, q = r % 1280, kb = q / 80, b = q % 80; int c0;
                if (b < 32) c0 = 32 * b; else if (b < 48) c0 = 1536 + 32 * (b - 32); else if (b < 56) c0 = 2048 + 32 * (b - 48); else if (b == 56) c0 = 2304; else if (b < 64) c0 = -1; else c0 = 1024 + 32 * (b - 64);
                if (c0 >= 0) transpose_item(args.in[I_AB_WIN] + (size_t)j * 1024 * AB_IN, AB_IN, c0, kb * 64, nullptr, (bf16_t*)(ws + WS_WABIN) + (size_t)j * 2560 * 1024, 1024, b * 32, scr, lane);
                continue; } r -= J2;
            if (r < J3) { const int j = r / 192, q = r % 192, kb = q / 24, b = q % 24;
                transpose_item(args.in[I_AB_WUQ] + (size_t)j * 512 * 768, 768, b * 32, kb * 64, args.in[I_AB_QN] + j * 512, (bf16_t*)(ws + WS_WUQ) + (size_t)j * 768 * 512, 512, b * 32, scr, lane); continue; } r -= J3;
            if (r < J4 + J5) { const int isv = r >= J4; if (isv) r -= J4; const int j = r / 64, q = r % 64, kb = q / 16, b = q % 16; const int h = b >> 1, hf = b & 1;
                transpose_item(args.in[I_AB_WUKV] + (size_t)j * 256 * 1024, 1024, h * 128 + 32 * hf + (isv ? 64 : 0), kb * 64, args.in[I_AB_KVN] + j * 256, (bf16_t*)(ws + (isv ? WS_WUKVV : WS_WUKVK)) + (size_t)j * 512 * 256, 256, b * 32, scr, lane); continue; } r -= J4 + J5;
            if (r < J6) { const int j = r / 512, q = r % 512, kb = q / 32, b = q % 32;
                transpose_item(args.in[I_AB_WOUT] + (size_t)j * 1024 * 1024, 1024, b * 32, kb * 64, nullptr, (bf16_t*)(ws + WS_WABOUT) + (size_t)j * 1024 * 1024, 1024, b * 32, scr, lane); continue; } r -= J6;
            if (r < J7) { const int j = r / 1536, q = r % 1536, kb = q / 96, b = q % 96;
                transpose_item(args.in[I_C_WIN] + (size_t)j * 1024 * 3072, 3072, b * 32, kb * 64, nullptr, (bf16_t*)(ws + WS_WCIN) + (size_t)j * 3072 * 1024, 1024, b * 32, scr, lane); continue; } r -= J7;
            if (r < J8) { const int j = r / 512, q = r % 512, kb = q / 32, b = q % 32;
                transpose_item(args.in[I_C_WOUT] + (size_t)j * 1024 * 1024, 1024, b * 32, kb * 64, nullptr, (bf16_t*)(ws + WS_WCOUT) + (size_t)j * 1024 * 1024, 1024, b * 32, scr, lane); continue; } r -= J8;
#if MOE_FP8
            if (r < J9) { const int j = r / 256, q = r % 256, kb = q / 32, b = q % 32;
                convert_tile_fp8(args.in[I_PGW] + (size_t)j * 1024 * 1024, 1024, b * 32, kb * 128, 32.0f, ws + WS_WPG + (size_t)j * 1024 * 1024, 1024, b * 32, lane); continue; } r -= J9;
#else
            if (r < J9) { const int j = r / 512, q = r % 512, kb = q / 32, b = q % 32;
                transpose_item(args.in[I_PGW] + (size_t)j * 1024 * 1024, 1024, b * 32, kb * 64, nullptr, (bf16_t*)(ws + WS_WPG) + (size_t)j * 1024 * 1024, 1024, b * 32, scr, lane); continue; } r -= J9;
#endif
            { const int j = r / 128, q = r % 128, kb = q / 32, b = q % 32;
                transpose_item(args.in[I_PPW] + (size_t)j * 256 * 1024, 1024, b * 32, kb * 64, nullptr, (bf16_t*)(ws + WS_WPP) + (size_t)j * 1024 * 256, 256, b * 32, scr, lane); }
        }
    }
    SEAM(0);
    if (PHE(1) && IN(1)) REP(1) { WS_DECL;
        for (int L = 0; L < 4; ++L) {
            pg8::Gemm g{PB + (size_t)L * S * PLE, (const bf16_t*)(ws + WS_WPP) + (size_t)L * 1024 * 256, 256, 0, wave}; pg8::StaticOrder So; So.init(S, D, G, bx);
            pg8::EpiBf16Split E{PP + (size_t)L * S * D, D, 1 << 20, 0, 1.0f};
            pg8::gemm_phase<pg8::EpiBf16Split, pg8::StaticOrder, true>(lds, g, So, E);
        }
    }

    { Ctx cx{lds, ctl, wave, G, bx, vcu, gw, NGW, lo, hi};
#if MK_ONE_LAUNCH
      const XcdBarrier& barr = bar;
#else
      XcdBarrier barr{nullptr, 0u, nullptr};
#endif
      layer_body<0>(args, cx, barr); layer_body<1>(args, cx, barr); layer_body<2>(args, cx, barr); layer_body<3>(args, cx, barr); }
}

template <int L> __device__ __forceinline__ void layer_body(const Args& args, const Ctx cx, const XcdBarrier& bar) {
    LAS unsigned char* lds = cx.lds; gu32* ctl = cx.ctl; const int wave = cx.wave, G = cx.G, bx = cx.bx, vcu = cx.vcu, gw = cx.gw, NGW = cx.NGW, lo = cx.lo, hi = cx.hi;
    (void)bar; (void)ctl; (void)bx; (void)gw; (void)NGW; (void)vcu;
    {
        const int pb = 2 + 8 * L, j = L >> 1;
        if (pb + 8 <= lo || pb >= hi) return;
        if ((L & 1) == 0) {
            if (PHE(2) && IN(pb + 0)) REP(2) { WS_DECL;
                const bf16_t* W = (const bf16_t*)(ws + WS_WABIN) + (size_t)j * 2560 * 1024;
                { pg8::Gemm g{XB, W, 1024, 0, wave}; pg8::StaticOrder So; So.init(S, 2048, G, bx);
                  pg8::EpiABIn E{ws, 0.125f * LOG2E};
                  pg8::gemm_phase<pg8::EpiABIn, pg8::StaticOrder, true>(lds, g, So, E); }
                { pg8::Gemm g{W + (size_t)2048 * 1024, XB, 1024, 0, wave}; pg8::StaticOrder So; So.init(512, S, G, bx);
                  pg8::EpiVt<64, 0> E{VAT, nullptr, 0.f};
                  pg8::gemm_phase<pg8::EpiVt<64, 0>, pg8::StaticOrder, true>(lds, g, So, E); }
            }
            SEAM(pb + 0);
            if (PHE(3) && IN(pb + 1)) REP(3) { WS_DECL;
                { pg8::Gemm g{CQ, (const bf16_t*)(ws + WS_WUQ) + (size_t)j * 768 * 512, 512, 0, wave}; pg8::StaticOrder So; So.init(S, 768, G, bx);
                  pg8::EpiQUp E{ws, 0.10206207261596575f * LOG2E};
                  pg8::gemm_phase<pg8::EpiQUp, pg8::StaticOrder, true>(lds, g, So, E); }
                { pg8::Gemm g{CKV, (const bf16_t*)(ws + WS_WUKVK) + (size_t)j * 512 * 256, 256, 0, wave}; pg8::StaticOrder So; So.init(S, 512, G, (bx + 128) % G);
                  pg8::EpiKUp E{ws};
                  pg8::gemm_phase<pg8::EpiKUp, pg8::StaticOrder, true>(lds, g, So, E); }
                { pg8::Gemm g{(const bf16_t*)(ws + WS_WUKVV) + (size_t)j * 512 * 256, CKV, 256, 0, wave}; pg8::StaticOrder So; So.init(512, S, G, (bx + 64) % G);
                  pg8::EpiVt<64, 4> E{VBT, SSQKV, 1.0f / 256.0f};
                  pg8::gemm_phase<pg8::EpiVt<64, 4>, pg8::StaticOrder, true>(lds, g, So, E); }
            }
            SEAM(pb + 1);
        } else {
            if (PHE(4) && IN(pb + 0)) REP(4) { WS_DECL;
                const bf16_t* W = (const bf16_t*)(ws + WS_WCIN) + (size_t)j * 3072 * 1024;
                { pg8::Gemm g{XB, W, 1024, 0, wave}; pg8::StaticOrder So; So.init(S, 2048, G, bx);
                  pg8::EpiCIn E{ws, 0.125f * LOG2E};
                  pg8::gemm_phase<pg8::EpiCIn, pg8::StaticOrder, true>(lds, g, So, E); }
                { pg8::Gemm g{W + (size_t)2048 * 1024, XB, 1024, 0, wave}; pg8::StaticOrder So; So.init(1024, S, G, bx);
                  pg8::EpiVt<128, 0> E{VCT, nullptr, 0.f};
                  pg8::gemm_phase<pg8::EpiVt<128, 0>, pg8::StaticOrder, true>(lds, g, So, E); }
            }
            SEAM(pb + 0);
        }
#if !NAIVE_ATTN
        if (PHE(5) && IN(pb + 2)) REP(5 + (L & 1)) { WS_DECL;
            if ((L & 1) == 0) {
                for (int p = vcu; p < 256; p += G) { const int h = p >> 5, sidx = p & 31;
#pragma unroll 1
                    for (int k = 0; k < 2; ++k) { const int qb = k ? 63 - sidx : sidx;
                        fa::Desc ds{QB + h * 96, (const bf16_t*)((const unsigned char*)KB + (size_t)h * 256 * (ATT_B_FP8 ? 8192 : 12288)), VBT + (size_t)h * 256 * 64 * 64, OAB + 512 + h * 64, 768, 768, qb * 256, nullptr, 0.f, 0.f, 0.f, nullptr};
#if !defined(FA_ONLY) || FA_ONLY == 1
                        fa::attn_unit_checked<1>(lds, wave, ds);
#endif
                    } }
                for (int u = vcu; u < 512; u += G) { const int h = u >> 6, qb = u & 63;
                    fa::Desc ds{QA + h * 64, KA + (size_t)h * 256 * 64 * 64, VAT + (size_t)h * 256 * 64 * 64, OAB + h * 64, 512, 512, qb * 256, FATAB + (j * 8 + h) * 256, FAFAR[j * 8 + h], 0.f, 0.f, nullptr};
#if !defined(FA_ONLY) || FA_ONLY == 0
                    fa::attn_unit_checked<0>(lds, wave, ds);
#endif
                }
            } else {
                const float lam = LAMT[j * 2], omli = LAMT[j * 2 + 1];
                for (int p = vcu; p < 512; p += G) { const int h = p >> 6, sidx = p & 63;
#pragma unroll 1
                    for (int k = 0; k < 2; ++k) { const int qb = k ? 127 - sidx : sidx;
                        fa::Desc ds{QC + h * 128, (const bf16_t*)((const unsigned char*)KC + (size_t)h * 256 * (ATT_C_FP8 ? 8192 : 16384)), VCT + (size_t)h * 256 * 128 * 64, OAB + h * 128, 1024, 1024, qb * 128, FATAB + (16 + h) * 256, FAFAR[16 + h], lam, omli, ARGIN(I_C_SUBLN) + j * 128};
#if !defined(FA_ONLY) || FA_ONLY == 2
                        fa::attn_unit_checked<2>(lds, wave, ds);
#endif
                    } }
            }
            asm volatile("s_waitcnt vmcnt(0) lgkmcnt(0)\n\ts_barrier" ::: "memory");
        }
#else
        if (IN(pb + 2)) { TID_DECL; WS_DECL;
            if ((L & 1) == 0) { if (PHE(5)) {
                const float* bA = BIASA + (size_t)j * 8 * 260;
                for (int it = gw; it < 2 * 8 * S; it += NGW) {
                    const int typ = it / (8 * S), r2 = it % (8 * S), h = r2 / S, s = r2 % S, c = s >> 6;
                    const int dqk = typ ? 96 : 64; const bf16_t* Qp = typ ? QB + (size_t)s * 768 + h * 96 : QA + (size_t)s * 512 + h * 64;
                    const bf16_t* Kp = typ ? KB + h * 96 : KA + h * 64; const int kld = typ ? 768 : 512; const bf16_t* Vt = (typ ? VBT : VAT) + (size_t)h * 256 * 64 * 64;
                    float q[96];
#pragma unroll
                    for (int d = 0; d < 96; ++d) q[d] = d < dqk ? bf2f(Qp[d]) : 0.f;
                    float mx = -1e30f, l = 0.f, o = 0.f;
                    const int t0 = typ ? 0 : (c >= 8 ? c - 8 : 0);
                    for (int t = t0; t <= c; ++t) {
                        const int key = t * 64 + lane; const bf16_t* kr = Kp + (size_t)key * kld; float sc = 0.f;
#pragma unroll
                        for (int d8 = 0; d8 < 12; ++d8) if (d8 * 8 < dqk) { const u32x4 kk = *(const u32x4*)(kr + d8 * 8);
                            sc += q[d8 * 8] * bf_lo(kk.x) + q[d8 * 8 + 1] * bf_hi(kk.x) + q[d8 * 8 + 2] * bf_lo(kk.y) + q[d8 * 8 + 3] * bf_hi(kk.y) + q[d8 * 8 + 4] * bf_lo(kk.z) + q[d8 * 8 + 5] * bf_hi(kk.z) + q[d8 * 8 + 6] * bf_lo(kk.w) + q[d8 * 8 + 7] * bf_hi(kk.w); }
                        if (!typ) { int rel = s - key; rel = rel > 128 ? 128 : rel; sc += bA[h * 260 + rel + 128]; }
                        const float tm = wave_max(sc), mn = fmaxf(mx, tm), al_ = fast_exp2(mx - mn), p = fast_exp2(sc - mn);
                        l = l * al_ + wave_sum(p); o *= al_; mx = mn;
                        const bf16_t* vr = Vt + ((size_t)t * 64 + lane) * 64;
#pragma unroll
                        for (int k8 = 0; k8 < 8; ++k8) { const u32x4 vv = *(const u32x4*)(vr + k8 * 8);
                            o += rdlane(p, k8 * 8 + 0) * bf_lo(vv.x) + rdlane(p, k8 * 8 + 1) * bf_hi(vv.x) + rdlane(p, k8 * 8 + 2) * bf_lo(vv.y) + rdlane(p, k8 * 8 + 3) * bf_hi(vv.y)
                               + rdlane(p, k8 * 8 + 4) * bf_lo(vv.z) + rdlane(p, k8 * 8 + 5) * bf_hi(vv.z) + rdlane(p, k8 * 8 + 6) * bf_lo(vv.w) + rdlane(p, k8 * 8 + 7) * bf_hi(vv.w); }
                    }
                    const float r = o / l;
                    OAB[(size_t)s * D + typ * 512 + h * 64 + lane] = (bf16_t)(cvt_pk_bf16(r, r) & 0xffffu);
                }
            } } else if (PHE(6)) {
                const float lam = LAMT[j * 2], omli = LAMT[j * 2 + 1]; const float* sub = ARGIN(I_C_SUBLN) + j * 128;
                for (int it = gw; it < 8 * S; it += NGW) {
                    const int h = it / S, s = it % S, c = s >> 6; const bf16_t* Vt = VCT + (size_t)h * 256 * 128 * 64;
                    float ra0 = 0.f, ra1 = 0.f, rb0 = 0.f, rb1 = 0.f;
                    for (int sb = 0; sb < 2; ++sb) {
                        const bf16_t* Qp = QC + (size_t)s * D + h * 128 + sb * 64; const bf16_t* Kp = KC + h * 128 + sb * 64;
                        float q[64];
#pragma unroll
                        for (int d = 0; d < 64; ++d) q[d] = bf2f(Qp[d]);
                        float mx = -1e30f, l = 0.f, o0 = 0.f, o1 = 0.f;
                        for (int t = 0; t <= c; ++t) {
                            const int key = t * 64 + lane; const bf16_t* kr = Kp + (size_t)key * D; float sc = 0.f;
#pragma unroll
                            for (int d8 = 0; d8 < 8; ++d8) { const u32x4 kk = *(const u32x4*)(kr + d8 * 8);
                                sc += q[d8 * 8] * bf_lo(kk.x) + q[d8 * 8 + 1] * bf_hi(kk.x) + q[d8 * 8 + 2] * bf_lo(kk.y) + q[d8 * 8 + 3] * bf_hi(kk.y) + q[d8 * 8 + 4] * bf_lo(kk.z) + q[d8 * 8 + 5] * bf_hi(kk.z) + q[d8 * 8 + 6] * bf_lo(kk.w) + q[d8 * 8 + 7] * bf_hi(kk.w); }
                            { int rel = key - s; rel = rel < -128 ? -128 : rel; sc += T5T[h * 192 + rel + 128]; }
                            const float tm = wave_max(sc), mn = fmaxf(mx, tm), al_ = fast_exp2(mx - mn), p = fast_exp2(sc - mn);
                            l = l * al_ + wave_sum(p); o0 *= al_; o1 *= al_; mx = mn;
                            const bf16_t* vr0 = Vt + ((size_t)t * 128 + lane) * 64; const bf16_t* vr1 = vr0 + 64 * 64;
#pragma unroll
                            for (int k8 = 0; k8 < 8; ++k8) { const u32x4 va = *(const u32x4*)(vr0 + k8 * 8), vb = *(const u32x4*)(vr1 + k8 * 8);
                                const float p0 = rdlane(p, k8 * 8 + 0), p1 = rdlane(p, k8 * 8 + 1), p2 = rdlane(p, k8 * 8 + 2), p3 = rdlane(p, k8 * 8 + 3), p4 = rdlane(p, k8 * 8 + 4), p5 = rdlane(p, k8 * 8 + 5), p6 = rdlane(p, k8 * 8 + 6), p7 = rdlane(p, k8 * 8 + 7);
                                o0 += p0 * bf_lo(va.x) + p1 * bf_hi(va.x) + p2 * bf_lo(va.y) + p3 * bf_hi(va.y) + p4 * bf_lo(va.z) + p5 * bf_hi(va.z) + p6 * bf_lo(va.w) + p7 * bf_hi(va.w);
                                o1 += p0 * bf_lo(vb.x) + p1 * bf_hi(vb.x) + p2 * bf_lo(vb.y) + p3 * bf_hi(vb.y) + p4 * bf_lo(vb.z) + p5 * bf_hi(vb.z) + p6 * bf_lo(vb.w) + p7 * bf_hi(vb.w); }
                        }
                        if (sb == 0) { ra0 = o0 / l; ra1 = o1 / l; } else { rb0 = o0 / l; rb1 = o1 / l; }
                    }
                    const float a0 = ra0 - lam * rb0, a1 = ra1 - lam * rb1;
                    const float ms = wave_sum(a0 * a0 + a1 * a1) * (1.0f / 128.0f), inv = omli / sqrtf(ms + RMS_EPS);
                    const float r0 = a0 * inv * sub[lane], r1 = a1 * inv * sub[64 + lane];
                    OAB[(size_t)s * D + h * 128 + lane] = (bf16_t)(cvt_pk_bf16(r0, r0) & 0xffffu); OAB[(size_t)s * D + h * 128 + 64 + lane] = (bf16_t)(cvt_pk_bf16(r1, r1) & 0xffffu);
                }
            }
        }
#endif
        SEAM(pb + 2);
        if (PHE(7) && IN(pb + 3)) REP(7) { WS_DECL;
            pg8::Gemm g{OAB, (const bf16_t*)(ws + ((L & 1) ? WS_WCOUT : WS_WABOUT)) + (size_t)j * 1024 * 1024, 1024, 0, wave}; pg8::StaticOrder So; So.init(S, D, G, bx);
            if (L == 0) { pg8::EpiResid<true> E{ARGIN(I_X), Z}; pg8::gemm_phase<pg8::EpiResid<true>, pg8::StaticOrder, false>(lds, g, So, E); }
            else { pg8::EpiResid<false> E{XB, Z}; pg8::gemm_phase<pg8::EpiResid<false>, pg8::StaticOrder, false>(lds, g, So, E); }
        }
        SEAM(pb + 3);
        if (PHE(8) && IN(pb + 4)) { TID_DECL; WS_DECL;
            constexpr int XP = 1028;
            LAS float* XS = (LAS float*)lds;
            LAS float* PART = (LAS float*)(lds + 66048);
            LAS int* hist = (LAS int*)(lds + LM_HIST); LAS int* basep = (LAS int*)(lds + LM_BASE); LAS int* sel = (LAS int*)(lds + LM_SEL);
            if (tid < 32) hist[tid] = 0;
            __syncthreads();
            const float* gam = ARGIN(I_LNMG) + L * D; const float* bet = ARGIN(I_LNMB) + L * D; const float* rb = ARGIN(I_RB) + L * 32;
            const float* Wr = ARGIN(I_RW) + (size_t)L * D * 32;
            f32x4 gv[4], bv[4];
#pragma unroll
            for (int q = 0; q < 4; ++q) { gv[q] = *(const f32x4*)(gam + 4 * lane + 256 * q); bv[q] = *(const f32x4*)(bet + 4 * lane + 256 * q); }
            const int mi = lane & 15, kq = lane >> 4;
#define SPLIT8(src, H, Lw) do { u32x4 h_, l_; _Pragma("unroll") for (int i_ = 0; i_ < 4; ++i_) { const unsigned hp_ = cvt_pk_bf16(src[2 * i_], src[2 * i_ + 1]); h_[i_] = hp_; \
                l_[i_] = cvt_pk_bf16(src[2 * i_] - bf_lo(hp_), src[2 * i_ + 1] - bf_hi(hp_)); } H = __builtin_bit_cast(bf16x8, h_); Lw = __builtin_bit_cast(bf16x8, l_); } while (0)
            bf16x8 bh[4][2], bl[4][2];
            { const float* wp = Wr + (size_t)(128 * wave + 8 * kq) * 32 + mi;
#pragma unroll
              for (int ks = 0; ks < 4; ++ks)
#pragma unroll
                  for (int hf = 0; hf < 2; ++hf) { float w8[8];
#pragma unroll
                      for (int jj = 0; jj < 8; ++jj) w8[jj] = wp[(32 * ks + jj) * 32 + 16 * hf];
                      SPLIT8(w8, bh[ks][hf], bl[ks][hf]); } }
            for (int blk = vcu; blk < S / 64; blk += G) {
                u32x2 zr[2][4];
#pragma unroll
                for (int tt = 0; tt < 2; ++tt)
#pragma unroll
                    for (int q = 0; q < 4; ++q) zr[tt][q] = *(const u32x2*)(Z + (size_t)(blk * 64 + wave * 2 + tt) * D + 4 * lane + 256 * q);
#pragma unroll 1
                for (int g = 0; g < 4; ++g) {
#pragma unroll
                    for (int tt = 0; tt < 2; ++tt) { const int tl16 = wave * 2 + tt, tok = blk * 64 + g * 16 + tl16;
                        f32x4 v[4]; float s = 0.f;
#pragma unroll
                        for (int q = 0; q < 4; ++q) { const u32x2 zw = zr[tt][q]; v[q][0] = bf_lo(zw.x); v[q][1] = bf_hi(zw.x); v[q][2] = bf_lo(zw.y); v[q][3] = bf_hi(zw.y); s += (v[q][0] + v[q][1]) + (v[q][2] + v[q][3]); }
                        if (g < 3) {
#pragma unroll
                            for (int q = 0; q < 4; ++q) zr[tt][q] = *(const u32x2*)(Z + (size_t)(tok + 16) * D + 4 * lane + 256 * q); }
                        const float mean = wsum_fast(s) * (1.0f / D); float s2 = 0.f;
#pragma unroll
                        for (int q = 0; q < 4; ++q) { v[q] = v[q] - mean; s2 += (v[q][0] * v[q][0] + v[q][1] * v[q][1]) + (v[q][2] * v[q][2] + v[q][3] * v[q][3]); }
                        const float rstd = 1.0f / sqrtf(wsum_fast(s2) * (1.0f / D) + LN_EPS);
#pragma unroll
                        for (int q = 0; q < 4; ++q) { v[q] = v[q] * rstd * gv[q] + bv[q];
                            u32x2 w; w.x = cvt_pk_bf16(v[q][0], v[q][1]); w.y = cvt_pk_bf16(v[q][2], v[q][3]); *(u32x2*)(XB1 + (size_t)tok * D + 4 * lane + 256 * q) = w;
#if MOE_FP8
                            *(unsigned*)(XF8 + (size_t)tok * D + 4 * lane + 256 * q) = pg8::pack4_fp8(v[q][0], v[q][1], v[q][2], v[q][3]);
#endif
                            *(LAS f32x4*)(XS + tl16 * XP + 4 * lane + 256 * q) = v[q]; }
                    }
                    __syncthreads();
                    f32x4 acc0 = {0.f, 0.f, 0.f, 0.f}, acc1 = {0.f, 0.f, 0.f, 0.f};
#pragma unroll
                    for (int ks = 0; ks < 4; ++ks) { const f32x4 a0 = *(const LAS f32x4*)(XS + mi * XP + 128 * wave + 32 * ks + 8 * kq), a1 = *(const LAS f32x4*)(XS + mi * XP + 128 * wave + 32 * ks + 8 * kq + 4);
                        const float x8[8] = {a0[0], a0[1], a0[2], a0[3], a1[0], a1[1], a1[2], a1[3]}; bf16x8 xh, xl; SPLIT8(x8, xh, xl);
                        acc0 = __builtin_amdgcn_mfma_f32_16x16x32_bf16(xh, bh[ks][0], acc0, 0, 0, 0); acc1 = __builtin_amdgcn_mfma_f32_16x16x32_bf16(xh, bh[ks][1], acc1, 0, 0, 0);
                        acc0 = __builtin_amdgcn_mfma_f32_16x16x32_bf16(xh, bl[ks][0], acc0, 0, 0, 0); acc1 = __builtin_amdgcn_mfma_f32_16x16x32_bf16(xh, bl[ks][1], acc1, 0, 0, 0);
                        acc0 = __builtin_amdgcn_mfma_f32_16x16x32_bf16(xl, bh[ks][0], acc0, 0, 0, 0); acc1 = __builtin_amdgcn_mfma_f32_16x16x32_bf16(xl, bh[ks][1], acc1, 0, 0, 0); }
                    *(LAS f32x4*)(PART + (wave * 64 + lane) * 8) = acc0; *(LAS f32x4*)(PART + (wave * 64 + lane) * 8 + 4) = acc1;
                    __syncthreads();
                    const int tw = wave * 2 + (lane >> 5), e = lane & 31, sl = (e & 15) + 16 * (tw >> 2), sc = (e >> 4) * 4 + (tw & 3);
                    float lg = rb[e];
#pragma unroll
                    for (int w2 = 0; w2 < 8; ++w2) lg += PART[(w2 * 64 + sl) * 8 + sc];
                    const unsigned ub = __float_as_uint(lg); const unsigned key = (((ub & 0x80000000u) ? ~ub : (ub | 0x80000000u)) & ~31u) | (unsigned)(31 - e);
                    int rank = 4; unsigned kk = key;
#pragma unroll
                    for (int rd = 0; rd < 4; ++rd) { unsigned mx = kk, o_;
                        o_ = (unsigned)__builtin_amdgcn_update_dpp(0, (int)mx, 0xB1, 0xF, 0xF, true); mx = mx > o_ ? mx : o_;
                        o_ = (unsigned)__builtin_amdgcn_update_dpp(0, (int)mx, 0x4E, 0xF, 0xF, true); mx = mx > o_ ? mx : o_;
                        o_ = (unsigned)__builtin_amdgcn_update_dpp(0, (int)mx, 0x124, 0xF, 0xF, true); mx = mx > o_ ? mx : o_;
                        o_ = (unsigned)__builtin_amdgcn_update_dpp(0, (int)mx, 0x128, 0xF, 0xF, true); mx = mx > o_ ? mx : o_;
                        { const auto rr = __builtin_amdgcn_permlane16_swap(mx, mx, false, false); mx = rr[0] > rr[1] ? rr[0] : rr[1]; }
                        if (kk == mx) { rank = rd; kk = 0u; } }
                    const unsigned long long m0 = __ballot(rank == 0);
                    const float va = __uint_as_float((unsigned)__builtin_amdgcn_readlane((int)__float_as_uint(lg), __builtin_ctz((unsigned)m0)));
                    const float vb = __uint_as_float((unsigned)__builtin_amdgcn_readlane((int)__float_as_uint(lg), 32 + __builtin_ctz((unsigned)(m0 >> 32))));
                    const float v0 = (lane & 32) ? vb : va;
                    const float ex = (rank < 4) ? fast_exp2((lg - v0) * LOG2E) : 0.f;
                    float se = ex; se += dppx<0xB1>(se); se += dppx<0x4E>(se); se += dppx<0x124>(se); se += dppx<0x128>(se);
                    { auto rr = __builtin_amdgcn_permlane16_swap(__float_as_uint(se), __float_as_uint(se), false, false); se = __uint_as_float(rr[0]) + __uint_as_float(rr[1]); }
                    if (rank < 4) { const int tl = g * 16 + tw; const float ww = ex / se;
                        const int rk = __hip_atomic_fetch_add(&hist[e], 1, __ATOMIC_RELAXED, __HIP_MEMORY_SCOPE_WORKGROUP); sel[(tl * 4 + rank) * 3 + 0] = e; sel[(tl * 4 + rank) * 3 + 1] = rk; sel[(tl * 4 + rank) * 3 + 2] = __float_as_int(ww); }
                }
                __syncthreads();
                if (tid < 32) { const int n = hist[tid]; basep[tid] = n ? (int)__hip_atomic_fetch_add((unsigned*)(ctl + CW_CNT + (L * 32 + tid) * 16), (unsigned)n, __ATOMIC_RELAXED, __HIP_MEMORY_SCOPE_AGENT) : 0; }
                __syncthreads();
                if (tid < 256) { const int ee = sel[tid * 3], pos = basep[ee] + sel[tid * 3 + 1]; const int tok = blk * 64 + (tid >> 2);
                    TOK[(size_t)ee * S + pos] = tok; GATE[(size_t)ee * S + pos] = __int_as_float(sel[tid * 3 + 2]); SLOT[((size_t)tok * 4 + (tid & 3)) * 2] = ee; SLOT[((size_t)tok * 4 + (tid & 3)) * 2 + 1] = pos; }
                __syncthreads();
                if (tid < 32) hist[tid] = 0;
                __syncthreads();
            }
        }
        SEAM(pb + 4);
        if (IN(pb + 5) || IN(pb + 6) || IN(pb + 7)) { TID_DECL;
            LAS int* toff = (LAS int*)(lds + LM_TOFF); LAS int* cntl = (LAS int*)(lds + LM_CNT);
            __syncthreads();
            if (wave == 0) { const int e = tid & 31;
                const int c = (int)__hip_atomic_load((unsigned*)(ctl + CW_CNT + (L * 32 + e) * 16), __ATOMIC_RELAXED, __HIP_MEMORY_SCOPE_AGENT); const int nt = (tid < 32) ? (c + 255) >> 8 : 0;
                int incl = nt;
#pragma unroll
                for (int dlt = 1; dlt < 32; dlt <<= 1) { const int o = __shfl_up(incl, dlt); if ((tid & 63) >= dlt) incl += o; }
                if (tid < 32) { cntl[e] = c; toff[e] = incl - nt; if (tid == 31) toff[32] = incl; } }
            __syncthreads();
            if (tid < 320) { int e = 0;
#pragma unroll
                for (int stp = 16; stp >= 1; stp >>= 1) { if (e + stp <= 31 && toff[e + stp] <= tid) e += stp; }
                ((LAS int*)(lds + LM_T2E))[tid] = e; }
            __syncthreads();
        }
        if (PHE(9) && IN(pb + 5)) REP(9) { WS_DECL;
#if MOE_FP8
            { pg8::Gemm g{(const bf16_t*)XF8, (const bf16_t*)(ws + WS_W1 + (size_t)L * 32 * 2048 * 1024), 512, (size_t)2048 * 512, wave};
#else
            { pg8::Gemm g{XB1, (const bf16_t*)(ws + WS_W1) + (size_t)L * 32 * 2048 * 1024, 1024, (size_t)2048 * 1024, wave};
#endif
              pg8::MoeOrder<true> So{(const LAS int*)(lds + LM_TOFF), (const LAS int*)(lds + LM_CNT), (const LAS int*)(lds + LM_T2E), TOK, 8, G, vcu};
              pg8::EpiMoeAct E{(unsigned char*)HS, ARGIN(I_EBIN) + (size_t)L * 32 * 2048};
              pg8::gemm_phase<pg8::EpiMoeAct, pg8::MoeOrder<true>, true>(lds, g, So, E); }
#if MOE_FP8
            { pg8::Gemm g{(const bf16_t*)XF8, (const bf16_t*)(ws + WS_WPG + (size_t)L * 1024 * 1024), 512, 0, wave}; pg8::StaticOrder So; So.init(S, D, G, bx);
#else
            { pg8::Gemm g{XB1, (const bf16_t*)(ws + WS_WPG) + (size_t)L * 1024 * 1024, 1024, 0, wave}; pg8::StaticOrder So; So.init(S, D, G, bx);
#endif
              pg8::EpiPle E{XB1, PP + (size_t)L * S * D, Z2};
              pg8::gemm_phase<pg8::EpiPle, pg8::StaticOrder, false>(lds, g, So, E); }
        }
        SEAM(pb + 5);
        if (PHE(10) && IN(pb + 6)) REP(10) { WS_DECL;
#if MOE_FP8
            pg8::Gemm g{HS, (const bf16_t*)(ws + WS_W2 + (size_t)L * 32 * 1024 * 1024), 512, (size_t)1024 * 512, wave};
#else
            pg8::Gemm g{HS, (const bf16_t*)(ws + WS_W2) + (size_t)L * 32 * 1024 * 1024, 1024, (size_t)1024 * 1024, wave};
#endif
            pg8::MoeOrder<false> So{(const LAS int*)(lds + LM_TOFF), (const LAS int*)(lds + LM_CNT), (const LAS int*)(lds + LM_T2E), TOK, 4, G, vcu};
            pg8::EpiMoeDown E{YS, ARGIN(I_EBOUT) + (size_t)L * 32 * 1024, GATE};
            pg8::gemm_phase<pg8::EpiMoeDown, pg8::MoeOrder<false>, true>(lds, g, So, E);
        }
        SEAM(pb + 6);
        if (PHE(11) && IN(pb + 7)) REP(11) { TID_DECL; WS_DECL;
            const LAS int* toff = (const LAS int*)(lds + LM_TOFF);
            const float* gam = ARGIN(I_LNFG) + L * D; const float* bet = ARGIN(I_LNFB) + L * D;
            f32x4 gv[4], bv[4];
#pragma unroll
            for (int q = 0; q < 4; ++q) { gv[q] = *(const f32x4*)(gam + 4 * lane + 256 * q); bv[q] = *(const f32x4*)(bet + 4 * lane + 256 * q); }
            for (int t0 = gw; t0 < S; t0 += 8 * NGW) {
              const int tl = t0 + (lane >> 3) * NGW; const int sw = (tl < S) ? SLOT[(size_t)tl * 8 + (lane & 7)] : 0;
#pragma unroll 1
              for (int i8 = 0; i8 < 8; ++i8) { const int tok = t0 + i8 * NGW; if (tok >= S) break;
                f32x4 v[4];
#pragma unroll
                for (int q = 0; q < 4; ++q) { const u32x2 zw = *(const u32x2*)(Z2 + (size_t)tok * D + 4 * lane + 256 * q); v[q][0] = bf_lo(zw.x); v[q][1] = bf_hi(zw.x); v[q][2] = bf_lo(zw.y); v[q][3] = bf_hi(zw.y); }
#pragma unroll
                for (int k = 0; k < 4; ++k) { const int ee = __builtin_amdgcn_readlane(sw, i8 * 8 + 2 * k), pos = __builtin_amdgcn_readlane(sw, i8 * 8 + 2 * k + 1); const bf16_t* yr = YS + ((size_t)toff[ee] * 256 + pos) * 1024;
#pragma unroll
                    for (int q = 0; q < 4; ++q) { const u32x2 w = *(const u32x2*)(yr + 4 * lane + 256 * q); v[q][0] += bf_lo(w.x); v[q][1] += bf_hi(w.x); v[q][2] += bf_lo(w.y); v[q][3] += bf_hi(w.y); } }
                float s = 0.f;
#pragma unroll
                for (int q = 0; q < 4; ++q) s += (v[q][0] + v[q][1]) + (v[q][2] + v[q][3]);
                const float mean = wave_sum(s) * (1.0f / D); float s2 = 0.f;
#pragma unroll
                for (int q = 0; q < 4; ++q) { v[q] = v[q] - mean; s2 += (v[q][0] * v[q][0] + v[q][1] * v[q][1]) + (v[q][2] * v[q][2] + v[q][3] * v[q][3]); }
                const float rstd = 1.0f / sqrtf(wave_sum(s2) * (1.0f / D) + LN_EPS);
#pragma unroll
                for (int q = 0; q < 4; ++q) { v[q] = v[q] * rstd * gv[q] + bv[q]; if (L == DEPTH - 1) *(f32x4*)(args.out + (size_t)tok * D + 4 * lane + 256 * q) = v[q];
                    u32x2 w; w.x = cvt_pk_bf16(v[q][0], v[q][1]); w.y = cvt_pk_bf16(v[q][2], v[q][3]); *(u32x2*)(XB + (size_t)tok * D + 4 * lane + 256 * q) = w; }
              }
            }
        }
        SEAM(pb + 7);
    }
}

extern "C" void kernel_launch(void* const* d_in, const int* in_sizes, int n_in, void* d_out, int out_size, void* d_ws, size_t ws_size, hipStream_t stream) {
    static int grid = 0;
    if (grid == 0) {
        if (n_in != 26 || out_size != S * D || ws_size < WS_END) { fprintf(stderr, "kernel_launch: unexpected shapes (n_in %d out %d ws %zu need %zu)\n", n_in, out_size, ws_size, (size_t)WS_END); grid = -1; return; }
        int dev = 0, cus = 0, per_cu = 0;
        if (hipGetDevice(&dev) != hipSuccess || hipDeviceGetAttribute(&cus, hipDeviceAttributeMultiprocessorCount, dev) != hipSuccess) { grid = -1; return; }
        if (hipFuncSetAttribute((const void*)mk_fwd, hipFuncAttributeMaxDynamicSharedMemorySize, LDS_BYTES) != hipSuccess) { fprintf(stderr, "kernel_launch: hipFuncSetAttribute failed\n"); grid = -1; return; }
        if (hipOccupancyMaxActiveBlocksPerMultiprocessor(&per_cu, (const void*)mk_fwd, NTHREADS, LDS_BYTES) != hipSuccess || per_cu < 1) { fprintf(stderr, "kernel_launch: occupancy query says %d\n", per_cu); }
        (void)hipGetLastError();
        grid = cus;
    }
    if (grid < 0) return;
    hipMemsetAsync((char*)d_ws + WS_CTL, 0, CTL_BYTES, stream);
    Args a{};
    for (int i = 0; i < 26; ++i) a.in[i] = (const float*)d_in[i];
    a.out = (float*)d_out; a.ws = (unsigned char*)d_ws;
    for (int i = 0; i < 16; ++i) a.inv_freq[i] = powf(10000.0f, -(float)(2 * i) / 32.0f);
    const int NPH = 2 + 8 * DEPTH;
#if MK_ONE_LAUNCH
    a.ph_lo = 0; a.ph_hi = NPH;
    hipLaunchKernelGGL(mk_fwd, dim3(grid), dim3(NTHREADS), LDS_BYTES, stream, a);
#else
    for (int ph = 0; ph < NPH; ++ph) {
        if (ph >= 2 && ((ph - 2) % 8) == 1 && (((ph - 2) / 8) & 1)) continue;
        a.ph_lo = ph; a.ph_hi = ph + 1;
        hipLaunchKernelGGL(mk_fwd, dim3(grid), dim3(NTHREADS), LDS_BYTES, stream, a);
    }
#endif
}
```

```cpp
#include <hip/hip_runtime.h>
#include <cstdio>
#include <cstdint>
#include <cmath>

#ifndef MK_ONE_LAUNCH
#define MK_ONE_LAUNCH 1
#endif
#ifndef NAIVE_ATTN
#define NAIVE_ATTN 0
#endif
#ifndef MOE_FP8
#define MOE_FP8 1
#endif
#ifndef ATT_C_FP8
#define ATT_C_FP8 1
#endif
#ifndef ATT_B_FP8
#define ATT_B_FP8 1
#endif
#ifndef REF_GEMM
#define REF_GEMM 0
#endif

#define LAS __attribute__((address_space(3)))
#define GAS __attribute__((address_space(1)))
typedef unsigned short bf16_t;
typedef short bf16x8 __attribute__((ext_vector_type(8)));
typedef float f32x4 __attribute__((ext_vector_type(4)));
typedef float f32x2 __attribute__((ext_vector_type(2)));
typedef unsigned u32x4 __attribute__((ext_vector_type(4)));
typedef unsigned u32x2 __attribute__((ext_vector_type(2)));
typedef GAS unsigned gu32;

constexpr int S = 16384, D = 1024, DEPTH = 4, PLE = 256;
constexpr int NE = 32, TOPK = 4, DFF = 1024;
constexpr int AB_IN = 2336;
constexpr float LOG2E = 1.4426950408889634f;
constexpr float DN_ALPHA = 1.681792830507429f;
constexpr float LN_EPS = 1e-5f, RMS_EPS = 1e-6f;
constexpr int NWAVES = 8, NTHREADS = 512;
constexpr int SLOT_ROWS = 65536 + NE * 256;

constexpr size_t MiB = 1u << 20;
constexpr size_t CTL_BYTES = 1 * MiB;
constexpr size_t al(size_t x) { return (x + MiB - 1) / MiB * MiB; }
constexpr size_t WS_CTL = 0;
constexpr size_t WS_TAB = WS_CTL + CTL_BYTES;
constexpr size_t TAB_ROPE = 0;
constexpr size_t TAB_WRT = 2 * MiB;
constexpr size_t TAB_BIASA = TAB_WRT + 512 * 1024;
constexpr size_t TAB_T5 = TAB_BIASA + 32 * 1024;
constexpr size_t TAB_LAM = TAB_T5 + 8 * 1024;
constexpr size_t TAB_FA = TAB_LAM + 1024;
constexpr size_t TAB_FAFAR = TAB_FA + 3 * 8 * 256 * 4;
constexpr size_t WS_WABIN = WS_TAB + 4 * MiB;
constexpr size_t WS_WUQ = WS_WABIN + al((size_t)2 * 2560 * 1024 * 2);
constexpr size_t WS_WUKVK = WS_WUQ + al((size_t)2 * 768 * 512 * 2);
constexpr size_t WS_WUKVV = WS_WUKVK + al((size_t)2 * 512 * 256 * 2);
constexpr size_t WS_WABOUT = WS_WUKVV + al((size_t)2 * 512 * 256 * 2);
constexpr size_t WS_WCIN = WS_WABOUT + al((size_t)2 * 1024 * 1024 * 2);
constexpr size_t WS_WCOUT = WS_WCIN + al((size_t)2 * 3072 * 1024 * 2);
constexpr size_t WS_WPG = WS_WCOUT + al((size_t)2 * 1024 * 1024 * 2);
constexpr size_t WS_WPP = WS_WPG + al((size_t)4 * 1024 * 1024 * 2);
constexpr size_t WS_W1 = WS_WPP + al((size_t)4 * 1024 * 256 * 2);
constexpr size_t WS_W2 = WS_W1 + al((size_t)4 * 32 * 2048 * 1024 * 2);
constexpr size_t WS_XB = WS_W2 + al((size_t)4 * 32 * 1024 * 1024 * 2);
constexpr size_t WS_PB = WS_XB + al((size_t)S * D * 2);
constexpr size_t WS_PP = WS_PB + al((size_t)4 * S * 256 * 2);
constexpr size_t WS_QA = WS_PP + al((size_t)4 * S * D * 2);
constexpr size_t WS_KA = WS_QA + al((size_t)S * 512 * 2);
constexpr size_t WS_VAT = WS_KA + al((size_t)S * 512 * 2);
constexpr size_t WS_CQ = WS_VAT + al((size_t)S * 512 * 2);
constexpr size_t WS_CKV = WS_CQ + al((size_t)S * 512 * 2);
constexpr size_t WS_SSQQ = WS_CKV + al((size_t)S * 256 * 2);
constexpr size_t WS_SSQKV = WS_SSQQ + al((size_t)S * 8 * 4);
constexpr size_t WS_QB = WS_SSQKV + al((size_t)S * 4 * 4);
constexpr size_t WS_KB = WS_QB + al((size_t)S * 768 * 2);
constexpr size_t WS_VBT = WS_KB + al((size_t)S * 768 * 2);
constexpr size_t WS_QC = WS_VBT + al((size_t)S * 512 * 2);
constexpr size_t WS_KC = WS_QC + al((size_t)S * D * 2);
constexpr size_t WS_VCT = WS_KC + al((size_t)S * D * 2);
constexpr size_t WS_OAB = WS_VCT + al((size_t)S * D * 2);
constexpr size_t WS_Z = WS_OAB + al((size_t)S * D * 2);
constexpr size_t WS_X1 = WS_Z + al((size_t)S * D * 4);
constexpr size_t WS_XB1 = WS_X1 + al((size_t)S * D * 4);
constexpr size_t WS_Z2 = WS_XB1 + al((size_t)S * D * 2);
constexpr size_t WS_HS = WS_Z2 + al((size_t)S * D * 4);
constexpr size_t WS_YS = WS_HS + al((size_t)SLOT_ROWS * 1024 * 2);
constexpr size_t WS_TOK = WS_YS + al((size_t)SLOT_ROWS * 1024 * 2);
constexpr size_t WS_GATE = WS_TOK + al((size_t)NE * S * 4);
constexpr size_t WS_SLOT = WS_GATE + al((size_t)NE * S * 4);
constexpr size_t WS_XF8 = WS_SLOT + al((size_t)S * 4 * 8);
constexpr size_t WS_END = WS_XF8 + al((size_t)S * D);

constexpr int CW_BAR = 4096;
constexpr int CW_CNT = 16384;

constexpr int LDS_BYTES = 147456;
constexpr int LM = 131072;
constexpr int LM_BAR = LM + 0;
constexpr int LM_TOFF = LM + 64;
constexpr int LM_CNT = LM + 256;
constexpr int LM_HIST = LM + 512;
constexpr int LM_BASE = LM + 640;
constexpr int LM_SEL = LM + 1024;
constexpr int LM_FLAG = LM + 32;
constexpr int LM_T2E = LM + 4608;
constexpr int LM_FREE = LM + 8192;

__device__ __forceinline__ unsigned cvt_pk_bf16(float lo, float hi) { unsigned r; asm volatile("v_cvt_pk_bf16_f32 %0, %1, %2" : "=v"(r) : "v"(lo), "v"(hi)); return r; }
__device__ __forceinline__ float bf_lo(unsigned w) { return __uint_as_float(w << 16); }
__device__ __forceinline__ float bf_hi(unsigned w) { return __uint_as_float(w & 0xffff0000u); }
__device__ __forceinline__ float bf2f(bf16_t h) { return __uint_as_float(((unsigned)h) << 16); }
__device__ __forceinline__ float wave_sum(float v) {
#pragma unroll
    for (int o = 1; o < 64; o <<= 1) v += __shfl_xor(v, o);
    return v;
}
__device__ __forceinline__ float wave_max(float v) {
#pragma unroll
    for (int o = 1; o < 64; o <<= 1) v = fmaxf(v, __shfl_xor(v, o));
    return v;
}
__device__ __forceinline__ float rdlane(float v, int l) { return __uint_as_float((unsigned)__builtin_amdgcn_readlane((int)__float_as_uint(v), l)); }
__device__ __forceinline__ float fast_exp2(float x) { return __builtin_amdgcn_exp2f(x); }
__device__ __forceinline__ float fast_rcp(float x) { return __builtin_amdgcn_rcpf(x); }
__device__ __forceinline__ float sigmoidf_(float x) { return fast_rcp(1.0f + fast_exp2(-x * LOG2E)); }
__device__ __forceinline__ int lane_id_asm() { int l; asm volatile("v_mbcnt_lo_u32_b32 %0, -1, 0\n\tv_mbcnt_hi_u32_b32 %0, -1, %0" : "=v"(l)); return l; }
template <int CTRL> __device__ __forceinline__ float dppx(float v) { return __uint_as_float((unsigned)__builtin_amdgcn_update_dpp(0, (int)__float_as_uint(v), CTRL, 0xF, 0xF, true)); }
__device__ __forceinline__ float xpart16(float v, int lane) { auto rr = __builtin_amdgcn_permlane16_swap(__float_as_uint(v), __float_as_uint(v), false, false); return __uint_as_float((lane & 16) ? rr[0] : rr[1]); }
__device__ __forceinline__ float xpart32(float v, int lane) { auto rr = __builtin_amdgcn_permlane32_swap(__float_as_uint(v), __float_as_uint(v), false, false); return __uint_as_float((lane & 32) ? rr[0] : rr[1]); }
__device__ __forceinline__ float wsum_fast(float v) {
    v += dppx<0xB1>(v); v += dppx<0x4E>(v); v += dppx<0x124>(v); v += dppx<0x128>(v);
    { auto rr = __builtin_amdgcn_permlane16_swap(__float_as_uint(v), __float_as_uint(v), false, false); v = __uint_as_float(rr[0]) + __uint_as_float(rr[1]); }
    { auto rr = __builtin_amdgcn_permlane32_swap(__float_as_uint(v), __float_as_uint(v), false, false); v = __uint_as_float(rr[0]) + __uint_as_float(rr[1]); }
    return v;
}
#define LDS_WAIT() asm volatile("s_waitcnt lgkmcnt(0)" ::: "memory")
#define VM_WAIT() asm volatile("s_waitcnt vmcnt(0)" ::: "memory")

#define XB_TMO      128
#define XB_XCNT(j)  (256  + 64 * (j))
#define XB_XSUB(j)  (1280 + 64 * (j))
#define XB_XGEN(j)  (2304 + 64 * (j))
#define XB_TOP      3328
#define XB_TOPGEN   3392
#define XCD_BAR_WORDS 3456
#define XB_SPIN_CAP (1u << 22)
__device__ __forceinline__ unsigned xb_ld(unsigned* p)              { return __hip_atomic_load(p, __ATOMIC_RELAXED, __HIP_MEMORY_SCOPE_AGENT); }
__device__ __forceinline__ unsigned xb_add(unsigned* p, unsigned v) { return __hip_atomic_fetch_add(p, v, __ATOMIC_RELAXED, __HIP_MEMORY_SCOPE_AGENT); }
__device__ __forceinline__ unsigned xb_xcc_id() { return (unsigned)__builtin_amdgcn_s_getreg((3 << 11) | 20) & 0xFu; }
#define XB_SPIN(cond, bar) do { unsigned _sp = 0; while (cond) { __builtin_amdgcn_s_sleep(1); \
    if ((++_sp & 255u) == 0u) { if (xb_ld(&(bar)[XB_TMO])) break; if (_sp > XB_SPIN_CAP) { atomicAdd(&(bar)[XB_TMO], 1u); break; } } } } while (0)
struct XcdBarrier { unsigned* bar; unsigned x; volatile LAS unsigned* st; };
__device__ __forceinline__ XcdBarrier xcd_barrier_post(unsigned* bar, volatile LAS unsigned* st) {
    XcdBarrier b; b.bar = bar; b.x = xb_xcc_id(); b.st = st;
    if (threadIdx.x == 0) (void)xb_add(&bar[XB_XCNT(b.x)], 1u);
    return b;
}
__device__ __forceinline__ void xcd_barrier_complete(unsigned* bar, unsigned x, unsigned& nloc, unsigned& nx) {
    const unsigned G = gridDim.x * gridDim.y * gridDim.z;
    unsigned sum, cnt, mine, sp = 0u;
    for (;;) {
        sum = 0u; cnt = 0u; mine = 0u;
#pragma unroll
        for (unsigned j = 0; j < 16; ++j) { const unsigned c = xb_ld(&bar[XB_XCNT(j)]); sum += c; cnt += (c > 0u) ? 1u : 0u; mine = (j == x) ? c : mine; }
        if (sum == G) break;
        __builtin_amdgcn_s_sleep(1);
        if ((++sp & 255u) == 0u) { if (xb_ld(&bar[XB_TMO])) break; if (sp > XB_SPIN_CAP) { atomicAdd(&bar[XB_TMO], 1u); break; } }
    }
    nloc = mine > 0u ? mine : 1u; nx = cnt > 0u ? cnt : 1u;
}
__device__ __forceinline__ void xcd_barrier(const XcdBarrier& b) {
    asm volatile("s_waitcnt vmcnt(0)" ::: "memory");
    __syncthreads();
    if (threadIdx.x == 0) {
        unsigned* bar = b.bar;
        __builtin_amdgcn_s_waitcnt(0);
        unsigned nloc = b.st[0], nx = b.st[1];
        if (nloc == 0u) { xcd_barrier_complete(bar, b.x, nloc, nx); b.st[0] = nloc; b.st[1] = nx; }
        const unsigned old = xb_add(&bar[XB_XSUB(b.x)], 1u);
        const unsigned gen = old / nloc;
        if (old + 1u == (gen + 1u) * nloc) {
            __builtin_amdgcn_fence(__ATOMIC_RELEASE, "agent");
            asm volatile("s_waitcnt vmcnt(0)" ::: "memory");
            const unsigned og = xb_add(&bar[XB_TOP], 1u);
            const unsigned tg = og / nx;
            if (og + 1u == (tg + 1u) * nx) xb_add(&bar[XB_TOPGEN], 1u);
            else XB_SPIN(xb_ld(&bar[XB_TOPGEN]) == tg, bar);
            __builtin_amdgcn_fence(__ATOMIC_ACQUIRE, "agent");
            xb_add(&bar[XB_XGEN(b.x)], 1u);
            asm volatile("s_waitcnt vmcnt(0)" ::: "memory");
        } else {
            XB_SPIN(xb_ld(&bar[XB_XGEN(b.x)]) == gen, bar);
            __builtin_amdgcn_fence(__ATOMIC_ACQUIRE, "agent");
            asm volatile("s_waitcnt vmcnt(0)" ::: "memory");
        }
    }
    __syncthreads();
}

namespace pg8 {
constexpr int BM = 256, BK = 64, HALF = 128, HTB = HALF * BK * 2, STAGE_BYTES = 8 * HTB, NXCD = 8, WGM = 8;
__host__ __device__ __forceinline__ int lds_byte(int r, int c) { const int st = (r >> 4) * 2 + (c >> 5), rr = r & 15, cc = c & 31, ob = rr * 64 + cc * 2; return st * 1024 + (ob ^ (((ob >> 9) & 1) << 5)); }
__host__ __device__ __forceinline__ void stage_rc(int b, int& R, int& C) { const int st = b / 1024, sb = b % 1024, swz = sb ^ (((sb >> 9) & 1) << 5); R = (st >> 1) * 16 + swz / 64; C = (st & 1) * 32 + (swz % 64) / 2; }
__host__ __device__ __forceinline__ int perm32(int rho) { const int n = rho >> 4, i = rho & 15; return 8 * (i >> 2) + 4 * n + (i & 3); }

struct Unit { int pm, pn, e, aux; };
struct Gemm { const bf16_t* A; const bf16_t* Bt; int K; size_t strideBe; int wave; };

struct StaticOrder {
    static constexpr bool GATHER = false;
    int nM, nN, nwg, G, c;
    __device__ __forceinline__ void init(int M, int N, int G_, int c_) { nM = M / BM; nN = N / BM; nwg = nM * nN; G = G_; c = c_; }
    __device__ __forceinline__ bool next(int i, Unit& u) const {
        const long L = (long)i * G + c; if (L >= nwg) return false;
        int wgid = (int)L; { const int q = nwg / NXCD, r = nwg % NXCD, xcd = wgid % NXCD, off = wgid / NXCD; wgid = (xcd < r ? xcd * (q + 1) : r * (q + 1) + (xcd - r) * q) + off; }
        const int nig = WGM * nN, gid = wgid / nig, fm = gid * WGM, gsz = (nM - fm) < WGM ? (nM - fm) : WGM;
        u.pm = fm + ((wgid % nig) % gsz); u.pn = (wgid % nig) / gsz; u.e = 0; u.aux = 0; return true;
    }
    __device__ __forceinline__ int arow(const Unit& u, int r) const { return u.pm * BM + r; }
};

struct LayeredOrder {
    static constexpr bool GATHER = false;
    StaticOrder so;
    __device__ __forceinline__ bool next(int i, Unit& u) const { if (!so.next(i, u)) return false; u.e = u.pm / (S / BM); return true; }
    __device__ __forceinline__ int arow(const Unit& u, int r) const { return u.pm * BM + r; }
};
#define PG8_SA(b, h) (((b) * 2 + (h)) * HTB)
#define PG8_SB(b, h) ((4 + (b) * 2 + (h)) * HTB)
__device__ __forceinline__ const char* uniform_ptr(const void* p) { const unsigned long long a = (unsigned long long)p; const unsigned lo = (unsigned)__builtin_amdgcn_readfirstlane((int)(unsigned)a), hi = (unsigned)__builtin_amdgcn_readfirstlane((int)(unsigned)(a >> 32)); return (const char*)(((unsigned long long)hi << 32) | lo); }
__device__ __forceinline__ void glds_sv(const void* base, unsigned voff, unsigned ldsaddr) { unsigned keep;
    asm volatile("s_mov_b32 %0, m0\n\ts_mov_b32 m0, %3\n\ts_nop 0\n\tglobal_load_lds_dwordx4 %1, %2\n\ts_mov_b32 m0, %0" : "=&s"(keep) : "v"(voff), "s"(base), "s"(ldsaddr) : "memory"); }
__device__ __forceinline__ void glds_dw(const void* base, unsigned voff, unsigned ldsaddr) { unsigned keep;
    asm volatile("s_mov_b32 %0, m0\n\ts_mov_b32 m0, %3\n\ts_nop 0\n\tglobal_load_lds_dword %1, %2\n\ts_mov_b32 m0, %0" : "=&s"(keep) : "v"(voff), "s"(base), "s"(ldsaddr) : "memory"); }
#define PG8_STAGE_B(bufoff, gbase) do { _Pragma("unroll") for (int _i = 0; _i < 2; ++_i) \
        glds_sv((const char*)(gbase), voffB[_i], ldsbase + (unsigned)((bufoff) + _i * 8192)); } while (0)
#define PG8_STAGE_A(bufoff, kofs, W, h) do { _Pragma("unroll") for (int _i = 0; _i < 2; ++_i) { \
        if constexpr (GATH) glds_sv(gA + (kofs), v##W[(h) % NH][_i], ldsbase + (unsigned)((bufoff) + _i * 8192)); \
        else glds_sv(u##W + (kofs) + (size_t)(h) * hstep, voffA[_i], ldsbase + (unsigned)((bufoff) + _i * 8192)); } } while (0)
typedef int i32x8 __attribute__((ext_vector_type(8)));
typedef int i32x4 __attribute__((ext_vector_type(4)));
__device__ __forceinline__ i32x8 ld_pair(const LAS unsigned char* p) { const i32x4 x = *(const LAS i32x4*)p, y = *(const LAS i32x4*)(p + 1024); return __builtin_shufflevector(x, y, 0, 1, 2, 3, 4, 5, 6, 7); }
__device__ __forceinline__ bf16x8 half_lo(i32x8 v) { const i32x4 x = __builtin_shufflevector(v, v, 0, 1, 2, 3); return __builtin_bit_cast(bf16x8, x); }
__device__ __forceinline__ bf16x8 half_hi(i32x8 v) { const i32x4 x = __builtin_shufflevector(v, v, 4, 5, 6, 7); return __builtin_bit_cast(bf16x8, x); }
#define PG8_LDA(dst, b, h) do { _Pragma("unroll") for (int m = 0; m < 4; ++m) dst[m] = ld_pair(lds + PG8_SA(b, h) + aoff + m * 2048); } while (0)
#define PG8_LDB(dst, b, h) do { _Pragma("unroll") for (int n = 0; n < 2; ++n) dst[n] = ld_pair(lds + PG8_SB(b, h) + boff + n * 2048); } while (0)
#define PG8_MMA(ai, bj, At, Bt) do { __builtin_amdgcn_s_setprio(1); _Pragma("unroll") for (int m = 0; m < 4; ++m) _Pragma("unroll") for (int n = 0; n < 2; ++n) { \
        if constexpr (Epi::FP8) asm volatile("v_mfma_scale_f32_16x16x128_f8f6f4 %0, %1, %2, %0, %3, %3 op_sel_hi:[0,0,0]" : "+v"(acc[ai][bj][m][n]) : "v"(Bt[n]), "v"(At[m]), "v"(0x7F7F7F7F)); \
        else { acc[ai][bj][m][n] = __builtin_amdgcn_mfma_f32_16x16x32_bf16(half_lo(Bt[n]), half_lo(At[m]), acc[ai][bj][m][n], 0, 0, 0); \
               acc[ai][bj][m][n] = __builtin_amdgcn_mfma_f32_16x16x32_bf16(half_hi(Bt[n]), half_hi(At[m]), acc[ai][bj][m][n], 0, 0, 0); } } \
        __builtin_amdgcn_s_setprio(0); } while (0)
#define PG8_WAIT_V(n) asm volatile("s_waitcnt vmcnt(" #n ")" ::: "memory")
#define PG8_WAIT_L(n) asm volatile("s_waitcnt lgkmcnt(" #n ")" ::: "memory")
#define PG8_BAR __builtin_amdgcn_s_barrier()
#define PG8_SCHED __builtin_amdgcn_sched_barrier(0)
#define PG8_SETOFF(W, UN) do { if constexpr (GATH) { _Pragma("unroll") for (int _i = 0; _i < 2; ++_i) { int _R, _C; stage_rc(tid * 16 + _i * 8192, _R, _C); \
        _Pragma("unroll") for (int _h = 0; _h < 2; ++_h) v##W[_h][_i] = (unsigned)S.arow((UN), _h * HALF + _R) * (unsigned)(K * 2) + (unsigned)_C * 2u; } } \
        else { u##W = gA + (size_t)S.arow((UN), 0) * (size_t)(K * 2); } } while (0)
#define PG8_ZERO_ACC() do { _Pragma("unroll") for (int a = 0; a < 2; ++a) _Pragma("unroll") for (int b = 0; b < 2; ++b) _Pragma("unroll") for (int m = 0; m < 4; ++m) _Pragma("unroll") for (int n = 0; n < 2; ++n) acc[a][b][m][n] = (f32x4){0.f, 0.f, 0.f, 0.f}; } while (0)
#define PG8_KPASS(k1, k2, b2, b3, W) do { \
            PG8_LDB(B0, 0, 0); PG8_LDB(B1, 0, 1); PG8_SCHED; PG8_LDA(At, 0, 0); PG8_STAGE_A(PG8_SA(1, 1), k1, cur, 1); \
            PG8_WAIT_V(8); PG8_WAIT_L(0); PG8_BAR; PG8_MMA(0, 0, At, B0); PG8_MMA(0, 1, At, B1); PG8_BAR; PG8_SCHED; \
            PG8_LDA(At, 0, 1); PG8_STAGE_B(PG8_SB(0, 0), b2); PG8_STAGE_B(PG8_SB(0, 1), (b2) + hstep); PG8_STAGE_A(PG8_SA(0, 0), k2, W, 0); \
            PG8_WAIT_V(8); PG8_WAIT_L(0); PG8_BAR; PG8_MMA(1, 0, At, B0); PG8_MMA(1, 1, At, B1); PG8_BAR; PG8_SCHED; \
            PG8_LDB(B0, 1, 0); PG8_LDB(B1, 1, 1); PG8_SCHED; PG8_LDA(At, 1, 0); PG8_STAGE_A(PG8_SA(0, 1), k2, W, 1); \
            PG8_WAIT_V(8); PG8_WAIT_L(0); PG8_BAR; PG8_MMA(0, 0, At, B0); PG8_MMA(0, 1, At, B1); PG8_BAR; PG8_SCHED; \
            PG8_LDA(At, 1, 1); PG8_STAGE_B(PG8_SB(1, 0), b3); PG8_STAGE_B(PG8_SB(1, 1), (b3) + hstep); PG8_STAGE_A(PG8_SA(1, 0), (k2) + kstep, W, 0); \
            PG8_WAIT_V(8); PG8_WAIT_L(0); PG8_BAR; PG8_MMA(1, 0, At, B0); PG8_MMA(1, 1, At, B1); PG8_BAR; PG8_SCHED; } while (0)

struct NoPre {};
template <class T, class = void> struct EpiHasPre { static constexpr bool value = false; };
template <class T> struct EpiHasPre<T, decltype((void)sizeof(typename T::Pre))> { static constexpr bool value = true; };
template <class Epi> __device__ __forceinline__ auto epi_pre(const Epi& E, const Unit& u, int wr, int wc) { if constexpr (EpiHasPre<Epi>::value) return E.pre(u, wr, wc); else return NoPre{}; }
#if !REF_GEMM
template <class Epi, class Sched, bool ALIGN_EPI>
__device__ __forceinline__ void gemm_phase(LAS unsigned char* lds, const Gemm g, const Sched& S, const Epi& E) {
    const int wid = g.wave, lane = lane_id_asm(), tid = wid * 64 + lane,
              wr = wid >> 2, wc = wid & 3, fr = lane & 15, fq = lane >> 4;
    const int K = g.K, nt = K / BK;
    constexpr bool GATH = Sched::GATHER; constexpr int NH = GATH ? 2 : 1;
    unsigned voffA[2], voffB[2];
#pragma unroll
    for (int i = 0; i < 2; ++i) { int R, C; stage_rc(tid * 16 + i * 8192, R, C); const int Rb = Epi::PERM ? ((R & ~31) + perm32(R & 31)) : R; voffA[i] = (unsigned)(R * K + C) * 2u; voffB[i] = (unsigned)(Rb * K + C) * 2u; }
    const size_t kstep = (size_t)(BK * 2);
    const size_t hstep = (size_t)HALF * K * 2;
    const size_t tstep = 2 * hstep;
    const unsigned ldsbase = (unsigned)__builtin_amdgcn_readfirstlane((int)((unsigned)(size_t)lds + (unsigned)wid * 1024u));
    const int aoff = lds_byte(wr * 64 + fr, fq * 8), boff = lds_byte(wc * 32 + fr, fq * 8);
    Unit cur, nxt; int ui = 0;
    if (!S.next(0, cur)) return;
    f32x4 acc[2][2][4][2];
    PG8_ZERO_ACC();
    i32x8 At[4], B0[2], B1[2];
    const char* gA = (const char*)g.A;
    const char* cB = (const char*)(g.Bt + (size_t)cur.e * g.strideBe) + (size_t)cur.pn * tstep;
    unsigned vcur[NH][2], vnxt[NH][2]; const char* ucur = gA; const char* unxt = gA;
    (void)vcur; (void)vnxt; (void)ucur; (void)unxt; (void)voffA;
    PG8_SETOFF(cur, cur);
    PG8_STAGE_B(PG8_SB(0, 0), cB); PG8_STAGE_B(PG8_SB(0, 1), cB + hstep); PG8_STAGE_A(PG8_SA(0, 0), 0, cur, 0); PG8_STAGE_A(PG8_SA(0, 1), 0, cur, 1);
    if (wr == 1) PG8_BAR;
    PG8_WAIT_V(2); PG8_BAR;
    PG8_STAGE_B(PG8_SB(1, 0), cB + kstep); PG8_STAGE_A(PG8_SA(1, 0), kstep, cur, 0); PG8_STAGE_B(PG8_SB(1, 1), cB + hstep + kstep);
    PG8_WAIT_V(6); PG8_BAR;
    for (;;) {
        const bool has_next = S.next(ui + 1, nxt);
        const char* nB = cB;
        if (has_next) { nB = (const char*)(g.Bt + (size_t)nxt.e * g.strideBe) + (size_t)nxt.pn * tstep;
            if constexpr (GATH) {
                const unsigned scr = (unsigned)(LM_FREE + wid * 1024 + lane * 4);
                if (ui == 0) { PG8_SETOFF(nxt, nxt); }
                else {
#pragma unroll
                    for (int _i = 0; _i < 2; ++_i) { int _R, _C; stage_rc(tid * 16 + _i * 8192, _R, _C);
#pragma unroll
                        for (int _h = 0; _h < 2; ++_h) vnxt[_h][_i] = (unsigned)(*(const LAS int*)(lds + scr + (_h * 2 + _i) * 256)) * (unsigned)(K * 2) + (unsigned)_C * 2u; }
                }
                Unit n2;
                if (S.next(ui + 2, n2)) { asm volatile("s_waitcnt lgkmcnt(0)" ::: "memory");
#pragma unroll
                    for (int _i = 0; _i < 2; ++_i) { int _R, _C; stage_rc(tid * 16 + _i * 8192, _R, _C);
#pragma unroll
                        for (int _h = 0; _h < 2; ++_h) glds_dw(uniform_ptr(S.tokbase(n2)), S.tokidx(n2, _h * HALF + _R) * 4u, (unsigned)__builtin_amdgcn_readfirstlane((int)((unsigned)(size_t)lds + (unsigned)(LM_FREE + wid * 1024 + (_h * 2 + _i) * 256)))); }
                }
            } else { PG8_SETOFF(nxt, nxt); }
        }
        else { unxt = ucur;
#pragma unroll
            for (int h = 0; h < NH; ++h)
#pragma unroll
                for (int i = 0; i < 2; ++i) vnxt[h][i] = vcur[h][i];
        }
        int t = 0;
#pragma clang loop unroll(disable)
        for (; t < nt - 2; t += 2) {
            const size_t k1 = (size_t)(t + 1) * kstep, k2 = (size_t)(t + 2) * kstep; const char* b2 = cB + k2; const char* b3 = b2 + kstep;
            PG8_KPASS(k1, k2, b2, b3, cur);
        }
        const auto pre = epi_pre(E, cur, wr, wc);
        {
            const size_t k1 = (size_t)(t + 1) * kstep; const char* b3 = nB + kstep;
            PG8_KPASS(k1, (size_t)0, nB, b3, nxt);
            cB = nB;
        }
        if constexpr (ALIGN_EPI) { if (wr == 0) PG8_BAR; }
        if constexpr (Epi::FP8) asm volatile("s_nop 15\n\ts_nop 15" ::: "memory");
        if constexpr (EpiHasPre<Epi>::value) E(acc, cur, wr, wc, fr, fq, pre); else E(acc, cur, wr, wc, fr, fq);
        if (!has_next) break;
        PG8_ZERO_ACC();
        cur = nxt; ++ui; ucur = unxt;
#pragma unroll
        for (int h = 0; h < NH; ++h)
#pragma unroll
            for (int i = 0; i < 2; ++i) vcur[h][i] = vnxt[h][i];
        if constexpr (ALIGN_EPI) { if (wr == 1) PG8_BAR; }
    }
    PG8_WAIT_V(0);
    if constexpr (!ALIGN_EPI) { if (wr == 0) PG8_BAR; }
    PG8_BAR;
}
#else
template <class Epi, class Sched, bool ALIGN_EPI>
__device__ __forceinline__ void gemm_phase(LAS unsigned char* lds, const Gemm g, const Sched& S, const Epi& E) {
    const int wid = g.wave, lane = lane_id_asm(), wr = wid >> 2, wc = wid & 3, fr = lane & 15, fq = lane >> 4;
    const int K = g.K;
    Unit u;
    for (int ui = 0; S.next(ui, u); ++ui) {
        f32x4 acc[2][2][4][2];
        const bf16_t* Bb = g.Bt + (size_t)u.e * g.strideBe + (size_t)u.pn * 256 * K;
        for (int ai = 0; ai < 2; ++ai) for (int m = 0; m < 4; ++m) {
            const bf16_t* ap = g.A + (size_t)S.arow(u, ai * 128 + wr * 64 + m * 16 + fr) * K;
            for (int bj = 0; bj < 2; ++bj) for (int n = 0; n < 2; ++n) { f32x4 r;
                for (int j = 0; j < 4; ++j) {
                    const int col = 128 * bj + 32 * wc + (Epi::PERM ? 8 * fq + 4 * n + j : 16 * n + 4 * fq + j);
                    const bf16_t* bp = Bb + (size_t)col * K; float s = 0.f;
                    for (int k = 0; k < K; k += 8) { const u32x4 a = *(const u32x4*)(ap + k), b = *(const u32x4*)(bp + k);
                        s += bf_lo(a.x) * bf_lo(b.x) + bf_hi(a.x) * bf_hi(b.x) + bf_lo(a.y) * bf_lo(b.y) + bf_hi(a.y) * bf_hi(b.y) + bf_lo(a.z) * bf_lo(b.z) + bf_hi(a.z) * bf_hi(b.z) + bf_lo(a.w) * bf_lo(b.w) + bf_hi(a.w) * bf_hi(b.w); }
                    r[j] = s; }
                acc[ai][bj][m][n] = r; } }
        E(acc, u, wr, wc, fr, fq);
    }
}
#endif

typedef const f32x4 (&AccRef)[2][2][4][2];
__device__ __forceinline__ u32x4 pack8(f32x4 v0, f32x4 v1) { u32x4 w; w.x = cvt_pk_bf16(v0[0], v0[1]); w.y = cvt_pk_bf16(v0[2], v0[3]); w.z = cvt_pk_bf16(v1[0], v1[1]); w.w = cvt_pk_bf16(v1[2], v1[3]); return w; }
#define EPI_FOR_AM for (int ai = 0; ai < 2; ++ai) _Pragma("unroll") for (int m = 0; m < 4; ++m)

__device__ __forceinline__ void rope8(f32x4& v0, f32x4& v1, const f32x2* cs  , int fq) {
    const int i0 = 8 * (fq & 1);
    const bool second = (fq & 2) != 0;
#pragma unroll
    for (int j = 0; j < 4; ++j) {
        const float o0 = __shfl_xor(v0[j], 32), o1 = __shfl_xor(v1[j], 32);
        const f32x2 c0 = cs[i0 + j], c1 = cs[i0 + 4 + j];
        v0[j] = second ? (v0[j] * c0.x + o0 * c0.y) : (v0[j] * c0.x - o0 * c0.y);
        v1[j] = second ? (v1[j] * c1.x + o1 * c1.y) : (v1[j] * c1.x - o1 * c1.y);
    }
}
__device__ __forceinline__ void rope8r(f32x4& v0, f32x4& v1, const f32x4* ct, int fq) {
    const bool second = (fq & 2) != 0;
#pragma unroll
    for (int j = 0; j < 4; ++j) {
        const float o0 = __shfl_xor(v0[j], 32), o1 = __shfl_xor(v1[j], 32);
        const float c0x = ct[j >> 1][2 * (j & 1)], c0y = ct[j >> 1][2 * (j & 1) + 1], c1x = ct[2 + (j >> 1)][2 * (j & 1)], c1y = ct[2 + (j >> 1)][2 * (j & 1) + 1];
        v0[j] = second ? (v0[j] * c0x + o0 * c0y) : (v0[j] * c0x - o0 * c0y);
        v1[j] = second ? (v1[j] * c1x + o1 * c1y) : (v1[j] * c1x - o1 * c1y);
    }
}

__device__ __forceinline__ size_t kimg(int h, int s, int cc, int NCH) { return ((((size_t)h * 256 + (s >> 6)) * NCH + cc) * 64 + (s & 63)) * 8; }
__device__ __forceinline__ size_t vimg(int h, int d, int s, int DV) { return ((((size_t)h * 256 + (s >> 6)) * 8 + ((s & 63) >> 3)) * DV + d) * 8; }
__device__ __forceinline__ size_t kimg8b(int h, int s, int c16) { return ((((size_t)h * 256 + (s >> 6)) * 8 + c16) * 64 + (s & 63)) * 16; }
__device__ __forceinline__ unsigned pack4_fp8(float a, float b, float c, float d);
__device__ __forceinline__ f32x2 lo2(const f32x4 v) { return __builtin_shufflevector(v, v, 0, 1); }
__device__ __forceinline__ f32x2 hi2(const f32x4 v) { return __builtin_shufflevector(v, v, 2, 3); }
__device__ __forceinline__ f32x4 cat2(const f32x2 a, const f32x2 b) { return __builtin_shufflevector(a, b, 0, 1, 2, 3); }
__device__ __forceinline__ f32x4 pk_fma4(const f32x4 a, const float b, const f32x4 c) { const f32x2 b2 = {b, b}; return cat2(lo2(a) * b2 + lo2(c), hi2(a) * b2 + hi2(c)); }
__device__ __forceinline__ f32x4 pk_mul4(const f32x4 a, const float b) { const f32x2 b2 = {b, b}; return cat2(lo2(a) * b2, hi2(a) * b2); }
struct EpiABIn {
    static constexpr bool PERM = true, FP8 = false;
    unsigned char* ws; float qscale;
    __device__ __forceinline__ void operator()(AccRef acc, const Unit& u, int wr, int wc, int fr, int fq) const {
        { const int l_ = lane_id_asm(); fr = l_ & 15; fq = l_ >> 4; }
        bf16_t* QA = (bf16_t*)(ws + WS_QA); bf16_t* KA = (bf16_t*)(ws + WS_KA); bf16_t* CQ = (bf16_t*)(ws + WS_CQ); bf16_t* CKV = (bf16_t*)(ws + WS_CKV); bf16_t* KB = (bf16_t*)(ws + WS_KB);
        float* SSQQ = (float*)(ws + WS_SSQQ); float* SSQKV = (float*)(ws + WS_SSQKV); const f32x2* ROPE = (const f32x2*)(ws + WS_TAB + TAB_ROPE);
        const int pn = u.pn, row0 = u.pm * 256 + wr * 64 + fr;
        if (pn < 2) {
            const int cb = (pn & 1) * 256 + wc * 32 + 8 * fq;
#pragma unroll
            EPI_FOR_AM { const int row = row0 + ai * 128 + m * 16;
#pragma unroll
                for (int bj = 0; bj < 2; ++bj) *(u32x4*)(QA + (size_t)row * 512 + cb + bj * 128) = pack8(acc[ai][bj][m][0] * qscale, acc[ai][bj][m][1] * qscale); }
        } else if (pn < 4) {
#pragma unroll
            EPI_FOR_AM { const int row = row0 + ai * 128 + m * 16;
#pragma unroll
                for (int bj = 0; bj < 2; ++bj) { const int col = (pn & 1) * 256 + bj * 128 + wc * 32 + 8 * fq; *(u32x4*)(KA + kimg(col >> 6, row, (col & 63) >> 3, 8)) = pack8(acc[ai][bj][m][0], acc[ai][bj][m][1]); } }
        } else if (pn < 7) {
            const bool isq = pn < 6; bf16_t* dst = isq ? CQ : CKV; const int ld = isq ? 512 : 256; const int cb = (isq ? (pn - 4) * 256 : 0) + wc * 32 + 8 * fq;
#pragma unroll
            EPI_FOR_AM { const int row = row0 + ai * 128 + m * 16; float s = 0.f;
#pragma unroll
                for (int bj = 0; bj < 2; ++bj) { const f32x4 a = acc[ai][bj][m][0], b = acc[ai][bj][m][1];
                    s += (a[0] * a[0] + a[1] * a[1]) + (a[2] * a[2] + a[3] * a[3]) + (b[0] * b[0] + b[1] * b[1]) + (b[2] * b[2] + b[3] * b[3]);
                    *(u32x4*)(dst + (size_t)row * ld + cb + bj * 128) = pack8(a, b); }
                s += __shfl_xor(s, 16); s += __shfl_xor(s, 32);
                if (fq == 0) { if (isq) SSQQ[(size_t)row * 8 + (pn - 4) * 4 + wc] = s; else SSQKV[(size_t)row * 4 + wc] = s; } }
        } else if (wc == 0) {
#pragma unroll
            EPI_FOR_AM rope8(const_cast<f32x4&>(acc[ai][0][m][0]), const_cast<f32x4&>(acc[ai][0][m][1]), ROPE + (size_t)(row0 + ai * 128 + m * 16) * 16, fq);
#pragma unroll
            EPI_FOR_AM { const int row = row0 + ai * 128 + m * 16; const f32x4 v0 = acc[ai][0][m][0], v1 = acc[ai][0][m][1];
                const u32x4 w = pack8(v0, v1);
#if ATT_B_FP8
                { u32x2 w8; w8.x = pack4_fp8(v0[0], v0[1], v0[2], v0[3]); w8.y = pack4_fp8(v1[0], v1[1], v1[2], v1[3]); const u32x2 z8 = {0u, 0u};
#pragma unroll
                  for (int h = 0; h < 8; ++h) { unsigned char* kp = (unsigned char*)KB + kimg8b(h, row, 4 + (fq >> 1)) + 8 * (fq & 1); *(u32x2*)kp = w8; *(u32x2*)(kp + 2 * 1024) = z8; } }
                (void)w; }
#else
#pragma unroll
                for (int h = 0; h < 8; ++h) *(u32x4*)(KB + kimg(h, row, 8 + fq, 12)) = w; }
#endif
        }
    }
};
template <int DV, int NP> struct EpiVt {
    static constexpr bool PERM = true, FP8 = false;
    bf16_t* Vt; const float* ssq; float inv_n;
    __device__ __forceinline__ void operator()(AccRef acc, const Unit& u, int wr, int wc, int fr, int fq) const {
        { const int l_ = lane_id_asm(); fr = l_ & 15; fq = l_ >> 4; }
        float sc[2][8];
#pragma unroll
        for (int bj = 0; bj < 2; ++bj)
#pragma unroll
            for (int j = 0; j < 8; ++j) { sc[bj][j] = 1.0f;
                if (NP > 0) { const int tok = u.pn * 256 + bj * 128 + wc * 32 + 8 * fq + j; float s = 0.f;
#pragma unroll
                    for (int p = 0; p < (NP > 0 ? NP : 1); ++p) s += ssq[(size_t)tok * NP + p];
                    sc[bj][j] = 1.0f / sqrtf(s * inv_n + RMS_EPS); } }
#pragma unroll
        EPI_FOR_AM { const int f = u.pm * 256 + ai * 128 + wr * 64 + m * 16 + fr, h = f / DV, d = f % DV;
#pragma unroll
            for (int bj = 0; bj < 2; ++bj) { const int tok = u.pn * 256 + bj * 128 + wc * 32 + 8 * fq; f32x4 a = acc[ai][bj][m][0], b = acc[ai][bj][m][1];
                if (NP > 0) { a[0] *= sc[bj][0]; a[1] *= sc[bj][1]; a[2] *= sc[bj][2]; a[3] *= sc[bj][3]; b[0] *= sc[bj][4]; b[1] *= sc[bj][5]; b[2] *= sc[bj][6]; b[3] *= sc[bj][7]; }
                *(u32x4*)(Vt + vimg(h, d, tok, DV)) = pack8(a, b); } }
    }
};
struct EpiQUp {
    static constexpr bool PERM = true, FP8 = false;
    unsigned char* ws; float qscale;
    __device__ __forceinline__ void operator()(AccRef acc, const Unit& u, int wr, int wc, int fr, int fq) const {
        { const int l_ = lane_id_asm(); fr = l_ & 15; fq = l_ >> 4; }
        bf16_t* QB = (bf16_t*)(ws + WS_QB); const float* SSQQ = (const float*)(ws + WS_SSQQ); const f32x2* ROPE = (const f32x2*)(ws + WS_TAB + TAB_ROPE);
        float rqv[2][4];
#pragma unroll
        EPI_FOR_AM { const int row = u.pm * 256 + ai * 128 + wr * 64 + m * 16 + fr;
            const f32x4 p0 = *(const f32x4*)(SSQQ + (size_t)row * 8), p1 = *(const f32x4*)(SSQQ + (size_t)row * 8 + 4);
            const float ss = ((p0[0] + p0[1]) + (p0[2] + p0[3])) + ((p1[0] + p1[1]) + (p1[2] + p1[3]));
            rqv[ai][m] = qscale / sqrtf(ss * (1.0f / 512.0f) + RMS_EPS); }
#pragma unroll
        EPI_FOR_AM { const int row = u.pm * 256 + ai * 128 + wr * 64 + m * 16 + fr;
#pragma unroll
            for (int bj = 0; bj < 2; ++bj) { const int g32 = u.pn * 8 + bj * 4 + wc; if (g32 % 3 == 2) rope8(const_cast<f32x4&>(acc[ai][bj][m][0]), const_cast<f32x4&>(acc[ai][bj][m][1]), ROPE + (size_t)row * 16, fq); } }
#pragma unroll
        EPI_FOR_AM { const int row = u.pm * 256 + ai * 128 + wr * 64 + m * 16 + fr; const float rq = rqv[ai][m];
#pragma unroll
            for (int bj = 0; bj < 2; ++bj) { const int g32 = u.pn * 8 + bj * 4 + wc; const f32x4 a = acc[ai][bj][m][0] * rq, b = acc[ai][bj][m][1] * rq;
                *(u32x4*)(QB + (size_t)row * 768 + g32 * 32 + 8 * fq) = pack8(a, b); } }
    }
};
struct EpiKUp {
    static constexpr bool PERM = true, FP8 = false;
    unsigned char* ws;
    __device__ __forceinline__ void operator()(AccRef acc, const Unit& u, int wr, int wc, int fr, int fq) const {
        { const int l_ = lane_id_asm(); fr = l_ & 15; fq = l_ >> 4; }
        bf16_t* KB = (bf16_t*)(ws + WS_KB); const float* SSQKV = (const float*)(ws + WS_SSQKV);
        float rkv[2][4];
#pragma unroll
        EPI_FOR_AM { const int row = u.pm * 256 + ai * 128 + wr * 64 + m * 16 + fr; const f32x4 p0 = *(const f32x4*)(SSQKV + (size_t)row * 4);
            rkv[ai][m] = 1.0f / sqrtf(((p0[0] + p0[1]) + (p0[2] + p0[3])) * (1.0f / 256.0f) + RMS_EPS); }
#pragma unroll
        EPI_FOR_AM { const int row = u.pm * 256 + ai * 128 + wr * 64 + m * 16 + fr; const float rk = rkv[ai][m];
#pragma unroll
            for (int bj = 0; bj < 2; ++bj) { const int col = u.pn * 256 + bj * 128 + wc * 32 + 8 * fq, h = col >> 6, d = col & 63;
#if ATT_B_FP8
                { const f32x4 a = acc[ai][bj][m][0] * rk, b = acc[ai][bj][m][1] * rk; u32x2 w8; w8.x = pack4_fp8(a[0], a[1], a[2], a[3]); w8.y = pack4_fp8(b[0], b[1], b[2], b[3]);
                  *(u32x2*)((unsigned char*)KB + kimg8b(h, row, d >> 4) + (d & 15)) = w8; } } }
#else
                *(u32x4*)(KB + kimg(h, row, d >> 3, 12)) = pack8(acc[ai][bj][m][0] * rk, acc[ai][bj][m][1] * rk); } }
#endif
    }
};
struct EpiBf16Split {
    static constexpr bool PERM = true, FP8 = false;
    bf16_t* O; int ldc; int split; size_t stride; float scale0;
    __device__ __forceinline__ void operator()(AccRef acc, const Unit& u, int wr, int wc, int fr, int fq) const {
        { const int l_ = lane_id_asm(); fr = l_ & 15; fq = l_ >> 4; }
        int colt = u.pn * 256; bf16_t* base = O; float sc = 1.0f;
        { const int t = colt / split; base += (size_t)t * stride; colt -= t * split; if (t == 0) sc = scale0; }
#pragma unroll
        EPI_FOR_AM { const int row = u.pm * 256 + ai * 128 + wr * 64 + m * 16 + fr;
#pragma unroll
            for (int bj = 0; bj < 2; ++bj) *(u32x4*)(base + (size_t)row * ldc + colt + bj * 128 + wc * 32 + 8 * fq) = pack8(acc[ai][bj][m][0] * sc, acc[ai][bj][m][1] * sc); }
    }
};
__device__ __forceinline__ unsigned pack4_fp8(float a, float b, float c, float d);
struct EpiCIn {
    static constexpr bool PERM = true, FP8 = false;
    unsigned char* ws; float qscale;
    __device__ __forceinline__ void operator()(AccRef acc, const Unit& u, int wr, int wc, int fr, int fq) const {
        { const int l_ = lane_id_asm(); fr = l_ & 15; fq = l_ >> 4; }
        bf16_t* QC = (bf16_t*)(ws + WS_QC); bf16_t* KC = (bf16_t*)(ws + WS_KC);
#pragma unroll
        EPI_FOR_AM { const int row = u.pm * 256 + ai * 128 + wr * 64 + m * 16 + fr;
#pragma unroll
            for (int bj = 0; bj < 2; ++bj) { const int col = (u.pn & 3) * 256 + bj * 128 + wc * 32 + 8 * fq;
                if (u.pn < 4) *(u32x4*)(QC + (size_t)row * D + col) = pack8(acc[ai][bj][m][0] * qscale, acc[ai][bj][m][1] * qscale);
                else {
#if ATT_C_FP8
                    const int h = col >> 7, dd = col & 127, sb = dd >> 6, d = dd & 63;
                    unsigned char* kp = (unsigned char*)KC + (((((size_t)h * 256 + (row >> 6)) * 2 + sb) * 4 + (d >> 4)) * 64 + (row & 63)) * 16 + (d & 15);
                    const f32x4 a = acc[ai][bj][m][0], b = acc[ai][bj][m][1]; u32x2 w; w.x = pack4_fp8(a[0], a[1], a[2], a[3]); w.y = pack4_fp8(b[0], b[1], b[2], b[3]); *(u32x2*)kp = w;
#else
                    *(u32x4*)(KC + kimg(col >> 7, row, (col & 127) >> 3, 16)) = pack8(acc[ai][bj][m][0], acc[ai][bj][m][1]);
#endif
                } } }
    }
};
__device__ __forceinline__ void unpack8(const u32x4 w, f32x4& a, f32x4& b) { a[0] = bf_lo(w.x); a[1] = bf_hi(w.x); a[2] = bf_lo(w.y); a[3] = bf_hi(w.y); b[0] = bf_lo(w.z); b[1] = bf_hi(w.z); b[2] = bf_lo(w.w); b[3] = bf_hi(w.w); }
template <bool XF32> struct EpiResid {
    static constexpr bool PERM = true, FP8 = false;
    const void* X; bf16_t* Z;
    __device__ __forceinline__ void operator()(AccRef acc, const Unit& u, int wr, int wc, int fr, int fq) const {
        { const int l_ = lane_id_asm(); fr = l_ & 15; fq = l_ >> 4; }
        if constexpr (XF32) {
#pragma unroll
            for (int ai = 0; ai < 2; ++ai) { f32x4 xf[4][2][2];
#pragma unroll
                for (int m = 0; m < 4; ++m)
#pragma unroll
                    for (int bj = 0; bj < 2; ++bj) { const size_t o = (size_t)(u.pm * 256 + ai * 128 + wr * 64 + m * 16 + fr) * D + u.pn * 256 + wc * 32 + 8 * fq + bj * 128;
                        xf[m][bj][0] = *(const f32x4*)((const float*)X + o); xf[m][bj][1] = *(const f32x4*)((const float*)X + o + 4); }
#pragma unroll
                for (int m = 0; m < 4; ++m)
#pragma unroll
                    for (int bj = 0; bj < 2; ++bj) { const size_t o = (size_t)(u.pm * 256 + ai * 128 + wr * 64 + m * 16 + fr) * D + u.pn * 256 + wc * 32 + 8 * fq + bj * 128;
                        *(u32x4*)(Z + o) = pack8(pk_fma4(xf[m][bj][0], DN_ALPHA, acc[ai][bj][m][0]), pk_fma4(xf[m][bj][1], DN_ALPHA, acc[ai][bj][m][1])); } }
        } else {
            u32x4 xr[2][4][2];
#pragma unroll
            EPI_FOR_AM { const size_t off = (size_t)(u.pm * 256 + ai * 128 + wr * 64 + m * 16 + fr) * D + u.pn * 256 + wc * 32 + 8 * fq;
#pragma unroll
                for (int bj = 0; bj < 2; ++bj) xr[ai][m][bj] = *(const u32x4*)((const bf16_t*)X + off + bj * 128); }
#pragma unroll
            EPI_FOR_AM { const size_t off = (size_t)(u.pm * 256 + ai * 128 + wr * 64 + m * 16 + fr) * D + u.pn * 256 + wc * 32 + 8 * fq;
#pragma unroll
                for (int bj = 0; bj < 2; ++bj) { const size_t o = off + bj * 128; f32x4 xa, xb; unpack8(xr[ai][m][bj], xa, xb);
                    *(u32x4*)(Z + o) = pack8(pk_fma4(xa, DN_ALPHA, acc[ai][bj][m][0]), pk_fma4(xb, DN_ALPHA, acc[ai][bj][m][1])); } }
        }
    }
};
struct EpiPle {
    static constexpr bool PERM = true, FP8 = (MOE_FP8 != 0);
    const bf16_t* X1; const bf16_t* PP; bf16_t* Z2;
    __device__ __forceinline__ void operator()(AccRef acc, const Unit& u, int wr, int wc, int fr, int fq) const {
        { const int l_ = lane_id_asm(); fr = l_ & 15; fq = l_ >> 4; }
#pragma unroll
        for (int ai = 0; ai < 2; ++ai) { u32x4 xr[4][2], pr[4][2];
#pragma unroll
            for (int m = 0; m < 4; ++m)
#pragma unroll
                for (int bj = 0; bj < 2; ++bj) { const size_t o = (size_t)(u.pm * 256 + ai * 128 + wr * 64 + m * 16 + fr) * D + u.pn * 256 + wc * 32 + 8 * fq + bj * 128;
                    xr[m][bj] = *(const u32x4*)(X1 + o); pr[m][bj] = *(const u32x4*)(PP + o); }
#pragma unroll
            for (int m = 0; m < 4; ++m)
#pragma unroll
                for (int bj = 0; bj < 2; ++bj) { const size_t o = (size_t)(u.pm * 256 + ai * 128 + wr * 64 + m * 16 + fr) * D + u.pn * 256 + wc * 32 + 8 * fq + bj * 128;
                    f32x4 xa, xb, pa, pb; unpack8(xr[m][bj], xa, xb); unpack8(pr[m][bj], pa, pb);
                    constexpr float asc = FP8 ? 1.0f / 32.0f : 1.0f; f32x4 ra, rb;
                    { const f32x2 c2 = {-asc * LOG2E, -asc * LOG2E}, one2 = {1.0f, 1.0f}, al2 = {DN_ALPHA, DN_ALPHA};
#define PLE_HALF(accv, xv, pv, outv, H) do { const f32x2 t_ = (H ? hi2(accv) : lo2(accv)) * c2; const f32x2 d_ = (f32x2){fast_exp2(t_[0]), fast_exp2(t_[1])} + one2; \
                        const f32x2 r_ = {fast_rcp(d_[0]), fast_rcp(d_[1])}; const f32x2 q_ = (H ? hi2(xv) : lo2(xv)) * al2 + r_ * (H ? hi2(pv) : lo2(pv)); outv[2 * H] = q_[0]; outv[2 * H + 1] = q_[1]; } while (0)
                      PLE_HALF(acc[ai][bj][m][0], xa, pa, ra, 0); PLE_HALF(acc[ai][bj][m][0], xa, pa, ra, 1); PLE_HALF(acc[ai][bj][m][1], xb, pb, rb, 0); PLE_HALF(acc[ai][bj][m][1], xb, pb, rb, 1);
#undef PLE_HALF
                    }
                    *(u32x4*)(Z2 + o) = pack8(ra, rb); } }
    }
};
constexpr float W1_SCALE = 32.0f, W2_SCALE = 64.0f, H_SCALE = 4.0f;
__device__ __forceinline__ unsigned pack4_fp8(float a, float b, float c, float d) { int w = __builtin_amdgcn_cvt_pk_fp8_f32(a, b, 0, false); w = __builtin_amdgcn_cvt_pk_fp8_f32(c, d, w, true); return (unsigned)w; }
struct EpiMoeAct {
    static constexpr bool PERM = true, FP8 = (MOE_FP8 != 0);
    unsigned char* Hs; const float* bin;
    struct Pre { f32x4 g0, g1, l0, l1; };
    __device__ __forceinline__ Pre pre(const Unit& u, int wr, int wc) const { const int fq = lane_id_asm() >> 4; const float* bg = bin + (size_t)u.e * 2048 + u.pn * 128 + wc * 32 + 8 * fq;
        Pre p; p.g0 = *(const f32x4*)bg; p.g1 = *(const f32x4*)(bg + 4); p.l0 = *(const f32x4*)(bg + 1024); p.l1 = *(const f32x4*)(bg + 1028); return p; }
    __device__ __forceinline__ void operator()(AccRef acc, const Unit& u, int wr, int wc, int fr, int fq, const Pre& pr) const {
        { const int l_ = lane_id_asm(); fr = l_ & 15; fq = l_ >> 4; }
        const int cl = u.pn * 128 + wc * 32 + 8 * fq;
        const f32x4 g0 = pr.g0, g1 = pr.g1, l0 = pr.l0, l1 = pr.l1;
        constexpr float asc = FP8 ? 1.0f / W1_SCALE : 1.0f, osc = FP8 ? H_SCALE : 1.0f;
#pragma unroll
        EPI_FOR_AM { const int row = u.pm * 256 + ai * 128 + wr * 64 + m * 16 + fr; f32x4 o[2];
#pragma unroll
            for (int n = 0; n < 2; ++n) { const f32x4 ag = acc[ai][0][m][n], al = acc[ai][1][m][n], bg = n ? g1 : g0, bl = n ? l1 : l0;
#pragma unroll
                for (int h = 0; h < 2; ++h) {
                    const f32x2 a2 = {asc, asc}, o2 = {osc, osc}, c2 = {-1.702f * LOG2E, -1.702f * LOG2E}, one2 = {1.0f, 1.0f};
                    const f32x2 hg = (f32x2){ag[2 * h], ag[2 * h + 1]} * a2 + (f32x2){bg[2 * h], bg[2 * h + 1]}, hl = (f32x2){al[2 * h], al[2 * h + 1]} * a2 + (f32x2){bl[2 * h], bl[2 * h + 1]};
                    const f32x2 glu = {fminf(hg[0], 7.0f), fminf(hg[1], 7.0f)}, lin = {fminf(fmaxf(hl[0], -7.0f), 7.0f), fminf(fmaxf(hl[1], -7.0f), 7.0f)};
                    const f32x2 t = glu * c2; const f32x2 d = (f32x2){fast_exp2(t[0]), fast_exp2(t[1])} + one2; const f32x2 r = {fast_rcp(d[0]), fast_rcp(d[1])};
                    const f32x2 res = (glu * r) * (lin * o2 + o2);
                    o[n][2 * h] = res[0]; o[n][2 * h + 1] = res[1]; } }
            if constexpr (FP8) { u32x2 w; w.x = pack4_fp8(o[0][0], o[0][1], o[0][2], o[0][3]); w.y = pack4_fp8(o[1][0], o[1][1], o[1][2], o[1][3]); *(u32x2*)(Hs + (size_t)row * 1024 + cl) = w; }
            else *(u32x4*)((bf16_t*)Hs + (size_t)row * 1024 + cl) = pack8(o[0], o[1]); }
    }
};
struct EpiMoeDown {
    static constexpr bool PERM = true, FP8 = (MOE_FP8 != 0);
    bf16_t* Ys; const float* bout; const float* GATE;
    struct Pre { f32x4 bv[2][2]; float gtv[2][4]; };
    __device__ __forceinline__ Pre pre(const Unit& u, int wr, int wc) const { const int l_ = lane_id_asm(), fr = l_ & 15, fq = l_ >> 4; Pre p;
#pragma unroll
        for (int bj = 0; bj < 2; ++bj)
#pragma unroll
            for (int n = 0; n < 2; ++n) p.bv[bj][n] = *(const f32x4*)(bout + (size_t)u.e * 1024 + u.pn * 256 + bj * 128 + wc * 32 + 8 * fq + 4 * n);
#pragma unroll
        EPI_FOR_AM p.gtv[ai][m] = GATE[(size_t)u.e * S + u.aux * 256 + ai * 128 + wr * 64 + m * 16 + fr];
        return p; }
    __device__ __forceinline__ void operator()(AccRef acc, const Unit& u, int wr, int wc, int fr, int fq, const Pre& pr) const {
        { const int l_ = lane_id_asm(); fr = l_ & 15; fq = l_ >> 4; }
        constexpr float asc = FP8 ? 1.0f / (W2_SCALE * H_SCALE) : 1.0f;
        f32x4 bv[2][2];
#pragma unroll
        for (int bj = 0; bj < 2; ++bj)
#pragma unroll
            for (int n = 0; n < 2; ++n) bv[bj][n] = pr.bv[bj][n];
#pragma unroll
        EPI_FOR_AM { const int rl = ai * 128 + wr * 64 + m * 16 + fr; const float gt = pr.gtv[ai][m];
#pragma unroll
            for (int bj = 0; bj < 2; ++bj) *(u32x4*)(Ys + (size_t)(u.pm * 256 + rl) * 1024 + u.pn * 256 + bj * 128 + wc * 32 + 8 * fq) = pack8(pk_mul4(pk_fma4(acc[ai][bj][m][0], asc, bv[bj][0]), gt), pk_mul4(pk_fma4(acc[ai][bj][m][1], asc, bv[bj][1]), gt)); }
    }
};
template <bool GATHER_> struct MoeOrder {
    static constexpr bool GATHER = GATHER_;
    const LAS int* toff; const LAS int* cnt; const LAS int* t2e; const int* TOK; int NT, G, c;
    __device__ __forceinline__ bool next(int i, Unit& u) const {
        const int L = i * G + c; const int total = toff[32] * NT; if (L >= total) return false;
        const int tile = L / NT; u.pn = L - tile * NT; const int e = t2e[tile];
        u.pm = tile; u.e = e; u.aux = tile - toff[e]; return true;
    }
    __device__ __forceinline__ const int* tokbase(const Unit& u) const { return TOK + (size_t)u.e * S; }
    __device__ __forceinline__ unsigned tokidx(const Unit& u, int r) const { const int pos = u.aux * 256 + r; return (unsigned)(pos < cnt[u.e] ? pos : 0); }
    __device__ __forceinline__ int arow(const Unit& u, int r) const {
        if (!GATHER) return u.pm * 256 + r;
        const int pos = u.aux * 256 + r; const int* base = TOK + (size_t)u.e * S; return base[pos < cnt[u.e] ? pos : 0];
    }
};
}

namespace fa {
typedef float f32x16 __attribute__((ext_vector_type(16)));
template <int TYPE> struct Cfg;
template <> struct Cfg<0> { static constexpr int DQK = 64, DV = 64,  NSUB = 1, UROWS = 256, NKP = 1, NVP = 1, DQ8 = 64; static constexpr bool K8 = false; };
template <> struct Cfg<1> { static constexpr int DQK = 96, DV = 64,  NSUB = 1, UROWS = 256, NKP = (ATT_B_FP8 ? 1 : 2), NVP = 1, DQ8 = 128; static constexpr bool K8 = (ATT_B_FP8 != 0); };
template <> struct Cfg<2> { static constexpr int DQK = 64, DV = 128, NSUB = 2, UROWS = 128, NKP = (ATT_C_FP8 ? 1 : 2), NVP = 2, DQ8 = 64; static constexpr bool K8 = (ATT_C_FP8 != 0); };
constexpr float THR = 8.0f;
struct Desc { const bf16_t* Q; const bf16_t* K; const bf16_t* Vt; bf16_t* O; int ldq, ldk; int q0; const float* btab; float far; float lam, omli; const float* subln; };

__device__ __forceinline__ float pair_max(float v) { auto rr = __builtin_amdgcn_permlane32_swap(__float_as_uint(v), __float_as_uint(v), false, false); return fmaxf(__uint_as_float(rr[0]), __uint_as_float(rr[1])); }
__device__ __forceinline__ float pair_sum(float v) { auto rr = __builtin_amdgcn_permlane32_swap(__float_as_uint(v), __float_as_uint(v), false, false); return __uint_as_float(rr[0]) + __uint_as_float(rr[1]); }
__device__ __forceinline__ float max3f(float a, float b, float c) { return fmaxf(fmaxf(a, b), c); }
typedef __bf16 bf16x2_t __attribute__((ext_vector_type(2)));
__device__ __forceinline__ unsigned cvtpk_n(float lo, float hi) { f32x2 v = {lo, hi}; bf16x2_t b = __builtin_convertvector(v, bf16x2_t); return __builtin_bit_cast(unsigned, b); }
__device__ __forceinline__ bf16x8 pack_p(const f32x16& p, int b) { u32x4 w; w.x = cvtpk_n(p[b], p[b + 1]); w.y = cvtpk_n(p[b + 2], p[b + 3]); w.z = cvtpk_n(p[b + 4], p[b + 5]); w.w = cvtpk_n(p[b + 6], p[b + 7]); return __builtin_bit_cast(bf16x8, w); }
#define FA_WAITBAR(N) asm volatile("s_waitcnt vmcnt(" #N ") lgkmcnt(0)\n\ts_barrier" ::: "memory")

template <int TYPE, bool OPT>
__device__ __forceinline__ bool attn_unit(LAS unsigned char* lds, const int wave, const Desc ds) {
    typedef Cfg<TYPE> C;
    constexpr int DQK = C::DQK, DV = C::DV, KCH = C::K8 ? C::DQ8 / 16 : DQK / 8  , NQ8 = C::DQ8 / 64, KBYTES = C::NSUB * KCH * 1024, VBYTES = DV * 128, KRING = 0, VRING = 3 * KBYTES, NPW = C::NKP + C::NVP;
    constexpr int ND0 = DQK / 16, NDB = DV / 32, XCH = 0;
    const int lane = lane_id_asm(), q = lane & 31, hi = lane >> 5;
    const int rb = (TYPE == 2) ? (wave & 3) : wave, sub = (TYPE == 2) ? (wave >> 2) : 0;
    const int c0 = ds.q0 >> 6, T1 = c0 + C::UROWS / 64 - 1, T0 = (TYPE == 0) ? (c0 > 8 ? c0 - 8 : 0) : 0;
    const int cw = (ds.q0 + 32 * rb) >> 6, a_hi = cw, a_lo = (TYPE == 0) ? (cw > 8 ? cw - 8 : 0) : 0, near_lo = (TYPE == 1) ? (1 << 30) : cw - 2;
    const int qpos = ds.q0 + 32 * rb + q;
    const unsigned ldsb = (unsigned)(size_t)lds;
    int kdst[C::NKP], vdst[C::NVP]; const unsigned dvoff = (unsigned)lane * 16u;
#pragma unroll
    for (int i = 0; i < C::NKP; ++i) { int idx = wave + 8 * i; if (idx >= C::NSUB * KCH) idx -= C::NSUB * KCH; kdst[i] = idx * 1024; }
#pragma unroll
    for (int i = 0; i < C::NVP; ++i) vdst[i] = (wave + 8 * i) * 1024;
#define FA_ISSUE_K(u, slot) do { _Pragma("unroll") for (int _i = 0; _i < C::NKP; ++_i) \
        pg8::glds_sv(pg8::uniform_ptr((const char*)ds.K + (size_t)(u) * KBYTES + kdst[_i]), dvoff, (unsigned)__builtin_amdgcn_readfirstlane((int)(ldsb + KRING + (slot) * KBYTES + kdst[_i]))); } while (0)
#define FA_ISSUE_V(u, slot) do { _Pragma("unroll") for (int _i = 0; _i < C::NVP; ++_i) \
        pg8::glds_sv(pg8::uniform_ptr((const char*)ds.Vt + (size_t)(u) * VBYTES + vdst[_i]), dvoff, (unsigned)__builtin_amdgcn_readfirstlane((int)(ldsb + VRING + (slot) * VBYTES + vdst[_i]))); } while (0)
    const int pi = (q & ~12) | ((q & 4) << 1) | ((q & 8) >> 1);
    const int kfo = KRING + (C::K8 ? hi * 2048 : hi * 1024) + pi * 16 + sub * KCH * 1024, vfo = VRING + hi * DV * 16 + q * 16;
    FA_WAITBAR(0);
    if (TYPE != 1) { const int tid = wave * 64 + lane; if (tid < 256) *(LAS float*)(lds + LM_FREE + tid * 4) = ds.btab[tid] - ds.far; }
    FA_ISSUE_K(T0, 0); if (T0 + 1 <= T1) FA_ISSUE_K(T0 + 1, 1);
    bf16x8 qf[ND0]; pg8::i32x8 qf8[NQ8]; (void)qf8;
    if constexpr (C::K8) {
#pragma unroll
        for (int o8 = 0; o8 < NQ8; ++o8) { const int dbase = 64 * o8 + 32 * hi; const bf16_t* qp = ds.Q + (size_t)qpos * ds.ldq + sub * 64 + dbase;
#pragma unroll
            for (int j = 0; j < 4; ++j) { u32x4 w = {0u, 0u, 0u, 0u}; if (dbase + 8 * j < DQK) w = *(const u32x4*)(qp + 8 * j);
                qf8[o8][2 * j]     = (int)pg8::pack4_fp8(bf_lo(w.x) * 8.f, bf_hi(w.x) * 8.f, bf_lo(w.y) * 8.f, bf_hi(w.y) * 8.f);
                qf8[o8][2 * j + 1] = (int)pg8::pack4_fp8(bf_lo(w.z) * 8.f, bf_hi(w.z) * 8.f, bf_lo(w.w) * 8.f, bf_hi(w.w) * 8.f); } }
#pragma unroll
        for (int d0 = 0; d0 < ND0; ++d0) qf[d0] = bf16x8{};
    } else { const bf16_t* qp = ds.Q + (size_t)qpos * ds.ldq + sub * 64 + 8 * hi;
#pragma unroll
      for (int d0 = 0; d0 < ND0; ++d0) qf[d0] = *(const bf16x8*)(qp + 16 * d0); }
    f32x16 o[NDB];
#pragma unroll
    for (int db = 0; db < NDB; ++db) o[db] = f32x16{};
    f32x16 negm = f32x16{}; float m = 0.f, l = 0.f, fsc = 1.f; bool resc = false;
    f32x16 sA0 = f32x16{}, sA1 = f32x16{}, sB0 = f32x16{}, sB1 = f32x16{};
    bf16x8 pa[4], pb[4];
#pragma unroll
    for (int i = 0; i < 4; ++i) { pa[i] = bf16x8{}; pb[i] = bf16x8{}; }
    int s0 = 2;
#define FA_QK8_1(kb_, ka_, o8_, CIN) __builtin_amdgcn_mfma_scale_f32_32x32x64_f8f6f4(pg8::ld_pair(lds + (ka_) + (o8_) * 4096 + (kb_) * 512), qf8[o8_], CIN, 0, 0, 0, 0x7F7F7F7F, 0, 0x7C7C7C7C)
#define FA_QK8(kb_, ka_, CIN) (NQ8 == 1 ? FA_QK8_1(kb_, ka_, 0, CIN) : FA_QK8_1(kb_, ka_, NQ8 - 1, FA_QK8_1(kb_, ka_, 0, CIN)))
#define FA_QK(SN0, SN1) do { const int ka_ = kfo + ((s0 + 1) % 3) * KBYTES; \
        if constexpr (C::K8) { SN0 = FA_QK8(0, ka_, negm); SN1 = FA_QK8(1, ka_, negm); } else \
        _Pragma("unroll") for (int d0 = 0; d0 < ND0; ++d0) { const bf16x8 k0_ = *(const LAS bf16x8*)(lds + ka_ + d0 * 2048), k1_ = *(const LAS bf16x8*)(lds + ka_ + d0 * 2048 + 512); \
            SN0 = __builtin_amdgcn_mfma_f32_32x32x16_bf16(k0_, qf[d0], d0 == 0 ? negm : SN0, 0, 0, 0); SN1 = __builtin_amdgcn_mfma_f32_32x32x16_bf16(k1_, qf[d0], d0 == 0 ? negm : SN1, 0, 0, 0); } } while (0)
#define FA_ROWMAX(SC0, SC1, rm) do { float a_ = max3f(SC0[0], SC0[1], SC1[0]), b_ = max3f(SC0[2], SC0[3], SC1[1]); a_ = max3f(a_, SC1[2], SC1[3]); \
        _Pragma("unroll") for (int r = 4; r < 16; r += 4) { a_ = max3f(a_, SC0[r], SC0[r + 1]); b_ = max3f(b_, SC0[r + 2], SC0[r + 3]); a_ = max3f(a_, SC1[r], SC1[r + 1]); b_ = max3f(b_, SC1[r + 2], SC1[r + 3]); } \
        rm = pair_max(fmaxf(a_, b_)); } while (0)
#define FA_RESCALE_A(SC0, SC1, SN0, SN1, dl, HAVE_N) do { m += dl; \
        _Pragma("unroll") for (int r = 0; r < 16; ++r) { SC0[r] -= dl; SC1[r] -= dl; } \
        if (HAVE_N) { _Pragma("unroll") for (int r = 0; r < 16; ++r) { SN0[r] -= dl; SN1[r] -= dl; } } \
        _Pragma("unroll") for (int r = 0; r < 16; ++r) negm[r] = -m; \
        fsc = fast_exp2(-dl); l *= fsc; resc = true; } while (0)
#define FA_EXP(SC0, SC1, PC) do { \
        _Pragma("unroll") for (int r = 0; r < 16; ++r) { SC0[r] = fast_exp2(SC0[r]); SC1[r] = fast_exp2(SC1[r]); } \
        float s_ = 0.f, s2_ = 0.f, s3_ = 0.f, s4_ = 0.f; \
        _Pragma("unroll") for (int r = 0; r < 16; r += 2) { s_ += SC0[r]; s2_ += SC1[r]; s3_ += SC0[r + 1]; s4_ += SC1[r + 1]; } \
        l += (s_ + s2_) + (s3_ + s4_); \
        PC[0] = pack_p(SC0, 0); PC[1] = pack_p(SC0, 8); PC[2] = pack_p(SC1, 0); PC[3] = pack_p(SC1, 8); } while (0)
#define FA_PV(PP) do { const int va_ = vfo + ((s0 + 2) % 3) * VBYTES; \
        _Pragma("unroll") for (int ks = 0; ks < 4; ++ks) _Pragma("unroll") for (int db = 0; db < NDB; ++db) { const bf16x8 v_ = *(const LAS bf16x8*)(lds + va_ + ks * DV * 32 + db * 512); \
            o[db] = __builtin_amdgcn_mfma_f32_32x32x16_bf16(v_, PP[ks], o[db], 0, 0, 0); } } while (0)
#define FA_RESCALE_B() do { if (resc) { _Pragma("unroll") for (int db = 0; db < NDB; ++db) _Pragma("unroll") for (int r = 0; r < 16; ++r) o[db][r] *= fsc; resc = false; } } while (0)
#define FA_BIAS(SC0, SC1, t) do { const int bb_ = LM_FREE + (64 * (t) + 8 * hi - qpos + 192) * 4; \
        _Pragma("unroll") for (int r = 0; r < 16; ++r) { SC0[r] += *(const LAS float*)(lds + bb_ + (16 * (r >> 3) + (r & 7)) * 4); SC1[r] += *(const LAS float*)(lds + bb_ + (32 + 16 * (r >> 3) + (r & 7)) * 4); } } while (0)
#define FA_SB() __builtin_amdgcn_sched_barrier(0)
#define FA_X(SC0, SC1, e) ((e) < 16 ? SC0[(e) & 15] : SC1[(e) & 15])
#ifndef FA_FD
#define FA_FD 4
#endif
#define FA_QK_MAX(SC0, SC1, SN0, SN1, rm) do { const int ka_ = kfo + ((s0 + 1) % 3) * KBYTES; constexpr int NQ_ = 2 * ND0, VPC_ = (32 + NQ_ - 1) / NQ_, FD_ = FA_FD; \
        if constexpr (C::K8) { const f32x16 z8_ = f32x16{}; SN0 = FA_QK8(0, ka_, z8_); SN1 = FA_QK8(1, ka_, z8_); \
            if (__builtin_expect(__any(m != 0.f), 0)) { _Pragma("unroll") for (int r = 0; r < 16; ++r) { SN0[r] -= m; SN1[r] -= m; } } \
            FA_ROWMAX(SC0, SC1, rm); } else { \
        bf16x8 kf_[FD_]; _Pragma("unroll") for (int j_ = 0; j_ < FD_ - 1; ++j_) kf_[j_] = *(const LAS bf16x8*)(lds + ka_ + (j_ >> 1) * 2048 + (j_ & 1) * 512); \
        float a_ = -3.0e38f, b_ = -3.0e38f; const f32x16 z_ = f32x16{}; \
        _Pragma("unroll") for (int i_ = 0; i_ < NQ_; ++i_) { const int d0_ = i_ >> 1, kb_ = i_ & 1; \
            if (i_ + FD_ - 1 < NQ_) kf_[(i_ + FD_ - 1) % FD_] = *(const LAS bf16x8*)(lds + ka_ + ((i_ + FD_ - 1) >> 1) * 2048 + ((i_ + FD_ - 1) & 1) * 512); \
            if (kb_ == 0) SN0 = __builtin_amdgcn_mfma_f32_32x32x16_bf16(kf_[i_ % FD_], qf[d0_], d0_ == 0 ? z_ : SN0, 0, 0, 0); \
            else          SN1 = __builtin_amdgcn_mfma_f32_32x32x16_bf16(kf_[i_ % FD_], qf[d0_], d0_ == 0 ? z_ : SN1, 0, 0, 0); \
            _Pragma("unroll") for (int e_ = i_ * VPC_; e_ < (i_ + 1) * VPC_ && e_ < 32; e_ += 2) { \
                if (e_ + 1 < 32) { if ((e_ >> 1) & 1) b_ = max3f(b_, FA_X(SC0, SC1, e_), FA_X(SC0, SC1, e_ + 1)); else a_ = max3f(a_, FA_X(SC0, SC1, e_), FA_X(SC0, SC1, e_ + 1)); } \
                else a_ = fmaxf(a_, FA_X(SC0, SC1, e_)); } \
            FA_SB(); } \
        if (__builtin_expect(__any(m != 0.f), 0)) { _Pragma("unroll") for (int r = 0; r < 16; ++r) { SN0[r] -= m; SN1[r] -= m; } } \
        rm = pair_max(fmaxf(a_, b_)); } } while (0)
#define FA_QK_NOMAX(SN0, SN1) do { const int ka_ = kfo + ((s0 + 1) % 3) * KBYTES; constexpr int NQ_ = 2 * ND0, FD_ = FA_FD; \
        if constexpr (C::K8) { const f32x16 z8_ = f32x16{}; SN0 = FA_QK8(0, ka_, z8_); FA_SB(); SN1 = FA_QK8(1, ka_, z8_); FA_SB(); } else { \
        bf16x8 kf_[FD_]; _Pragma("unroll") for (int j_ = 0; j_ < FD_ - 1; ++j_) kf_[j_] = *(const LAS bf16x8*)(lds + ka_ + (j_ >> 1) * 2048 + (j_ & 1) * 512); \
        const f32x16 z_ = f32x16{}; \
        _Pragma("unroll") for (int i_ = 0; i_ < NQ_; ++i_) { const int d0_ = i_ >> 1, kb_ = i_ & 1; \
            if (i_ + FD_ - 1 < NQ_) kf_[(i_ + FD_ - 1) % FD_] = *(const LAS bf16x8*)(lds + ka_ + ((i_ + FD_ - 1) >> 1) * 2048 + ((i_ + FD_ - 1) & 1) * 512); \
            if (kb_ == 0) SN0 = __builtin_amdgcn_mfma_f32_32x32x16_bf16(kf_[i_ % FD_], qf[d0_], d0_ == 0 ? z_ : SN0, 0, 0, 0); \
            else          SN1 = __builtin_amdgcn_mfma_f32_32x32x16_bf16(kf_[i_ % FD_], qf[d0_], d0_ == 0 ? z_ : SN1, 0, 0, 0); \
            FA_SB(); } } } while (0)
#define FA_PIN(x) asm volatile("" : "+v"(x))
#define FA_PV_EXP(SC0, SC1, PP, PC) do { const int va_ = vfo + ((s0 + 2) % 3) * VBYTES; constexpr int NCH_ = 4 * NDB, EPC_ = 32 / NCH_, FD_ = FA_FD; \
        bf16x8 vf_[FD_]; _Pragma("unroll") for (int j_ = 0; j_ < FD_ - 1; ++j_) vf_[j_] = *(const LAS bf16x8*)(lds + va_ + (j_ / NDB) * DV * 32 + (j_ % NDB) * 512); \
        float s_[4] = {0.f, 0.f, 0.f, 0.f}; unsigned w_[16]; \
        _Pragma("unroll") for (int i_ = 0; i_ < NCH_; ++i_) { const int ks_ = i_ / NDB, db_ = i_ % NDB; \
            if (i_ + FD_ - 1 < NCH_) vf_[(i_ + FD_ - 1) % FD_] = *(const LAS bf16x8*)(lds + va_ + ((i_ + FD_ - 1) / NDB) * DV * 32 + ((i_ + FD_ - 1) % NDB) * 512); \
            o[db_] = __builtin_amdgcn_mfma_f32_32x32x16_bf16(vf_[i_ % FD_], PP[ks_], o[db_], 0, 0, 0); \
            _Pragma("unroll") for (int e_ = i_ * EPC_; e_ < (i_ + 1) * EPC_; ++e_) { if (e_ < 16) SC0[e_ & 15] = fast_exp2(SC0[e_ & 15]); else SC1[e_ & 15] = fast_exp2(SC1[e_ & 15]); } \
            if (i_ > 0) { _Pragma("unroll") for (int e_ = (i_ - 1) * EPC_; e_ < i_ * EPC_; ++e_) s_[e_ & 3] += FA_X(SC0, SC1, e_); \
                          _Pragma("unroll") for (int e_ = (i_ - 1) * EPC_; e_ < i_ * EPC_; e_ += 2) { w_[e_ >> 1] = cvtpk_n(FA_X(SC0, SC1, e_), FA_X(SC0, SC1, e_ + 1)); FA_PIN(w_[e_ >> 1]); } \
                          FA_PIN(s_[0]); FA_PIN(s_[1]); if (EPC_ > 2) { FA_PIN(s_[2]); FA_PIN(s_[3]); } } \
            FA_SB(); } \
        { _Pragma("unroll") for (int e_ = (NCH_ - 1) * EPC_; e_ < 32; ++e_) s_[e_ & 3] += FA_X(SC0, SC1, e_); \
          _Pragma("unroll") for (int e_ = (NCH_ - 1) * EPC_; e_ < 32; e_ += 2) { w_[e_ >> 1] = cvtpk_n(FA_X(SC0, SC1, e_), FA_X(SC0, SC1, e_ + 1)); FA_PIN(w_[e_ >> 1]); } } \
        l += (s_[0] + s_[1]) + (s_[2] + s_[3]); FA_PIN(l); \
        _Pragma("unroll") for (int g_ = 0; g_ < 4; ++g_) { u32x4 t_ = {w_[4 * g_], w_[4 * g_ + 1], w_[4 * g_ + 2], w_[4 * g_ + 3]}; PC[g_] = __builtin_bit_cast(bf16x8, t_); } \
        FA_SB(); } while (0)
#define FA_STEP(MODE, SC0, SC1, SN0, SN1, PP, PC) do { \
        const bool do_qk = (t + 1 >= a_lo && t + 1 <= a_hi), do_sm = (t >= a_lo && t <= a_hi), do_pv = (t - 1 >= a_lo && t - 1 <= a_hi); \
        if (MODE) {                                                              \
            if constexpr (OPT) { FA_QK_NOMAX(SN0, SN1); FA_PV_EXP(SC0, SC1, PP, PC); } \
            else { float rm; FA_QK_MAX(SC0, SC1, SN0, SN1, rm); \
                if (__builtin_expect(__any(rm > THR), 0)) { const float dl = fmaxf(rm, 0.f); FA_RESCALE_A(SC0, SC1, SN0, SN1, dl, true); } \
                FA_PV_EXP(SC0, SC1, PP, PC); FA_RESCALE_B(); } \
        } else {                                                                \
            if (do_qk) FA_QK(SN0, SN1); \
            if (do_sm) { if (TYPE != 1 && t >= near_lo) FA_BIAS(SC0, SC1, t); \
                if constexpr (!OPT) { float rm; FA_ROWMAX(SC0, SC1, rm); \
                    if (t == a_lo) { const float dl = (fabsf(rm) > 16.0f) ? rm : 0.f; FA_RESCALE_A(SC0, SC1, SN0, SN1, dl, do_qk); resc = false; l = 0.f; }     \
                    else if (__any(rm > THR)) { const float dl = fmaxf(rm, 0.f); FA_RESCALE_A(SC0, SC1, SN0, SN1, dl, do_qk); } } } \
            if (do_pv) FA_PV(PP); \
            if (do_sm) FA_EXP(SC0, SC1, PC); \
            if constexpr (!OPT) FA_RESCALE_B(); \
        } } while (0)
#define FA_ITER(MODE, t, SC0, SC1, SN0, SN1, PP, PC) do { \
        if ((t) >= T0 && (t) + 2 <= T1) { if (NPW == 2) FA_WAITBAR(2); else if (NPW == 3) FA_WAITBAR(3); else FA_WAITBAR(4); } else FA_WAITBAR(0); \
        if ((t) + 3 <= T1) FA_ISSUE_K((t) + 3, s0); \
        if ((t) + 1 <= T1) FA_ISSUE_V((t) + 1, (s0 + 1) % 3); \
        FA_STEP(MODE, SC0, SC1, SN0, SN1, PP, PC); \
        s0 = (s0 == 2) ? 0 : s0 + 1; } while (0)
#define FA_PAIR(MODE) do { { const int t = tt; FA_ITER(MODE, t, sA0, sA1, sB0, sB1, pa, pb); } { const int t = tt + 1; FA_ITER(MODE, t, sB0, sB1, sA0, sA1, pb, pa); } } while (0)
    int tt = T0 - 1;
    const int st_hi = (TYPE == 0) ? -(1 << 20) : c0 - 3;
    { FA_PAIR(0); tt += 2; }
    for (; tt + 1 <= st_hi; tt += 2) FA_PAIR(1);
#pragma unroll
    for (int r = 0; r < 16; ++r) negm[r] = -m;
    for (; tt <= T1 + 1; tt += 2) FA_PAIR(0);
    const float lt = pair_sum(l), inv = fast_rcp(lt);
    const bool ok_ = OPT ? (__all((lt > 7.9e-31f) && (lt < 1.2e30f)) != 0) : true;
    if (TYPE != 2) {
        bf16_t* op = ds.O + (size_t)qpos * D;
#pragma unroll
        for (int db = 0; db < NDB; ++db)
#pragma unroll
            for (int g = 0; g < 4; ++g) { u32x2 w; w.x = cvt_pk_bf16(o[db][4 * g] * inv, o[db][4 * g + 1] * inv); w.y = cvt_pk_bf16(o[db][4 * g + 2] * inv, o[db][4 * g + 3] * inv);
                *(u32x2*)(op + 32 * db + 8 * g + 4 * hi) = w; }
    } else {
        FA_WAITBAR(0);
        const int xb = XCH + ((rb * 32 + q) * 132) * 4;
        if (sub == 1) {
#pragma unroll
            for (int db = 0; db < NDB; ++db)
#pragma unroll
                for (int g = 0; g < 4; ++g) { f32x4 w = {o[db][4 * g] * inv, o[db][4 * g + 1] * inv, o[db][4 * g + 2] * inv, o[db][4 * g + 3] * inv}; *(LAS f32x4*)(lds + xb + (32 * db + 8 * g + 4 * hi) * 4) = w; }
        }
        FA_WAITBAR(0);
        if (sub == 0) {
            float ss = 0.f;
#pragma unroll
            for (int db = 0; db < NDB; ++db)
#pragma unroll
                for (int g = 0; g < 4; ++g) { const f32x4 w = *(const LAS f32x4*)(lds + xb + (32 * db + 8 * g + 4 * hi) * 4);
#pragma unroll
                    for (int jj = 0; jj < 4; ++jj) { const float a = o[db][4 * g + jj] * inv - ds.lam * w[jj]; o[db][4 * g + jj] = a; ss += a * a; } }
            ss = pair_sum(ss);
            const float rinv = ds.omli / sqrtf(ss * (1.0f / 128.0f) + RMS_EPS);
            bf16_t* op = ds.O + (size_t)qpos * D;
#pragma unroll
            for (int db = 0; db < NDB; ++db) { f32x4 sgv[4];
#pragma unroll
                for (int g = 0; g < 4; ++g) sgv[g] = *(const f32x4*)(ds.subln + 32 * db + 8 * g + 4 * hi);
#pragma unroll
                for (int g = 0; g < 4; ++g) { const int d = 32 * db + 8 * g + 4 * hi; const f32x4 sg = sgv[g];
                    u32x2 w; w.x = cvt_pk_bf16(o[db][4 * g] * rinv * sg[0], o[db][4 * g + 1] * rinv * sg[1]); w.y = cvt_pk_bf16(o[db][4 * g + 2] * rinv * sg[2], o[db][4 * g + 3] * rinv * sg[3]);
                    *(u32x2*)(op + d) = w; } }
        }
    }
#undef FA_ISSUE_K
#undef FA_ISSUE_V
    return ok_;
}
template <int TYPE>
__device__ __forceinline__ void attn_unit_checked(LAS unsigned char* lds, const int wave, const Desc ds) {
    const bool ok = attn_unit<TYPE, true>(lds, wave, ds);
    LAS int* flag = (LAS int*)(lds + LM_FLAG);
    if (!ok) *flag = 1;
    asm volatile("s_waitcnt vmcnt(0) lgkmcnt(0)\n\ts_barrier" ::: "memory");
    const int redo = *flag;
    asm volatile("s_waitcnt lgkmcnt(0)\n\ts_barrier" ::: "memory");
    if (redo) { if (wave == 0) *flag = 0; (void)attn_unit<TYPE, false>(lds, wave, ds); }
}
}

struct Args {
    const float* in[26];
    float* out; unsigned char* ws;
    float inv_freq[16];
    int ph_lo, ph_hi;
};
enum { I_X = 0, I_P, I_AB_WIN, I_AB_RELB, I_AB_QN, I_AB_KVN, I_AB_WUQ, I_AB_WUKV, I_AB_WOUT, I_C_WIN, I_C_LAM, I_C_SUBLN, I_C_WOUT, I_T5, I_LNMG, I_LNMB, I_LNFG, I_LNFB,
       I_RW, I_RB, I_EWIN, I_EBIN, I_EWOUT, I_EBOUT, I_PGW, I_PPW };

__device__ __forceinline__ void transpose_item(const float* W, int Nsrc, int c0, int k0, const float* kscale, bf16_t* WT, int K, int r0, LAS float* scr, int lane) {
#pragma unroll 8
    for (int i = 0; i < 32; ++i) { const int kk = 2 * i + (lane >> 5); float v = W[(size_t)(k0 + kk) * Nsrc + c0 + (lane & 31)]; if (kscale) v *= kscale[k0 + kk]; scr[kk * 33 + (lane & 31)] = v; }
    LDS_WAIT(); asm volatile("" ::: "memory");
    const int c = lane & 7;
#pragma unroll
    for (int j = 0; j < 4; ++j) { const int n = (lane >> 3) + 8 * j; const LAS float* s = scr + (8 * c) * 33 + n;
        u32x4 o; o.x = cvt_pk_bf16(s[0 * 33], s[1 * 33]); o.y = cvt_pk_bf16(s[2 * 33], s[3 * 33]); o.z = cvt_pk_bf16(s[4 * 33], s[5 * 33]); o.w = cvt_pk_bf16(s[6 * 33], s[7 * 33]);
        *(u32x4*)(WT + (size_t)(r0 + n) * K + k0 + 8 * c) = o; }
    LDS_WAIT(); asm volatile("" ::: "memory");
}
__device__ __forceinline__ void transpose_item_fp8(const float* W, int Nsrc, int c0, int k0, float sc, unsigned char* WT, int K, int r0, LAS float* scr, int lane) {
#pragma unroll 8
    for (int i = 0; i < 32; ++i) { const int kk = 2 * i + (lane >> 5); scr[kk * 33 + (lane & 31)] = W[(size_t)(k0 + kk) * Nsrc + c0 + (lane & 31)] * sc; }
    LDS_WAIT(); asm volatile("" ::: "memory");
    const int c = lane & 7;
#pragma unroll
    for (int j = 0; j < 4; ++j) { const int n = (lane >> 3) + 8 * j; const LAS float* s = scr + (8 * c) * 33 + n;
        u32x2 o; o.x = pg8::pack4_fp8(s[0 * 33], s[1 * 33], s[2 * 33], s[3 * 33]); o.y = pg8::pack4_fp8(s[4 * 33], s[5 * 33], s[6 * 33], s[7 * 33]);
        *(u32x2*)(WT + (size_t)(r0 + n) * K + k0 + 8 * c) = o; }
    LDS_WAIT(); asm volatile("" ::: "memory");
}
__device__ __forceinline__ void convert_tile_fp8(const float* W, int Nsrc, int c0, int k0, float sc, unsigned char* WT, int K, int r0, int lane) {
    const int q = lane & 7, g = lane >> 3;
    const float* src = W + (size_t)(k0 + 16 * g) * Nsrc + c0 + 4 * q;
    f32x4 v[16];
#pragma unroll
    for (int j = 0; j < 16; ++j) v[j] = __builtin_nontemporal_load((const f32x4*)(src + (size_t)j * Nsrc));
#pragma unroll
    for (int c = 0; c < 4; ++c) { u32x4 o;
        o.x = pg8::pack4_fp8(v[0][c] * sc, v[1][c] * sc, v[2][c] * sc, v[3][c] * sc); o.y = pg8::pack4_fp8(v[4][c] * sc, v[5][c] * sc, v[6][c] * sc, v[7][c] * sc);
        o.z = pg8::pack4_fp8(v[8][c] * sc, v[9][c] * sc, v[10][c] * sc, v[11][c] * sc); o.w = pg8::pack4_fp8(v[12][c] * sc, v[13][c] * sc, v[14][c] * sc, v[15][c] * sc);
        *(u32x4*)(WT + (size_t)(r0 + 4 * q + c) * K + k0 + 16 * g) = o; }
}
__device__ __forceinline__ void sincos_acc(float ang, float& sn, float& cs) {
    const double x = (double)ang; const double TWO_OVER_PI = 0.63661977236758134308, PIO2 = 1.57079632679489661923;
    const double kq = rint(x * TWO_OVER_PI); const double y = x - kq * PIO2; const double y2 = y * y;
    double s = y * (1.0 + y2 * (-1.0 / 6 + y2 * (1.0 / 120 + y2 * (-1.0 / 5040 + y2 * (1.0 / 362880 + y2 * (-1.0 / 39916800 + y2 * (1.0 / 6227020800.0)))))));
    double c = 1.0 + y2 * (-0.5 + y2 * (1.0 / 24 + y2 * (-1.0 / 720 + y2 * (1.0 / 40320 + y2 * (-1.0 / 3628800 + y2 * (1.0 / 479001600.0))))));
    const int q = ((int)(long long)kq) & 3;
    const double ss = (q == 0) ? s : (q == 1) ? c : (q == 2) ? -s : -c;
    const double cc = (q == 0) ? c : (q == 1) ? -s : (q == 2) ? -c : s;
    sn = (float)ss; cs = (float)cc;
}
__device__ __forceinline__ int t5_bucket_dev(int rel) {
    const int ret = rel > 0 ? 16 : 0; const int n = rel < 0 ? -rel : rel;
    if (n < 8) return ret + n;
    int large = 8 + (int)(__log2f((float)n * 0.125f) * 2.0f + 1e-4f);
    if (large > 15) large = 15;
    return ret + large;
}

__device__ __forceinline__ int opaque_s(int i) { asm volatile("" : "+s"(i)); return i; }
#define ARGIN(i) (args.in[opaque_s(i)])
struct Ctx { LAS unsigned char* lds; gu32* ctl; int wave, G, bx, vcu, gw, NGW, lo, hi; };
template <int L> __device__ __forceinline__ void layer_body(const Args& args, const Ctx cx, const XcdBarrier& bar);
__global__ void __launch_bounds__(NTHREADS, 2) mk_fwd(Args args) {
    extern __shared__ __attribute__((aligned(16))) unsigned char lds_raw[];
    LAS unsigned char* lds = (LAS unsigned char*)lds_raw;
    int wave_ = __builtin_amdgcn_readfirstlane(threadIdx.x >> 6); asm volatile("" : "+s"(wave_)); const int wave = wave_;
#define WS_DECL GAS unsigned char* wsg_ = (GAS unsigned char*)args.ws; asm volatile("" : "+s"(wsg_)); unsigned char* ws = (unsigned char*)wsg_
#define TID_DECL const int lane = lane_id_asm(), tid = wave * 64 + lane; (void)tid; (void)lane
    const int G = gridDim.x, bx = blockIdx.x;
    const int vcu = (G % 8 == 0) ? (bx % 8) * (G / 8) + bx / 8 : bx;
    const int gw = vcu * NWAVES + wave, NGW = G * NWAVES;
    gu32* ctl = (gu32*)(args.ws + WS_CTL);
    { TID_DECL; for (int u = tid; u < (LDS_BYTES - LM) / 4; u += NTHREADS) ((LAS unsigned*)(lds + LM))[u] = 0u; }
    __syncthreads();
#if MK_ONE_LAUNCH
    XcdBarrier bar = xcd_barrier_post((unsigned*)(ctl + CW_BAR), (volatile LAS unsigned*)(lds + LM_BAR));
#ifdef DOUBLE_BAR
#define GRID_BAR() do { xcd_barrier(bar); xcd_barrier(bar); } while (0)
#else
#define GRID_BAR() xcd_barrier(bar)
#endif
#else
#define GRID_BAR() do {} while (0)
#endif
    const int lo = args.ph_lo, hi = args.ph_hi;
#ifndef PH_MASK
#define PH_MASK 0xFFFF
#endif
#ifndef DUP_MASK
#define DUP_MASK 0
#endif
#define REP(b) for (int rep_ = 0; rep_ < (((DUP_MASK) >> (b)) & 1) + 1; ++rep_)
#define PHE(b) (((PH_MASK) >> (b)) & 1)
#define IN(k) (lo <= (k) && (k) < hi)
#define SEAM(k) do { if (IN(k) && IN((k) + 1)) GRID_BAR(); } while (0)

#define XB ((bf16_t*)(ws + WS_XB))
#define PB ((bf16_t*)(ws + WS_PB))
#define PP ((bf16_t*)(ws + WS_PP))
#define QA ((bf16_t*)(ws + WS_QA))
#define KA ((bf16_t*)(ws + WS_KA))
#define VAT ((bf16_t*)(ws + WS_VAT))
#define CQ ((bf16_t*)(ws + WS_CQ))
#define CKV ((bf16_t*)(ws + WS_CKV))
#define SSQQ ((float*)(ws + WS_SSQQ))
#define SSQKV ((float*)(ws + WS_SSQKV))
#define QB ((bf16_t*)(ws + WS_QB))
#define KB ((bf16_t*)(ws + WS_KB))
#define VBT ((bf16_t*)(ws + WS_VBT))
#define QC ((bf16_t*)(ws + WS_QC))
#define KC ((bf16_t*)(ws + WS_KC))
#define VCT ((bf16_t*)(ws + WS_VCT))
#define OAB ((bf16_t*)(ws + WS_OAB))
#define Z ((bf16_t*)(ws + WS_Z))
#define X1 ((float*)(ws + WS_X1))
#define XB1 ((bf16_t*)(ws + WS_XB1))
#define XF8 ((unsigned char*)(ws + WS_XF8))
#define Z2 ((bf16_t*)(ws + WS_Z2))
#define HS ((bf16_t*)(ws + WS_HS))
#define YS ((bf16_t*)(ws + WS_YS))
#define TOK ((int*)(ws + WS_TOK))
#define GATE ((float*)(ws + WS_GATE))
#define SLOT ((int*)(ws + WS_SLOT))
#define ROPE ((const f32x2*)(ws + WS_TAB + TAB_ROPE))
#define WRT ((float*)(ws + WS_TAB + TAB_WRT))
#define BIASA ((float*)(ws + WS_TAB + TAB_BIASA))
#define T5T ((float*)(ws + WS_TAB + TAB_T5))
#define LAMT ((float*)(ws + WS_TAB + TAB_LAM))
#define FATAB ((float*)(ws + WS_TAB + TAB_FA))
#define FAFAR ((float*)(ws + WS_TAB + TAB_FAFAR))
    if (PHE(0) && IN(0)) REP(0) { TID_DECL; WS_DECL;
        { const unsigned NT = (unsigned)(G * NTHREADS);
          for (unsigned i = (unsigned)(vcu * NTHREADS + wave * 64 + lane_id_asm()); i < (unsigned)(S * D / 8); i += NT) { const f32x4 a = *(const f32x4*)(args.in[I_X] + (size_t)i * 8), b = *(const f32x4*)(args.in[I_X] + (size_t)i * 8 + 4); *(u32x4*)(XB + (size_t)i * 8) = pg8::pack8(a, b); }
          for (unsigned i = (unsigned)(vcu * NTHREADS + wave * 64 + lane_id_asm()); i < (unsigned)(4 * S * PLE / 8); i += NT) { const f32x4 a = *(const f32x4*)(args.in[I_P] + (size_t)i * 8), b = *(const f32x4*)(args.in[I_P] + (size_t)i * 8 + 4); *(u32x4*)(PB + (size_t)i * 8) = pg8::pack8(a, b); }
          for (unsigned i = (unsigned)(vcu * NTHREADS + wave * 64 + lane_id_asm()); i < (unsigned)(S * 16); i += NT) { const int s = (int)(i >> 4), f = (int)(i & 15); const float ang = (float)s * args.inv_freq[f]; float sn, cs; sincos_acc(ang, sn, cs); ((f32x2*)(ws + WS_TAB + TAB_ROPE))[i] = (f32x2){cs, sn}; }
        }
        if (bx == 0) {
#if NAIVE_ATTN
          for (int i = tid; i < 2 * 8 * 260; i += NTHREADS) { const int j = i / (8 * 260), h = (i / 260) % 8, idx = i % 260; BIASA[i] = idx < 257 ? args.in[I_AB_RELB][((size_t)j * 257 + idx) * 8 + h] * LOG2E : 0.f; }
          for (int i = tid; i < 8 * 192; i += NTHREADS) { const int h = i / 192, rel = i % 192 - 128; T5T[i] = args.in[I_T5][t5_bucket_dev(rel) * 8 + h] * LOG2E; }
#endif
          if (tid < 16) { const int tb = tid >> 3, h = tid & 7; FAFAR[tid] = args.in[I_AB_RELB][((size_t)tb * 257 + 256) * 8 + h] * LOG2E; }
          else if (tid < 24) { FAFAR[tid] = args.in[I_T5][15 * 8 + (tid - 16)] * LOG2E; }
          if (wave < 2) { const int j = wave, d = lane_id_asm(); const float* lp = args.in[I_C_LAM] + j * 256; const float s01 = wave_sum(lp[d] * lp[64 + d]), s23 = wave_sum(lp[128 + d] * lp[192 + d]);
              const float li = 0.8f - 0.6f * fast_exp2(-0.3f * (float)(2 * j + 1) * LOG2E); if (d == 0) { LAMT[j * 2] = fast_exp2(s01 * LOG2E) - fast_exp2(s23 * LOG2E) + li; LAMT[j * 2 + 1] = 1.0f - li; } }
        }
        for (int i = vcu * NTHREADS + tid; i < 3 * 8 * 256; i += G * NTHREADS) {
          if (i < 2 * 8 * 256) { const int tb = i >> 11, h = (i >> 8) & 7, rel = (i & 255) - 192; int qk = -rel; qk = qk > 128 ? 128 : qk;
              FATAB[i] = args.in[I_AB_RELB][((size_t)tb * 257 + qk + 128) * 8 + h] * LOG2E; }
          else { const int i2 = i - 2 * 8 * 256, h = (i2 >> 8) & 7, rel = (i2 & 255) - 192; FATAB[i] = args.in[I_T5][t5_bucket_dev(rel) * 8 + h] * LOG2E; }
        }
        LAS float* scr = (LAS float*)(lds + wave * 16384);
        constexpr int J0 = 4 * 32 * (MOE_FP8 ? 8 : 16) * 64, J1 = 4 * 32 * (MOE_FP8 ? 8 : 16) * 32, J2 = 2 * 16 * 80, J3 = 2 * 8 * 24, J4 = 2 * 4 * 16, J5 = J4, J6 = 2 * 16 * 32, J7 = 2 * 16 * 96, J8 = J6, J9 = 4 * (MOE_FP8 ? 8 : 16) * 32, J10 = 4 * 4 * 32;
        constexpr int NITEMS = J0 + J1 + J2 + J3 + J4 + J5 + J6 + J7 + J8 + J9 + J10;
        for (int it = gw; it < NITEMS; it += NGW) {
            int r = it;
#if MOE_FP8
            if (r < J0) { const int mat = r / 512, q = r % 512, kb = q / 64, b = q % 64; const int t = b >> 3, s = (b >> 2) & 1, i32 = b & 3;
                convert_tile_fp8(args.in[I_EWIN] + (size_t)mat * 1024 * 2048, 2048, s * 1024 + 128 * t + 32 * i32, kb * 128, pg8::W1_SCALE, ws + WS_W1 + (size_t)mat * 2048 * 1024, 1024, b * 32, lane); continue; } r -= J0;
            if (r < J1) { const int mat = r / 256, q = r % 256, kb = q / 32, b = q % 32;
                convert_tile_fp8(args.in[I_EWOUT] + (size_t)mat * 1024 * 1024, 1024, b * 32, kb * 128, pg8::W2_SCALE, ws + WS_W2 + (size_t)mat * 1024 * 1024, 1024, b * 32, lane); continue; } r -= J1;
#else
            if (r < J0) { const int mat = r / 1024, q = r % 1024, kb = q / 64, b = q % 64; const int t = b >> 3, s = (b >> 2) & 1, i32 = b & 3;
                transpose_item(args.in[I_EWIN] + (size_t)mat * 1024 * 2048, 2048, s * 1024 + 128 * t + 32 * i32, kb * 64, nullptr, (bf16_t*)(ws + WS_W1) + (size_t)mat * 2048 * 1024, 1024, b * 32, scr, lane); continue; } r -= J0;
            if (r < J1) { const int mat = r / 512, q = r % 512, kb = q / 32, b = q % 32;
                transpose_item(args.in[I_EWOUT] + (size_t)mat * 1024 * 1024, 1024, b * 32, kb * 64, nullptr, (bf16_t*)(ws + WS_W2) + (size_t)mat * 1024 * 1024, 1024, b * 32, scr, lane); continue; } r -= J1;
#endif
            if (r < J2) { const int j = r / 1280, q = r % 1280, kb = q / 80, b = q % 80; int c0;
                if (b < 32) c0 = 32 * b; else if (b < 48) c0 = 1536 + 32 * (b - 32); else if (b < 56) c0 = 2048 + 32 * (b - 48); else if (b == 56) c0 = 2304; else if (b < 64) c0 = -1; else c0 = 1024 + 32 * (b - 64);
                if (c0 >= 0) transpose_item(args.in[I_AB_WIN] + (size_t)j * 1024 * AB_IN, AB_IN, c0, kb * 64, nullptr, (bf16_t*)(ws + WS_WABIN) + (size_t)j * 2560 * 1024, 1024, b * 32, scr, lane);
                continue; } r -= J2;
            if (r < J3) { const int j = r / 192, q = r % 192, kb = q / 24, b = q % 24;
                transpose_item(args.in[I_AB_WUQ] + (size_t)j * 512 * 768, 768, b * 32, kb * 64, args.in[I_AB_QN] + j * 512, (bf16_t*)(ws + WS_WUQ) + (size_t)j * 768 * 512, 512, b * 32, scr, lane); continue; } r -= J3;
            if (r < J4 + J5) { const int isv = r >= J4; if (isv) r -= J4; const int j = r / 64, q = r % 64, kb = q / 16, b = q % 16; const int h = b >> 1, hf = b & 1;
                transpose_item(args.in[I_AB_WUKV] + (size_t)j * 256 * 1024, 1024, h * 128 + 32 * hf + (isv ? 64 : 0), kb * 64, args.in[I_AB_KVN] + j * 256, (bf16_t*)(ws + (isv ? WS_WUKVV : WS_WUKVK)) + (size_t)j * 512 * 256, 256, b * 32, scr, lane); continue; } r -= J4 + J5;
            if (r < J6) { const int j = r / 512, q = r % 512, kb = q / 32, b = q % 32;
                transpose_item(args.in[I_AB_WOUT] + (size_t)j * 1024 * 1024, 1024, b * 32, kb * 64, nullptr, (bf16_t*)(ws + WS_WABOUT) + (size_t)j * 1024 * 1024, 1024, b * 32, scr, lane); continue; } r -= J6;
            if (r < J7) { const int j = r / 1536, q = r % 1536, kb = q / 96, b = q % 96;
                transpose_item(args.in[I_C_WIN] + (size_t)j * 1024 * 3072, 3072, b * 32, kb * 64, nullptr, (bf16_t*)(ws + WS_WCIN) + (size_t)j * 3072 * 1024, 1024, b * 32, scr, lane); continue; } r -= J7;
            if (r < J8) { const int j = r / 512, q = r % 512, kb = q / 32, b = q % 32;
                transpose_item(args.in[I_C_WOUT] + (size_t)j * 1024 * 1024, 1024, b * 32, kb * 64, nullptr, (bf16_t*)(ws + WS_WCOUT) + (size_t)j * 1024 * 1024, 1024, b * 32, scr, lane); continue; } r -= J8;
#if MOE_FP8
            if (r < J9) { const int j = r / 256, q = r % 256, kb = q / 32, b = q % 32;
                convert_tile_fp8(args.in[I_PGW] + (size_t)j * 1024 * 1024, 1024, b * 32, kb * 128, 32.0f, ws + WS_WPG + (size_t)j * 1024 * 1024, 1024, b * 32, lane); continue; } r -= J9;
#else
            if (r < J9) { const int j = r / 512, q = r % 512, kb = q / 32, b = q % 32;
                transpose_item(args.in[I_PGW] + (size_t)j * 1024 * 1024, 1024, b * 32, kb * 64, nullptr, (bf16_t*)(ws + WS_WPG) + (size_t)j * 1024 * 1024, 1024, b * 32, scr, lane); continue; } r -= J9;
#endif
            { const int j = r / 128, q = r % 128, kb = q / 32, b = q % 32;
                transpose_item(args.in[I_PPW] + (size_t)j * 256 * 1024, 1024, b * 32, kb * 64, nullptr, (bf16_t*)(ws + WS_WPP) + (size_t)j * 1024 * 256, 256, b * 32, scr, lane); }
        }
    }
    SEAM(0);
    if (PHE(1) && IN(1)) REP(1) { WS_DECL;
        { pg8::Gemm g{PB, (const bf16_t*)(ws + WS_WPP), 256, (size_t)1024 * 256, wave}; pg8::LayeredOrder So; So.so.init(4 * S, D, G, bx);
          pg8::EpiBf16Split E{PP, D, 1 << 20, 0, 1.0f};
          pg8::gemm_phase<pg8::EpiBf16Split, pg8::LayeredOrder, true>(lds, g, So, E); }
    }

    { Ctx cx{lds, ctl, wave, G, bx, vcu, gw, NGW, lo, hi};
#if MK_ONE_LAUNCH
      const XcdBarrier& barr = bar;
#else
      XcdBarrier barr{nullptr, 0u, nullptr};
#endif
      layer_body<0>(args, cx, barr); layer_body<1>(args, cx, barr); layer_body<2>(args, cx, barr); layer_body<3>(args, cx, barr); }
}

template <int L> __device__ __forceinline__ void layer_body(const Args& args, const Ctx cx, const XcdBarrier& bar) {
    LAS unsigned char* lds = cx.lds; gu32* ctl = cx.ctl; const int wave = cx.wave, G = cx.G, bx = cx.bx, vcu = cx.vcu, gw = cx.gw, NGW = cx.NGW, lo = cx.lo, hi = cx.hi;
    (void)bar; (void)ctl; (void)bx; (void)gw; (void)NGW; (void)vcu;
    {
        const int pb = 2 + 8 * L, j = L >> 1;
        if (pb + 8 <= lo || pb >= hi) return;
        if ((L & 1) == 0) {
            if (PHE(2) && IN(pb + 0)) REP(2) { WS_DECL;
                const bf16_t* W = (const bf16_t*)(ws + WS_WABIN) + (size_t)j * 2560 * 1024;
                { pg8::Gemm g{XB, W, 1024, 0, wave}; pg8::StaticOrder So; So.init(S, 2048, G, bx);
                  pg8::EpiABIn E{ws, 0.125f * LOG2E};
                  pg8::gemm_phase<pg8::EpiABIn, pg8::StaticOrder, true>(lds, g, So, E); }
                { pg8::Gemm g{W + (size_t)2048 * 1024, XB, 1024, 0, wave}; pg8::StaticOrder So; So.init(512, S, G, bx);
                  pg8::EpiVt<64, 0> E{VAT, nullptr, 0.f};
                  pg8::gemm_phase<pg8::EpiVt<64, 0>, pg8::StaticOrder, true>(lds, g, So, E); }
            }
            SEAM(pb + 0);
            if (PHE(3) && IN(pb + 1)) REP(3) { WS_DECL;
                { pg8::Gemm g{CQ, (const bf16_t*)(ws + WS_WUQ) + (size_t)j * 768 * 512, 512, 0, wave}; pg8::StaticOrder So; So.init(S, 768, G, bx);
                  pg8::EpiQUp E{ws, 0.10206207261596575f * LOG2E};
                  pg8::gemm_phase<pg8::EpiQUp, pg8::StaticOrder, true>(lds, g, So, E); }
                { pg8::Gemm g{CKV, (const bf16_t*)(ws + WS_WUKVK) + (size_t)j * 512 * 256, 256, 0, wave}; pg8::StaticOrder So; So.init(S, 512, G, (bx + 128) % G);
                  pg8::EpiKUp E{ws};
                  pg8::gemm_phase<pg8::EpiKUp, pg8::StaticOrder, true>(lds, g, So, E); }
                { pg8::Gemm g{(const bf16_t*)(ws + WS_WUKVV) + (size_t)j * 512 * 256, CKV, 256, 0, wave}; pg8::StaticOrder So; So.init(512, S, G, (bx + 64) % G);
                  pg8::EpiVt<64, 4> E{VBT, SSQKV, 1.0f / 256.0f};
                  pg8::gemm_phase<pg8::EpiVt<64, 4>, pg8::StaticOrder, true>(lds, g, So, E); }
            }
            SEAM(pb + 1);
        } else {
            if (PHE(4) && IN(pb + 0)) REP(4) { WS_DECL;
                const bf16_t* W = (const bf16_t*)(ws + WS_WCIN) + (size_t)j * 3072 * 1024;
                { pg8::Gemm g{XB, W, 1024, 0, wave}; pg8::StaticOrder So; So.init(S, 2048, G, bx);
                  pg8::EpiCIn E{ws, 0.125f * LOG2E};
                  pg8::gemm_phase<pg8::EpiCIn, pg8::StaticOrder, true>(lds, g, So, E); }
                { pg8::Gemm g{W + (size_t)2048 * 1024, XB, 1024, 0, wave}; pg8::StaticOrder So; So.init(1024, S, G, bx);
                  pg8::EpiVt<128, 0> E{VCT, nullptr, 0.f};
                  pg8::gemm_phase<pg8::EpiVt<128, 0>, pg8::StaticOrder, true>(lds, g, So, E); }
            }
            SEAM(pb + 0);
        }
#if !NAIVE_ATTN
        if (PHE(5) && IN(pb + 2)) REP(5 + (L & 1)) { WS_DECL;
            if ((L & 1) == 0) {
                for (int p = vcu; p < 256; p += G) { const int h = p >> 5, sidx = p & 31;
#pragma unroll 1
                    for (int k = 0; k < 2; ++k) { const int qb = k ? sidx : 63 - sidx;
                        fa::Desc ds{QB + h * 96, (const bf16_t*)((const unsigned char*)KB + (size_t)h * 256 * (ATT_B_FP8 ? 8192 : 12288)), VBT + (size_t)h * 256 * 64 * 64, OAB + 512 + h * 64, 768, 768, qb * 256, nullptr, 0.f, 0.f, 0.f, nullptr};
#if !defined(FA_ONLY) || FA_ONLY == 1
                        fa::attn_unit_checked<1>(lds, wave, ds);
#endif
                    } }
                for (int u = vcu; u < 512; u += G) { const int h = u >> 6, qb = u & 63;
                    fa::Desc ds{QA + h * 64, KA + (size_t)h * 256 * 64 * 64, VAT + (size_t)h * 256 * 64 * 64, OAB + h * 64, 512, 512, qb * 256, FATAB + (j * 8 + h) * 256, FAFAR[j * 8 + h], 0.f, 0.f, nullptr};
#if !defined(FA_ONLY) || FA_ONLY == 0
                    fa::attn_unit_checked<0>(lds, wave, ds);
#endif
                }
            } else {
                const float lam = LAMT[j * 2], omli = LAMT[j * 2 + 1];
                for (int p = vcu; p < 512; p += G) { const int h = p >> 6, sidx = p & 63;
#pragma unroll 1
                    for (int k = 0; k < 2; ++k) { const int qb = k ? sidx : 127 - sidx;
                        fa::Desc ds{QC + h * 128, (const bf16_t*)((const unsigned char*)KC + (size_t)h * 256 * (ATT_C_FP8 ? 8192 : 16384)), VCT + (size_t)h * 256 * 128 * 64, OAB + h * 128, 1024, 1024, qb * 128, FATAB + (16 + h) * 256, FAFAR[16 + h], lam, omli, ARGIN(I_C_SUBLN) + j * 128};
#if !defined(FA_ONLY) || FA_ONLY == 2
                        fa::attn_unit_checked<2>(lds, wave, ds);
#endif
                    } }
            }
            asm volatile("s_waitcnt vmcnt(0) lgkmcnt(0)\n\ts_barrier" ::: "memory");
        }
#else
        if (IN(pb + 2)) { TID_DECL; WS_DECL;
            if ((L & 1) == 0) { if (PHE(5)) {
                const float* bA = BIASA + (size_t)j * 8 * 260;
                for (int it = gw; it < 2 * 8 * S; it += NGW) {
                    const int typ = it / (8 * S), r2 = it % (8 * S), h = r2 / S, s = r2 % S, c = s >> 6;
                    const int dqk = typ ? 96 : 64; const bf16_t* Qp = typ ? QB + (size_t)s * 768 + h * 96 : QA + (size_t)s * 512 + h * 64;
                    const bf16_t* Kp = typ ? KB + h * 96 : KA + h * 64; const int kld = typ ? 768 : 512; const bf16_t* Vt = (typ ? VBT : VAT) + (size_t)h * 256 * 64 * 64;
                    float q[96];
#pragma unroll
                    for (int d = 0; d < 96; ++d) q[d] = d < dqk ? bf2f(Qp[d]) : 0.f;
                    float mx = -1e30f, l = 0.f, o = 0.f;
                    const int t0 = typ ? 0 : (c >= 8 ? c - 8 : 0);
                    for (int t = t0; t <= c; ++t) {
                        const int key = t * 64 + lane; const bf16_t* kr = Kp + (size_t)key * kld; float sc = 0.f;
#pragma unroll
                        for (int d8 = 0; d8 < 12; ++d8) if (d8 * 8 < dqk) { const u32x4 kk = *(const u32x4*)(kr + d8 * 8);
                            sc += q[d8 * 8] * bf_lo(kk.x) + q[d8 * 8 + 1] * bf_hi(kk.x) + q[d8 * 8 + 2] * bf_lo(kk.y) + q[d8 * 8 + 3] * bf_hi(kk.y) + q[d8 * 8 + 4] * bf_lo(kk.z) + q[d8 * 8 + 5] * bf_hi(kk.z) + q[d8 * 8 + 6] * bf_lo(kk.w) + q[d8 * 8 + 7] * bf_hi(kk.w); }
                        if (!typ) { int rel = s - key; rel = rel > 128 ? 128 : rel; sc += bA[h * 260 + rel + 128]; }
                        const float tm = wave_max(sc), mn = fmaxf(mx, tm), al_ = fast_exp2(mx - mn), p = fast_exp2(sc - mn);
                        l = l * al_ + wave_sum(p); o *= al_; mx = mn;
                        const bf16_t* vr = Vt + ((size_t)t * 64 + lane) * 64;
#pragma unroll
                        for (int k8 = 0; k8 < 8; ++k8) { const u32x4 vv = *(const u32x4*)(vr + k8 * 8);
                            o += rdlane(p, k8 * 8 + 0) * bf_lo(vv.x) + rdlane(p, k8 * 8 + 1) * bf_hi(vv.x) + rdlane(p, k8 * 8 + 2) * bf_lo(vv.y) + rdlane(p, k8 * 8 + 3) * bf_hi(vv.y)
                               + rdlane(p, k8 * 8 + 4) * bf_lo(vv.z) + rdlane(p, k8 * 8 + 5) * bf_hi(vv.z) + rdlane(p, k8 * 8 + 6) * bf_lo(vv.w) + rdlane(p, k8 * 8 + 7) * bf_hi(vv.w); }
                    }
                    const float r = o / l;
                    OAB[(size_t)s * D + typ * 512 + h * 64 + lane] = (bf16_t)(cvt_pk_bf16(r, r) & 0xffffu);
                }
            } } else if (PHE(6)) {
                const float lam = LAMT[j * 2], omli = LAMT[j * 2 + 1]; const float* sub = ARGIN(I_C_SUBLN) + j * 128;
                for (int it = gw; it < 8 * S; it += NGW) {
                    const int h = it / S, s = it % S, c = s >> 6; const bf16_t* Vt = VCT + (size_t)h * 256 * 128 * 64;
                    float ra0 = 0.f, ra1 = 0.f, rb0 = 0.f, rb1 = 0.f;
                    for (int sb = 0; sb < 2; ++sb) {
                        const bf16_t* Qp = QC + (size_t)s * D + h * 128 + sb * 64; const bf16_t* Kp = KC + h * 128 + sb * 64;
                        float q[64];
#pragma unroll
                        for (int d = 0; d < 64; ++d) q[d] = bf2f(Qp[d]);
                        float mx = -1e30f, l = 0.f, o0 = 0.f, o1 = 0.f;
                        for (int t = 0; t <= c; ++t) {
                            const int key = t * 64 + lane; const bf16_t* kr = Kp + (size_t)key * D; float sc = 0.f;
#pragma unroll
                            for (int d8 = 0; d8 < 8; ++d8) { const u32x4 kk = *(const u32x4*)(kr + d8 * 8);
                                sc += q[d8 * 8] * bf_lo(kk.x) + q[d8 * 8 + 1] * bf_hi(kk.x) + q[d8 * 8 + 2] * bf_lo(kk.y) + q[d8 * 8 + 3] * bf_hi(kk.y) + q[d8 * 8 + 4] * bf_lo(kk.z) + q[d8 * 8 + 5] * bf_hi(kk.z) + q[d8 * 8 + 6] * bf_lo(kk.w) + q[d8 * 8 + 7] * bf_hi(kk.w); }
                            { int rel = key - s; rel = rel < -128 ? -128 : rel; sc += T5T[h * 192 + rel + 128]; }
                            const float tm = wave_max(sc), mn = fmaxf(mx, tm), al_ = fast_exp2(mx - mn), p = fast_exp2(sc - mn);
                            l = l * al_ + wave_sum(p); o0 *= al_; o1 *= al_; mx = mn;
                            const bf16_t* vr0 = Vt + ((size_t)t * 128 + lane) * 64; const bf16_t* vr1 = vr0 + 64 * 64;
#pragma unroll
                            for (int k8 = 0; k8 < 8; ++k8) { const u32x4 va = *(const u32x4*)(vr0 + k8 * 8), vb = *(const u32x4*)(vr1 + k8 * 8);
                                const float p0 = rdlane(p, k8 * 8 + 0), p1 = rdlane(p, k8 * 8 + 1), p2 = rdlane(p, k8 * 8 + 2), p3 = rdlane(p, k8 * 8 + 3), p4 = rdlane(p, k8 * 8 + 4), p5 = rdlane(p, k8 * 8 + 5), p6 = rdlane(p, k8 * 8 + 6), p7 = rdlane(p, k8 * 8 + 7);
                                o0 += p0 * bf_lo(va.x) + p1 * bf_hi(va.x) + p2 * bf_lo(va.y) + p3 * bf_hi(va.y) + p4 * bf_lo(va.z) + p5 * bf_hi(va.z) + p6 * bf_lo(va.w) + p7 * bf_hi(va.w);
                                o1 += p0 * bf_lo(vb.x) + p1 * bf_hi(vb.x) + p2 * bf_lo(vb.y) + p3 * bf_hi(vb.y) + p4 * bf_lo(vb.z) + p5 * bf_hi(vb.z) + p6 * bf_lo(vb.w) + p7 * bf_hi(vb.w); }
                        }
                        if (sb == 0) { ra0 = o0 / l; ra1 = o1 / l; } else { rb0 = o0 / l; rb1 = o1 / l; }
                    }
                    const float a0 = ra0 - lam * rb0, a1 = ra1 - lam * rb1;
                    const float ms = wave_sum(a0 * a0 + a1 * a1) * (1.0f / 128.0f), inv = omli / sqrtf(ms + RMS_EPS);
                    const float r0 = a0 * inv * sub[lane], r1 = a1 * inv * sub[64 + lane];
                    OAB[(size_t)s * D + h * 128 + lane] = (bf16_t)(cvt_pk_bf16(r0, r0) & 0xffffu); OAB[(size_t)s * D + h * 128 + 64 + lane] = (bf16_t)(cvt_pk_bf16(r1, r1) & 0xffffu);
                }
            }
        }
#endif
        SEAM(pb + 2);
        if (PHE(7) && IN(pb + 3)) REP(7) { WS_DECL;
            pg8::Gemm g{OAB, (const bf16_t*)(ws + ((L & 1) ? WS_WCOUT : WS_WABOUT)) + (size_t)j * 1024 * 1024, 1024, 0, wave}; pg8::StaticOrder So; So.init(S, D, G, bx);
            if (L == 0) { pg8::EpiResid<true> E{ARGIN(I_X), Z}; pg8::gemm_phase<pg8::EpiResid<true>, pg8::StaticOrder, false>(lds, g, So, E); }
            else { pg8::EpiResid<false> E{XB, Z}; pg8::gemm_phase<pg8::EpiResid<false>, pg8::StaticOrder, false>(lds, g, So, E); }
        }
        SEAM(pb + 3);
        if (PHE(8) && IN(pb + 4)) { TID_DECL; WS_DECL;
            constexpr int XP = 1028;
            LAS float* XS = (LAS float*)lds;
            LAS float* PART = (LAS float*)(lds + 66048);
            LAS int* hist = (LAS int*)(lds + LM_HIST); LAS int* basep = (LAS int*)(lds + LM_BASE); LAS int* sel = (LAS int*)(lds + LM_SEL);
            if (tid < 32) hist[tid] = 0;
            __syncthreads();
            const float* gam = ARGIN(I_LNMG) + L * D; const float* bet = ARGIN(I_LNMB) + L * D; const float* rb = ARGIN(I_RB) + L * 32;
            const float* Wr = ARGIN(I_RW) + (size_t)L * D * 32;
            f32x4 gv[4], bv[4];
#pragma unroll
            for (int q = 0; q < 4; ++q) { gv[q] = *(const f32x4*)(gam + 4 * lane + 256 * q); bv[q] = *(const f32x4*)(bet + 4 * lane + 256 * q); }
            const int mi = lane & 15, kq = lane >> 4;
#define SPLIT8(src, H, Lw) do { u32x4 h_, l_; _Pragma("unroll") for (int i_ = 0; i_ < 4; ++i_) { const unsigned hp_ = cvt_pk_bf16(src[2 * i_], src[2 * i_ + 1]); h_[i_] = hp_; \
                l_[i_] = cvt_pk_bf16(src[2 * i_] - bf_lo(hp_), src[2 * i_ + 1] - bf_hi(hp_)); } H = __builtin_bit_cast(bf16x8, h_); Lw = __builtin_bit_cast(bf16x8, l_); } while (0)
            bf16x8 bh[4][2], bl[4][2];
            { const float* wp = Wr + (size_t)(128 * wave + 8 * kq) * 32 + mi;
#pragma unroll
              for (int ks = 0; ks < 4; ++ks)
#pragma unroll
                  for (int hf = 0; hf < 2; ++hf) { float w8[8];
#pragma unroll
                      for (int jj = 0; jj < 8; ++jj) w8[jj] = wp[(32 * ks + jj) * 32 + 16 * hf];
                      SPLIT8(w8, bh[ks][hf], bl[ks][hf]); } }
            for (int blk = vcu; blk < S / 64; blk += G) {
                u32x2 zr[2][4];
#pragma unroll
                for (int tt = 0; tt < 2; ++tt)
#pragma unroll
                    for (int q = 0; q < 4; ++q) zr[tt][q] = __builtin_nontemporal_load((const u32x2*)(Z + (size_t)(blk * 64 + wave * 2 + tt) * D + 4 * lane + 256 * q));
#pragma unroll 1
                for (int g = 0; g < 4; ++g) {
#pragma unroll
                    for (int tt = 0; tt < 2; ++tt) { const int tl16 = wave * 2 + tt, tok = blk * 64 + g * 16 + tl16;
                        f32x4 v[4]; float s = 0.f;
#pragma unroll
                        for (int q = 0; q < 4; ++q) { const u32x2 zw = zr[tt][q]; v[q][0] = bf_lo(zw.x); v[q][1] = bf_hi(zw.x); v[q][2] = bf_lo(zw.y); v[q][3] = bf_hi(zw.y); s += (v[q][0] + v[q][1]) + (v[q][2] + v[q][3]); }
                        if (g < 3) {
#pragma unroll
                            for (int q = 0; q < 4; ++q) zr[tt][q] = __builtin_nontemporal_load((const u32x2*)(Z + (size_t)(tok + 16) * D + 4 * lane + 256 * q)); }
                        const float mean = wsum_fast(s) * (1.0f / D); float s2 = 0.f;
#pragma unroll
                        for (int q = 0; q < 4; ++q) { v[q] = v[q] - mean; s2 += (v[q][0] * v[q][0] + v[q][1] * v[q][1]) + (v[q][2] * v[q][2] + v[q][3] * v[q][3]); }
                        const float rstd = 1.0f / sqrtf(wsum_fast(s2) * (1.0f / D) + LN_EPS);
#pragma unroll
                        for (int q = 0; q < 4; ++q) { v[q] = v[q] * rstd * gv[q] + bv[q];
                            u32x2 w; w.x = cvt_pk_bf16(v[q][0], v[q][1]); w.y = cvt_pk_bf16(v[q][2], v[q][3]); *(u32x2*)(XB1 + (size_t)tok * D + 4 * lane + 256 * q) = w;
#if MOE_FP8
                            *(unsigned*)(XF8 + (size_t)tok * D + 4 * lane + 256 * q) = pg8::pack4_fp8(v[q][0], v[q][1], v[q][2], v[q][3]);
#endif
                            *(LAS f32x4*)(XS + tl16 * XP + 4 * lane + 256 * q) = v[q]; }
                    }
                    __syncthreads();
                    f32x4 acc0 = {0.f, 0.f, 0.f, 0.f}, acc1 = {0.f, 0.f, 0.f, 0.f};
#pragma unroll
                    for (int ks = 0; ks < 4; ++ks) { const f32x4 a0 = *(const LAS f32x4*)(XS + mi * XP + 128 * wave + 32 * ks + 8 * kq), a1 = *(const LAS f32x4*)(XS + mi * XP + 128 * wave + 32 * ks + 8 * kq + 4);
                        const float x8[8] = {a0[0], a0[1], a0[2], a0[3], a1[0], a1[1], a1[2], a1[3]}; bf16x8 xh, xl; SPLIT8(x8, xh, xl);
                        acc0 = __builtin_amdgcn_mfma_f32_16x16x32_bf16(xh, bh[ks][0], acc0, 0, 0, 0); acc1 = __builtin_amdgcn_mfma_f32_16x16x32_bf16(xh, bh[ks][1], acc1, 0, 0, 0);
                        acc0 = __builtin_amdgcn_mfma_f32_16x16x32_bf16(xh, bl[ks][0], acc0, 0, 0, 0); acc1 = __builtin_amdgcn_mfma_f32_16x16x32_bf16(xh, bl[ks][1], acc1, 0, 0, 0);
                        acc0 = __builtin_amdgcn_mfma_f32_16x16x32_bf16(xl, bh[ks][0], acc0, 0, 0, 0); acc1 = __builtin_amdgcn_mfma_f32_16x16x32_bf16(xl, bh[ks][1], acc1, 0, 0, 0); }
                    *(LAS f32x4*)(PART + (wave * 64 + lane) * 8) = acc0; *(LAS f32x4*)(PART + (wave * 64 + lane) * 8 + 4) = acc1;
                    __syncthreads();
                    const int tw = wave * 2 + (lane >> 5), e = lane & 31, sl = (e & 15) + 16 * (tw >> 2), sc = (e >> 4) * 4 + (tw & 3);
                    float lg = rb[e];
#pragma unroll
                    for (int w2 = 0; w2 < 8; ++w2) lg += PART[(w2 * 64 + sl) * 8 + sc];
                    const unsigned ub = __float_as_uint(lg); const unsigned key = (((ub & 0x80000000u) ? ~ub : (ub | 0x80000000u)) & ~31u) | (unsigned)(31 - e);
                    int rank = 4; unsigned kk = key;
#pragma unroll
                    for (int rd = 0; rd < 4; ++rd) { unsigned mx = kk, o_;
                        o_ = (unsigned)__builtin_amdgcn_update_dpp(0, (int)mx, 0xB1, 0xF, 0xF, true); mx = mx > o_ ? mx : o_;
                        o_ = (unsigned)__builtin_amdgcn_update_dpp(0, (int)mx, 0x4E, 0xF, 0xF, true); mx = mx > o_ ? mx : o_;
                        o_ = (unsigned)__builtin_amdgcn_update_dpp(0, (int)mx, 0x124, 0xF, 0xF, true); mx = mx > o_ ? mx : o_;
                        o_ = (unsigned)__builtin_amdgcn_update_dpp(0, (int)mx, 0x128, 0xF, 0xF, true); mx = mx > o_ ? mx : o_;
                        { const auto rr = __builtin_amdgcn_permlane16_swap(mx, mx, false, false); mx = rr[0] > rr[1] ? rr[0] : rr[1]; }
                        if (kk == mx) { rank = rd; kk = 0u; } }
                    const unsigned long long m0 = __ballot(rank == 0);
                    const float va = __uint_as_float((unsigned)__builtin_amdgcn_readlane((int)__float_as_uint(lg), __builtin_ctz((unsigned)m0)));
                    const float vb = __uint_as_float((unsigned)__builtin_amdgcn_readlane((int)__float_as_uint(lg), 32 + __builtin_ctz((unsigned)(m0 >> 32))));
                    const float v0 = (lane & 32) ? vb : va;
                    const float ex = (rank < 4) ? fast_exp2((lg - v0) * LOG2E) : 0.f;
                    float se = ex; se += dppx<0xB1>(se); se += dppx<0x4E>(se); se += dppx<0x124>(se); se += dppx<0x128>(se);
                    { auto rr = __builtin_amdgcn_permlane16_swap(__float_as_uint(se), __float_as_uint(se), false, false); se = __uint_as_float(rr[0]) + __uint_as_float(rr[1]); }
                    if (rank < 4) { const int tl = g * 16 + tw; const float ww = ex / se;
                        const int rk = __hip_atomic_fetch_add(&hist[e], 1, __ATOMIC_RELAXED, __HIP_MEMORY_SCOPE_WORKGROUP); sel[(tl * 4 + rank) * 3 + 0] = e; sel[(tl * 4 + rank) * 3 + 1] = rk; sel[(tl * 4 + rank) * 3 + 2] = __float_as_int(ww); }
                }
                __syncthreads();
                if (tid < 32) { const int n = hist[tid]; basep[tid] = n ? (int)__hip_atomic_fetch_add((unsigned*)(ctl + CW_CNT + (L * 32 + tid) * 16), (unsigned)n, __ATOMIC_RELAXED, __HIP_MEMORY_SCOPE_AGENT) : 0; }
                __syncthreads();
                if (tid < 256) { const int ee = sel[tid * 3], pos = basep[ee] + sel[tid * 3 + 1]; const int tok = blk * 64 + (tid >> 2);
                    TOK[(size_t)ee * S + pos] = tok; GATE[(size_t)ee * S + pos] = __int_as_float(sel[tid * 3 + 2]); SLOT[((size_t)tok * 4 + (tid & 3)) * 2] = ee; SLOT[((size_t)tok * 4 + (tid & 3)) * 2 + 1] = pos; }
                __syncthreads();
                if (tid < 32) hist[tid] = 0;
                __syncthreads();
            }
        }
        SEAM(pb + 4);
        if (IN(pb + 5) || IN(pb + 6) || IN(pb + 7)) { TID_DECL;
            LAS int* toff = (LAS int*)(lds + LM_TOFF); LAS int* cntl = (LAS int*)(lds + LM_CNT);
            __syncthreads();
            if (wave == 0) { const int e = tid & 31;
                const int c = (int)__hip_atomic_load((unsigned*)(ctl + CW_CNT + (L * 32 + e) * 16), __ATOMIC_RELAXED, __HIP_MEMORY_SCOPE_AGENT); const int nt = (tid < 32) ? (c + 255) >> 8 : 0;
                int incl = nt;
#pragma unroll
                for (int dlt = 1; dlt < 32; dlt <<= 1) { const int o = __shfl_up(incl, dlt); if ((tid & 63) >= dlt) incl += o; }
                if (tid < 32) { cntl[e] = c; toff[e] = incl - nt; if (tid == 31) toff[32] = incl; } }
            __syncthreads();
            if (tid < 320) { int e = 0;
#pragma unroll
                for (int stp = 16; stp >= 1; stp >>= 1) { if (e + stp <= 31 && toff[e + stp] <= tid) e += stp; }
                ((LAS int*)(lds + LM_T2E))[tid] = e; }
            __syncthreads();
        }
        if (PHE(9) && IN(pb + 5)) REP(9) { WS_DECL;
#if MOE_FP8
            { pg8::Gemm g{(const bf16_t*)XF8, (const bf16_t*)(ws + WS_W1 + (size_t)L * 32 * 2048 * 1024), 512, (size_t)2048 * 512, wave};
#else
            { pg8::Gemm g{XB1, (const bf16_t*)(ws + WS_W1) + (size_t)L * 32 * 2048 * 1024, 1024, (size_t)2048 * 1024, wave};
#endif
              pg8::MoeOrder<true> So{(const LAS int*)(lds + LM_TOFF), (const LAS int*)(lds + LM_CNT), (const LAS int*)(lds + LM_T2E), TOK, 8, G, vcu};
              pg8::EpiMoeAct E{(unsigned char*)HS, ARGIN(I_EBIN) + (size_t)L * 32 * 2048};
              pg8::gemm_phase<pg8::EpiMoeAct, pg8::MoeOrder<true>, true>(lds, g, So, E); }
#if MOE_FP8
            { pg8::Gemm g{(const bf16_t*)XF8, (const bf16_t*)(ws + WS_WPG + (size_t)L * 1024 * 1024), 512, 0, wave}; pg8::StaticOrder So; So.init(S, D, G, bx);
#else
            { pg8::Gemm g{XB1, (const bf16_t*)(ws + WS_WPG) + (size_t)L * 1024 * 1024, 1024, 0, wave}; pg8::StaticOrder So; So.init(S, D, G, bx);
#endif
              pg8::EpiPle E{XB1, PP + (size_t)L * S * D, Z2};
              pg8::gemm_phase<pg8::EpiPle, pg8::StaticOrder, false>(lds, g, So, E); }
        }
        SEAM(pb + 5);
        if (PHE(10) && IN(pb + 6)) REP(10) { WS_DECL;
#if MOE_FP8
            pg8::Gemm g{HS, (const bf16_t*)(ws + WS_W2 + (size_t)L * 32 * 1024 * 1024), 512, (size_t)1024 * 512, wave};
#else
            pg8::Gemm g{HS, (const bf16_t*)(ws + WS_W2) + (size_t)L * 32 * 1024 * 1024, 1024, (size_t)1024 * 1024, wave};
#endif
            pg8::MoeOrder<false> So{(const LAS int*)(lds + LM_TOFF), (const LAS int*)(lds + LM_CNT), (const LAS int*)(lds + LM_T2E), TOK, 4, G, vcu};
            pg8::EpiMoeDown E{YS, ARGIN(I_EBOUT) + (size_t)L * 32 * 1024, GATE};
            pg8::gemm_phase<pg8::EpiMoeDown, pg8::MoeOrder<false>, true>(lds, g, So, E);
        }
        SEAM(pb + 6);
        if (PHE(11) && IN(pb + 7)) REP(11) { TID_DECL; WS_DECL;
            const LAS int* toff = (const LAS int*)(lds + LM_TOFF);
            const float* gam = ARGIN(I_LNFG) + L * D; const float* bet = ARGIN(I_LNFB) + L * D;
            f32x4 gv[4], bv[4];
#pragma unroll
            for (int q = 0; q < 4; ++q) { gv[q] = *(const f32x4*)(gam + 4 * lane + 256 * q); bv[q] = *(const f32x4*)(bet + 4 * lane + 256 * q); }
            for (int t0 = gw; t0 < S; t0 += 8 * NGW) {
              const int tl = t0 + (lane >> 3) * NGW; const int sw = (tl < S) ? SLOT[(size_t)tl * 8 + (lane & 7)] : 0;
#pragma unroll 1
              for (int i8 = 0; i8 < 8; ++i8) { const int tok = t0 + i8 * NGW; if (tok >= S) break;
                f32x4 v[4];
#pragma unroll
                for (int q = 0; q < 4; ++q) { const u32x2 zw = __builtin_nontemporal_load((const u32x2*)(Z2 + (size_t)tok * D + 4 * lane + 256 * q)); v[q][0] = bf_lo(zw.x); v[q][1] = bf_hi(zw.x); v[q][2] = bf_lo(zw.y); v[q][3] = bf_hi(zw.y); }
#pragma unroll
                for (int k = 0; k < 4; ++k) { const int ee = __builtin_amdgcn_readlane(sw, i8 * 8 + 2 * k), pos = __builtin_amdgcn_readlane(sw, i8 * 8 + 2 * k + 1); const bf16_t* yr = YS + ((size_t)toff[ee] * 256 + pos) * 1024;
#pragma unroll
                    for (int q = 0; q < 4; ++q) { const u32x2 w = __builtin_nontemporal_load((const u32x2*)(yr + 4 * lane + 256 * q)); v[q][0] += bf_lo(w.x); v[q][1] += bf_hi(w.x); v[q][2] += bf_lo(w.y); v[q][3] += bf_hi(w.y); } }
                float s = 0.f;
#pragma unroll
                for (int q = 0; q < 4; ++q) s += (v[q][0] + v[q][1]) + (v[q][2] + v[q][3]);
                const float mean = wave_sum(s) * (1.0f / D); float s2 = 0.f;
#pragma unroll
                for (int q = 0; q < 4; ++q) { v[q] = v[q] - mean; s2 += (v[q][0] * v[q][0] + v[q][1] * v[q][1]) + (v[q][2] * v[q][2] + v[q][3] * v[q][3]); }
                const float rstd = 1.0f / sqrtf(wave_sum(s2) * (1.0f / D) + LN_EPS);
#pragma unroll
                for (int q = 0; q < 4; ++q) { v[q] = v[q] * rstd * gv[q] + bv[q]; if (L == DEPTH - 1) *(f32x4*)(args.out + (size_t)tok * D + 4 * lane + 256 * q) = v[q];
                    u32x2 w; w.x = cvt_pk_bf16(v[q][0], v[q][1]); w.y = cvt_pk_bf16(v[q][2], v[q][3]); *(u32x2*)(XB + (size_t)tok * D + 4 * lane + 256 * q) = w; }
              }
            }
        }
        SEAM(pb + 7);
    }
}

extern "C" void kernel_launch(void* const* d_in, const int* in_sizes, int n_in, void* d_out, int out_size, void* d_ws, size_t ws_size, hipStream_t stream) {
    static int grid = 0;
    if (grid == 0) {
        if (n_in != 26 || out_size != S * D || ws_size < WS_END) { fprintf(stderr, "kernel_launch: unexpected shapes (n_in %d out %d ws %zu need %zu)\n", n_in, out_size, ws_size, (size_t)WS_END); grid = -1; return; }
        int dev = 0, cus = 0, per_cu = 0;
        if (hipGetDevice(&dev) != hipSuccess || hipDeviceGetAttribute(&cus, hipDeviceAttributeMultiprocessorCount, dev) != hipSuccess) { grid = -1; return; }
        if (hipFuncSetAttribute((const void*)mk_fwd, hipFuncAttributeMaxDynamicSharedMemorySize, LDS_BYTES) != hipSuccess) { fprintf(stderr, "kernel_launch: hipFuncSetAttribute failed\n"); grid = -1; return; }
        if (hipOccupancyMaxActiveBlocksPerMultiprocessor(&per_cu, (const void*)mk_fwd, NTHREADS, LDS_BYTES) != hipSuccess || per_cu < 1) { fprintf(stderr, "kernel_launch: occupancy query says %d\n", per_cu); }
        (void)hipGetLastError();
        grid = cus;
    }
    if (grid < 0) return;
    hipMemsetAsync((char*)d_ws + WS_CTL, 0, CTL_BYTES, stream);
    Args a{};
    for (int i = 0; i < 26; ++i) a.in[i] = (const float*)d_in[i];
    a.out = (float*)d_out; a.ws = (unsigned char*)d_ws;
    for (int i = 0; i < 16; ++i) a.inv_freq[i] = powf(10000.0f, -(float)(2 * i) / 32.0f);
    const int NPH = 2 + 8 * DEPTH;
#if MK_ONE_LAUNCH
    a.ph_lo = 0; a.ph_hi = NPH;
    hipLaunchKernelGGL(mk_fwd, dim3(grid), dim3(NTHREADS), LDS_BYTES, stream, a);
#else
    for (int ph = 0; ph < NPH; ++ph) {
        if (ph >= 2 && ((ph - 2) % 8) == 1 && (((ph - 2) / 8) & 1)) continue;
        a.ph_lo = ph; a.ph_hi = ph + 1;
        hipLaunchKernelGGL(mk_fwd, dim3(grid), dim3(NTHREADS), LDS_BYTES, stream, a);
    }
#endif
}
```
